# Optimizing an MI355X kernel written in HIP

```python
import jax
import jax.numpy as jnp
from jax import lax
import numpy as np

D_MODEL = 2048
BATCH = 8
SEQ = 4096
DEPTH = 2

EPS = 1e-6
A_WIDTH = D_MODEL // 2
A_BLOCKS = 8
A_BLOCK = A_WIDTH // A_BLOCKS
A_CONV = 4
LRU_C = 8.0
B_WIDTH = D_MODEL // 2
B_HEAD = 64
B_HEADS = B_WIDTH // B_HEAD
B_DECAY_RANK = 64
B_AAA_RANK = 64
B_GATE_RANK = 160
B_PROJ = 3 * B_WIDTH + B_DECAY_RANK + B_AAA_RANK + B_GATE_RANK
B_SPLITS = (B_WIDTH, 2 * B_WIDTH, 3 * B_WIDTH, 3 * B_WIDTH + B_DECAY_RANK, 3 * B_WIDTH + B_DECAY_RANK + B_AAA_RANK)
B_LN_EPS = 64e-5
EVEN_IN = 2 * A_WIDTH + B_PROJ
C_WIDTH = 2 * D_MODEL
C_HEADS = 8
C_HEAD = C_WIDTH // C_HEADS
C_QKV_BLOCK = 4
C_CONV = 4
C_CHUNK = 64
D_FF = 5632
FFN_CONV = 3
N_EVEN = (DEPTH + 1) // 2
N_ODD = DEPTH // 2

kernel_name = 'hybrid_rglru_rwkv7_mlstm_convffn'


def rms_norm(x, g):
    x32 = x.astype(jnp.float32)
    y = x32 * lax.rsqrt(jnp.mean(x32 * x32, axis=-1, keepdims=True) + EPS)
    return (y * g).astype(x.dtype)


def head_layer_norm(x, eps):
    x32 = x.astype(jnp.float32)
    xc = x32 - jnp.mean(x32, axis=-1, keepdims=True)
    return xc * lax.rsqrt(jnp.mean(xc * xc, axis=-1, keepdims=True) + eps)


def causal_dwconv(x, w, b):
    k_width, t_len = w.shape[0], x.shape[1]
    xp = jnp.pad(x, ((0, 0), (k_width - 1, 0), (0, 0)))
    out = b + xp[:, 0:t_len] * w[0]
    for j in range(1, k_width):
        out = out + xp[:, j:j + t_len] * w[j]
    return out


def token_shift(x):
    return jnp.pad(x[:, :-1], ((0, 0), (1, 0), (0, 0)))


def block_diag(x, w):
    g, bs = w.shape[0], w.shape[1]
    y = jnp.einsum('btgi,gij->btgj', x.reshape(x.shape[0], x.shape[1], g, bs), w)
    return y.reshape(x.shape)


def rg_lru(x, w_r, b_r, w_i, b_i, lam):
    x32 = x.astype(jnp.float32)
    r = jax.nn.sigmoid(block_diag(x32, w_r) + b_r)
    i = jax.nn.sigmoid(block_diag(x32, w_i) + b_i)
    log_a = -LRU_C * r * jax.nn.softplus(-lam)
    a = jnp.exp(log_a)
    u = jnp.sqrt(-jnp.expm1(2.0 * log_a)) * (i * x32)

    def combine(lhs, rhs):
        a_l, u_l = lhs
        a_r, u_r = rhs
        return a_r * a_l, a_r * u_l + u_r

    _, h = lax.associative_scan(combine, (a, u), axis=1)
    return h.astype(x.dtype)


def rwkv7_time_mix(p, mu, w0, w_up, a0, a_up, g_up, k_k, k_a, r_k, ln_w, ln_b):
    bsz, t_len, _ = p.shape
    p = p + (token_shift(p) - p) * mu
    r, k, v, xw, xa, xg = jnp.split(p, B_SPLITS, axis=-1)
    log_w = -jnp.exp(-jax.nn.softplus(-(w0 + jnp.tanh(xw) @ w_up)) - 0.5)
    a = jax.nn.sigmoid(a0 + xa @ a_up)
    g = jax.nn.sigmoid(xg) @ g_up

    def heads(t):
        return t.astype(jnp.float32).reshape(bsz, t_len, B_HEADS, B_HEAD)

    kk = heads(k * k_k)
    kk = kk * lax.rsqrt(jnp.maximum(jnp.sum(kk * kk, axis=-1, keepdims=True), 1e-12))
    k = heads(k * (1.0 + (a - 1.0) * k_a))
    r, v, a, w = heads(r), heads(v), heads(a), jnp.exp(heads(log_w))

    def step(s, inp):
        r_t, w_t, k_t, v_t, a_t, b_t = inp
        sa = jnp.einsum('bhvk,bhk->bhv', s, a_t)
        s = s * w_t[:, :, None, :] + sa[..., None] * b_t[:, :, None, :] + v_t[..., None] * k_t[:, :, None, :]
        return s, jnp.einsum('bhvk,bhk->bhv', s, r_t)

    xs = tuple(jnp.moveaxis(t, 1, 0) for t in (r, w, k, v, -kk, kk * a))
    s0 = jnp.zeros((bsz, B_HEADS, B_HEAD, B_HEAD), jnp.float32)
    _, y = lax.scan(step, s0, xs)
    y = jnp.moveaxis(y, 0, 1)
    y = head_layer_norm(y, B_LN_EPS) * ln_w.reshape(B_HEADS, B_HEAD) + ln_b.reshape(B_HEADS, B_HEAD)
    y = y + jnp.sum(r * k * r_k, axis=-1, keepdims=True) * v
    return (y.reshape(bsz, t_len, B_WIDTH) * g).astype(p.dtype)


def mlstm_chunkwise(q, k, v, i_pre, f_pre):
    bsz, t_len = q.shape[0], q.shape[1]
    nc = t_len // C_CHUNK

    def chunks(t):
        t = t.reshape((bsz, nc, C_CHUNK) + t.shape[2:])
        return jnp.moveaxis(jnp.moveaxis(t, 1, 0), 2, 3)

    causal = jnp.tril(jnp.ones((C_CHUNK, C_CHUNK), dtype=bool))

    def step(carry, inp):
        c_mat, n_vec, m = carry
        q_c, k_c, v_c, lf, li = inp
        b = jnp.cumsum(lf, axis=-1)
        d_log = jnp.where(causal, b[..., :, None] - b[..., None, :] + li[..., None, :], -jnp.inf)
        inter = b + m[..., None]
        m_t = jnp.maximum(inter, jnp.max(d_log, axis=-1))
        s = jnp.einsum('bhtd,bhsd->bhts', q_c, k_c) * jnp.exp(d_log - m_t[..., None])
        sc = jnp.exp(inter - m_t)
        num = jnp.einsum('bhts,bhsd->bhtd', s, v_c) + sc[..., None] * jnp.einsum('bhvk,bhtk->bhtv', c_mat, q_c)
        den = jnp.sum(s, axis=-1) + sc * jnp.einsum('bhk,bhtk->bht', n_vec, q_c)
        h = num / jnp.maximum(jnp.abs(den), jnp.exp(-m_t))[..., None]
        b_last = b[..., -1]
        g_log = b_last[..., None] - b + li
        m_new = jnp.maximum(b_last + m, jnp.max(g_log, axis=-1))
        e = jnp.exp(g_log - m_new[..., None])
        decay = jnp.exp(b_last + m - m_new)
        c_mat = decay[..., None, None] * c_mat + jnp.einsum('bhsv,bhsk->bhvk', v_c * e[..., None], k_c)
        n_vec = decay[..., None] * n_vec + jnp.einsum('bhs,bhsk->bhk', e, k_c)
        return (c_mat, n_vec, m_new), h

    k = k * (C_HEAD ** -0.5)
    xs = (chunks(q), chunks(k), chunks(v), chunks(jax.nn.log_sigmoid(f_pre)), chunks(i_pre))
    init = (jnp.zeros((bsz, C_HEADS, C_HEAD, C_HEAD), jnp.float32),
            jnp.zeros((bsz, C_HEADS, C_HEAD), jnp.float32),
            jnp.zeros((bsz, C_HEADS), jnp.float32))
    _, h = lax.scan(step, init, xs)
    return jnp.moveaxis(jnp.moveaxis(h, 3, 2), 0, 1).reshape(bsz, t_len, C_HEADS, C_HEAD)


def rglru_rwkv7_layer(x, norm, w_in, a_conv_w, a_conv_b, a_w_r, a_b_r, a_w_i, a_b_i, a_lambda,
                      b_mu, b_w0, b_w_up, b_a0, b_a_up, b_g_up, b_k_k, b_k_a, b_r_k, b_ln_w, b_ln_b, w_out):
    h = rms_norm(x, norm)
    xa, ga, pb = jnp.split(h @ w_in, [A_WIDTH, 2 * A_WIDTH], axis=-1)
    ya = rg_lru(causal_dwconv(xa, a_conv_w, a_conv_b), a_w_r, a_b_r, a_w_i, a_b_i, a_lambda) * jax.nn.gelu(ga)
    yb = rwkv7_time_mix(pb, b_mu, b_w0, b_w_up, b_a0, b_a_up, b_g_up, b_k_k, b_k_a, b_r_k, b_ln_w, b_ln_b)
    return x + jnp.concatenate([ya, yb], axis=-1) @ w_out


def mlstm_layer(x, norm, w_in, conv_w, conv_b, w_q, w_k, w_v, w_if, b_if, ln_w, skip, w_out):
    bsz, t_len, _ = x.shape
    h = rms_norm(x, norm)
    xm, z = jnp.split(h @ w_in, [C_WIDTH], axis=-1)
    xc = jax.nn.silu(causal_dwconv(xm, conv_w, conv_b))
    q, k, v = block_diag(xc, w_q), block_diag(xc, w_k), block_diag(xm, w_v)
    gates = (jnp.einsum('btc,cg->btg', q, w_if[0]) + jnp.einsum('btc,cg->btg', k, w_if[1])
             + jnp.einsum('btc,cg->btg', v, w_if[2]) + b_if)
    i_pre, f_pre = jnp.split(gates.astype(jnp.float32), [C_HEADS], axis=-1)

    def heads(t):
        return t.astype(jnp.float32).reshape(bsz, t_len, C_HEADS, C_HEAD)

    hc = mlstm_chunkwise(heads(q), heads(k), heads(v), i_pre, f_pre)
    hn = head_layer_norm(hc, EPS) * ln_w.reshape(C_HEADS, C_HEAD)
    hs = hn.reshape(bsz, t_len, C_WIDTH).astype(x.dtype) + skip * xc
    return x + (hs * jax.nn.silu(z)) @ w_out


def conv_ffn(x, norm, w_gate, w_up, conv_w, conv_b, w_down):
    h = rms_norm(x, norm)
    u = jax.nn.silu(causal_dwconv(h @ w_gate, conv_w, conv_b)) * (h @ w_up)
    return x + u @ w_down


def setup_inputs(seed: int = 0) -> dict:
    key = jax.random.key(seed)
    ks = list(jax.random.split(key, 48))
    f32 = jnp.float32

    def normal(i, shape, scale):
        return jax.random.normal(ks[i], shape, f32) * scale

    def uniform(i, shape, lo, hi):
        return jax.random.uniform(ks[i], shape, f32, lo, hi)

    def gain(i, shape):
        return 1.0 + normal(i, shape, 0.02)

    ne, no, nl = N_EVEN, N_ODD, DEPTH
    a_decay = uniform(9, (ne, A_WIDTH), 0.9, 0.999)
    b_if = jnp.concatenate([normal(33, (no, C_HEADS), 0.1), uniform(34, (no, C_HEADS), 3.0, 6.0)], axis=-1)
    return {
        'x': normal(0, (BATCH, SEQ, D_MODEL), 1.0),
        'even_norm': gain(1, (ne, D_MODEL)),
        'even_w_in': normal(2, (ne, D_MODEL, EVEN_IN), D_MODEL ** -0.5),
        'a_conv_w': normal(3, (ne, A_CONV, A_WIDTH), A_CONV ** -0.5),
        'a_conv_b': normal(4, (ne, A_WIDTH), 0.01),
        'a_w_r': normal(5, (ne, A_BLOCKS, A_BLOCK, A_BLOCK), A_BLOCK ** -0.5),
        'a_b_r': normal(6, (ne, A_WIDTH), 0.1),
        'a_w_i': normal(7, (ne, A_BLOCKS, A_BLOCK, A_BLOCK), A_BLOCK ** -0.5),
        'a_b_i': normal(8, (ne, A_WIDTH), 0.1),
        'a_lambda': jnp.log(a_decay) - jnp.log1p(-a_decay),
        'b_mu': uniform(10, (ne, B_PROJ), 0.0, 1.0),
        'b_w0': uniform(11, (ne, B_WIDTH), -6.0, 0.0),
        'b_w_up': normal(12, (ne, B_DECAY_RANK, B_WIDTH), 0.5 * B_DECAY_RANK ** -0.5),
        'b_a0': normal(13, (ne, B_WIDTH), 0.1),
        'b_a_up': normal(14, (ne, B_AAA_RANK, B_WIDTH), 0.5 * B_AAA_RANK ** -0.5),
        'b_g_up': normal(15, (ne, B_GATE_RANK, B_WIDTH), B_GATE_RANK ** -0.5),
        'b_k_k': uniform(16, (ne, B_WIDTH), 0.7, 1.0),
        'b_k_a': uniform(17, (ne, B_WIDTH), 0.8, 1.2),
        'b_r_k': normal(18, (ne, B_HEADS, B_HEAD), 0.1),
        'b_ln_w': gain(19, (ne, B_WIDTH)),
        'b_ln_b': normal(20, (ne, B_WIDTH), 0.01),
        'even_w_out': normal(21, (ne, D_MODEL, D_MODEL), D_MODEL ** -0.5),
        'odd_norm': gain(22, (no, D_MODEL)),
        'odd_w_in': normal(23, (no, D_MODEL, 2 * C_WIDTH), D_MODEL ** -0.5),
        'c_conv_w': normal(24, (no, C_CONV, C_WIDTH), C_CONV ** -0.5),
        'c_conv_b': normal(25, (no, C_WIDTH), 0.01),
        'c_w_q': normal(26, (no, C_WIDTH // C_QKV_BLOCK, C_QKV_BLOCK, C_QKV_BLOCK), C_QKV_BLOCK ** -0.5),
        'c_w_k': normal(27, (no, C_WIDTH // C_QKV_BLOCK, C_QKV_BLOCK, C_QKV_BLOCK), C_QKV_BLOCK ** -0.5),
        'c_w_v': normal(28, (no, C_WIDTH // C_QKV_BLOCK, C_QKV_BLOCK, C_QKV_BLOCK), C_QKV_BLOCK ** -0.5),
        'c_w_if': normal(29, (no, 3, C_WIDTH, 2 * C_HEADS), (3 * C_WIDTH) ** -0.5),
        'c_b_if': b_if,
        'c_ln_w': gain(30, (no, C_WIDTH)),
        'c_skip': gain(31, (no, C_WIDTH)),
        'odd_w_out': normal(32, (no, C_WIDTH, D_MODEL), C_WIDTH ** -0.5),
        'ffn_norm': gain(35, (nl, D_MODEL)),
        'ffn_w_gate': normal(36, (nl, D_MODEL, D_FF), D_MODEL ** -0.5),
        'ffn_w_up': normal(37, (nl, D_MODEL, D_FF), D_MODEL ** -0.5),
        'ffn_conv_w': normal(38, (nl, FFN_CONV, D_FF), FFN_CONV ** -0.5),
        'ffn_conv_b': normal(39, (nl, D_FF), 0.01),
        'ffn_w_down': normal(40, (nl, D_FF, D_MODEL), D_FF ** -0.5),
        'final_norm': gain(41, (D_MODEL,)),
    }


def reference(x, even_norm, even_w_in, a_conv_w, a_conv_b, a_w_r, a_b_r, a_w_i, a_b_i, a_lambda,
              b_mu, b_w0, b_w_up, b_a0, b_a_up, b_g_up, b_k_k, b_k_a, b_r_k, b_ln_w, b_ln_b, even_w_out,
              odd_norm, odd_w_in, c_conv_w, c_conv_b, c_w_q, c_w_k, c_w_v, c_w_if, c_b_if, c_ln_w, c_skip, odd_w_out,
              ffn_norm, ffn_w_gate, ffn_w_up, ffn_conv_w, ffn_conv_b, ffn_w_down, final_norm):
    for layer in range(DEPTH):
        if layer % 2 == 0:
            e = layer // 2
            x = rglru_rwkv7_layer(x, even_norm[e], even_w_in[e], a_conv_w[e], a_conv_b[e], a_w_r[e], a_b_r[e],
                                  a_w_i[e], a_b_i[e], a_lambda[e], b_mu[e], b_w0[e], b_w_up[e], b_a0[e], b_a_up[e],
                                  b_g_up[e], b_k_k[e], b_k_a[e], b_r_k[e], b_ln_w[e], b_ln_b[e], even_w_out[e])
        else:
            o = layer // 2
            x = mlstm_layer(x, odd_norm[o], odd_w_in[o], c_conv_w[o], c_conv_b[o], c_w_q[o], c_w_k[o], c_w_v[o],
                            c_w_if[o], c_b_if[o], c_ln_w[o], c_skip[o], odd_w_out[o])
        x = conv_ffn(x, ffn_norm[layer], ffn_w_gate[layer], ffn_w_up[layer], ffn_conv_w[layer],
                     ffn_conv_b[layer], ffn_w_down[layer])
    return rms_norm(x, final_norm)
```

```cpp
#include <hip/hip_runtime.h>
#include <cstdio>
#include <cstdint>
#ifndef MK_N_LAUNCHES
#define MK_N_LAUNCHES 1
#endif
namespace pg8 {
#define PG8_LAS __attribute__((address_space(3)))
typedef unsigned short bf16_t;
typedef short bf16x8 __attribute__((ext_vector_type(8)));
typedef float f32x4 __attribute__((ext_vector_type(4)));
typedef unsigned u32x4 __attribute__((ext_vector_type(4)));
constexpr int BM = 256, BK = 64, HALF = 128, HTB = HALF * BK * 2  , STAGE_BYTES = 8 * HTB, NXCD = 8, WGM = 8;

__host__ __device__ __forceinline__ int lds_byte(int r, int c) { const int st = (r >> 4) * 2 + (c >> 5), rr = r & 15, cc = c & 31, ob = rr * 64 + cc * 2; return st * 1024 + (ob ^ (((ob >> 9) & 1) << 5)); }
__host__ __device__ __forceinline__ void stage_rc(int b, int& R, int& C) { const int st = b / 1024, sb = b % 1024, swz = sb ^ (((sb >> 9) & 1) << 5); R = (st >> 1) * 16 + swz / 64; C = (st & 1) * 32 + (swz % 64) / 2; }
__host__ __device__ __forceinline__ int perm32(int rho) { const int n = rho >> 4, i = rho & 15; return 8 * (i >> 2) + 4 * n + (i & 3); }

struct Unit { int pm, pn; };
struct Gemm { const bf16_t* A; const bf16_t* Bt; int M, N, K; };

struct StaticOrder {
    int nM, nN, nwg, G, c;
    __host__ __device__ void init(int M, int N, int G_, int c_) { nM = M / BM; nN = N / BM; nwg = nM * nN; G = G_; c = c_; }
    __host__ __device__ bool next(int i, Unit& u) const {
        const long L = (long)i * G + c; if (L >= nwg) return false;
        int wgid = (int)L; { const int q = nwg / NXCD, r = nwg % NXCD, xcd = wgid % NXCD, off = wgid / NXCD; wgid = (xcd < r ? xcd * (q + 1) : r * (q + 1) + (xcd - r) * q) + off; }
        const int nig = WGM * nN, gid = wgid / nig, fm = gid * WGM, gsz = (nM - fm) < WGM ? (nM - fm) : WGM;
        u.pm = fm + ((wgid % nig) % gsz); u.pn = (wgid % nig) / gsz; return true;
    }
    __device__ __forceinline__ void a_ready(const Unit&) const {}
    __device__ __forceinline__ void done(const Unit&) const {}
};

typedef float f32x2c __attribute__((ext_vector_type(2))); typedef __bf16 bf16x2c __attribute__((ext_vector_type(2)));
__device__ __forceinline__ unsigned cvt_pk_bf16(float lo, float hi) { const f32x2c v = {lo, hi}; return __builtin_bit_cast(unsigned, __builtin_convertvector(v, bf16x2c)); }
typedef float f32x2 __attribute__((ext_vector_type(2)));
__device__ __forceinline__ f32x2 gelu_pk(f32x2 v) {
    const f32x2 av = __builtin_elementwise_abs(v), d = av * 0.2316418882f + 1.0f;
    f32x2 t; t.x = __builtin_amdgcn_rcpf(d.x); t.y = __builtin_amdgcn_rcpf(d.y);
    f32x2 q = t * 0.5307027145f + (-0.7265760135f); q = q * t + 0.7107068705f; q = q * t + (-0.142248368f); q = q * t + 0.127414796f; q = q * t;
    const f32x2 s = (v * v) * (-0.72134752044f);
    f32x2 e; e.x = __builtin_amdgcn_exp2f(s.x); e.y = __builtin_amdgcn_exp2f(s.y);
    const f32x2 m = v * (q * e), r = v - m;
    f32x2 o; o.x = v.x < 0.f ? m.x : r.x; o.y = v.y < 0.f ? m.y : r.y; return o;
}
template <int ACT  > struct EpiBf16 {
    static constexpr bool PERM = true, AFTER_DRAIN = false; static_assert(ACT == 0 || ACT == 1, "EpiBf16: ACT is 0 (none) or 1 (gelu_pk)");
    bf16_t* O; int ldc; const float* bias; int split_cols; size_t split_stride; float scale0;
    __device__ __forceinline__ void operator()(const f32x4 (&acc)[2][2][4][2], const Unit& u, int wr, int wc, int fr, int fq) const {
        const int row0 = u.pm * BM + wr * 64 + fr; int colt = u.pn * BM; bf16_t* base = O;
        float sc = 1.f; if (split_cols) { const int t = colt / split_cols; base += (size_t)t * split_stride; colt -= t * split_cols; if (t == 0) sc = scale0; }
        const int col0 = colt + wc * 32 + 8 * fq, bcol0 = u.pn * BM + wc * 32 + 8 * fq;
        f32x4 bv[2][2];
#pragma unroll
        for (int bj = 0; bj < 2; ++bj)
#pragma unroll
            for (int n = 0; n < 2; ++n) bv[bj][n] = bias ? *(const f32x4*)(bias + bcol0 + bj * HALF + 4 * n) : (f32x4){0.f, 0.f, 0.f, 0.f};
#pragma unroll
        for (int ai = 0; ai < 2; ++ai)
#pragma unroll
            for (int m = 0; m < 4; ++m) { bf16_t* rowp = base + (size_t)(row0 + ai * HALF + m * 16) * ldc + col0;
#pragma unroll
                for (int bj = 0; bj < 2; ++bj) { f32x4 v0 = acc[ai][bj][m][0] + bv[bj][0], v1 = acc[ai][bj][m][1] + bv[bj][1];
                    if (ACT == 1) { f32x2 a = gelu_pk((f32x2){v0[0], v0[1]}), b = gelu_pk((f32x2){v0[2], v0[3]}), c = gelu_pk((f32x2){v1[0], v1[1]}), d = gelu_pk((f32x2){v1[2], v1[3]});
                        v0 = (f32x4){a.x, a.y, b.x, b.y}; v1 = (f32x4){c.x, c.y, d.x, d.y}; }
                    v0 = v0 * sc; v1 = v1 * sc; u32x4 w; w.x = cvt_pk_bf16(v0[0], v0[1]); w.y = cvt_pk_bf16(v0[2], v0[3]); w.z = cvt_pk_bf16(v1[0], v1[1]); w.w = cvt_pk_bf16(v1[2], v1[3]);
                    *(u32x4*)(rowp + bj * HALF) = w; } }
    }
};
__device__ __forceinline__ float fsigmoid(float x) { return __builtin_amdgcn_rcpf(1.0f + __expf(-x)); }
struct EpiRes {
    static constexpr bool PERM = false, AFTER_DRAIN = false;
    const float* res; float* out; int ldc;
    __device__ __forceinline__ void operator()(const f32x4 (&acc)[2][2][4][2], const Unit& u, int wr, int wc, int fr, int fq) const {
        const int row0 = u.pm * BM + wr * 64 + fr, col0 = u.pn * BM + wc * 32 + 4 * fq;
#pragma unroll
        for (int ai = 0; ai < 2; ++ai)
#pragma unroll
            for (int m = 0; m < 4; ++m) { const size_t off = (size_t)(row0 + ai * HALF + m * 16) * ldc + col0;
#pragma unroll
                for (int bj = 0; bj < 2; ++bj)
#pragma unroll
                    for (int n = 0; n < 2; ++n) { const f32x4 r = *(const f32x4*)(res + off + bj * HALF + n * 16); *(f32x4*)(out + off + bj * HALF + n * 16) = r + acc[ai][bj][m][n]; }
                if (m & 1) asm volatile("" ::: "memory"); }
    }
};
struct EpiLR {
    static constexpr bool PERM = true, AFTER_DRAIN = false;
    bf16_t* O; const float* w0; const float* a0;
    __device__ __forceinline__ void operator()(const f32x4 (&acc)[2][2][4][2], const Unit& u, int wr, int wc, int fr, int fq) const {
        const int row0 = u.pm * BM + wr * 64 + fr, col0 = u.pn * BM + wc * 32 + 8 * fq;
        const int kind = u.pn >> 2;
        const float* bsrc = kind == 0 ? w0 + col0 : a0 + (col0 - 1024);
#pragma unroll
        for (int bj = 0; bj < 2; ++bj) {
            f32x4 bv0 = (f32x4){0.f, 0.f, 0.f, 0.f}, bv1 = bv0;
            if (kind < 2) { bv0 = *(const f32x4*)(bsrc + bj * HALF); bv1 = *(const f32x4*)(bsrc + bj * HALF + 4); }
#pragma unroll
        for (int ai = 0; ai < 2; ++ai)
#pragma unroll
            for (int m = 0; m < 4; ++m) { bf16_t* rowp = O + (size_t)(row0 + ai * HALF + m * 16) * 3072 + col0;
                { f32x4 v0 = acc[ai][bj][m][0] + bv0, v1 = acc[ai][bj][m][1] + bv1;
                    if (kind < 2) {
#pragma unroll
                        for (int j = 0; j < 4; ++j) { v0[j] = fsigmoid(v0[j]); v1[j] = fsigmoid(v1[j]); }
                        if (kind == 0) { v0 = v0 * (-0.60653066f); v1 = v1 * (-0.60653066f); } }
                    u32x4 w; w.x = cvt_pk_bf16(v0[0], v0[1]); w.y = cvt_pk_bf16(v0[2], v0[3]); w.z = cvt_pk_bf16(v1[0], v1[1]); w.w = cvt_pk_bf16(v1[2], v1[3]);
                    *(u32x4*)(rowp + bj * HALF) = w; } }
            asm volatile("" ::: "memory"); }
    }
};
struct EpiZMul {
    static constexpr bool PERM = true, AFTER_DRAIN = false;
    bf16_t* HS; int ldc;
    __device__ __forceinline__ void operator()(const f32x4 (&acc)[2][2][4][2], const Unit& u, int wr, int wc, int fr, int fq) const {
        const int row0 = u.pm * BM + wr * 64 + fr, col0 = u.pn * BM + wc * 32 + 8 * fq;
#pragma unroll
        for (int ai = 0; ai < 2; ++ai)
#pragma unroll
            for (int m = 0; m < 4; ++m) { bf16_t* rowp = HS + (size_t)(row0 + ai * HALF + m * 16) * ldc + col0;
#pragma unroll
                for (int bj = 0; bj < 2; ++bj) { const u32x4 h = *(const u32x4*)(rowp + bj * HALF); f32x4 v0 = acc[ai][bj][m][0], v1 = acc[ai][bj][m][1];
                    float hv[8];
#pragma unroll
                    for (int j = 0; j < 4; ++j) { hv[2 * j] = __uint_as_float(h[j] << 16); hv[2 * j + 1] = __uint_as_float(h[j] & 0xffff0000u); }
#pragma unroll
                    for (int j = 0; j < 4; ++j) { v0[j] = hv[j] * v0[j] * fsigmoid(v0[j]); v1[j] = hv[4 + j] * v1[j] * fsigmoid(v1[j]); }
                    u32x4 w; w.x = cvt_pk_bf16(v0[0], v0[1]); w.y = cvt_pk_bf16(v0[2], v0[3]); w.z = cvt_pk_bf16(v1[0], v1[1]); w.w = cvt_pk_bf16(v1[2], v1[3]);
                    *(u32x4*)(rowp + bj * HALF) = w; } }
    }
};
template <class Epi, class Sched, bool ALIGN_EPI = false, bool SP2 = false>
__device__ __forceinline__ void gemm_phase(PG8_LAS unsigned char* lds, const Gemm g, const Sched& S, const Epi& E) {
    int tid_ = threadIdx.x; asm volatile("" : "+v"(tid_));
    const int tid = tid_, wid = __builtin_amdgcn_readfirstlane(tid >> 6), lane = tid & 63, wr = wid >> 2, wc = wid & 3, fr = lane & 15, fq = lane >> 4;
    const int K = g.K, nt = K / BK;
    unsigned voffA[2], voffB[2];
#pragma unroll
    for (int i = 0; i < 2; ++i) { int R, C; stage_rc(tid * 16 + i * 8192, R, C); const int Rb = Epi::PERM ? ((R & ~31) + perm32(R & 31)) : R;
        voffA[i] = (unsigned)(R * K + C) * 2u; voffB[i] = (unsigned)(Rb * K + C) * 2u; }
    const size_t kstep = (size_t)(BK * 2);
    const size_t hstep = (size_t)HALF * K * 2;
    const size_t tstep = 2 * hstep;
    const unsigned ldsw = (unsigned)wid * 1024u;
    const int aoff = lds_byte(wr * 64 + fr, fq * 8), boff = lds_byte(wc * 32 + fr, fq * 8);
#define PG8_SA(b, h) (((b) * 2 + (h)) * HTB)
#define PG8_SB(b, h) ((4 + (b) * 2 + (h)) * HTB)
#define PG8_STAGE(bufoff, gbase, voff) do { _Pragma("unroll") for (int _i = 0; _i < 2; ++_i) \
        __builtin_amdgcn_global_load_lds((const unsigned*)((const char*)(gbase) + (voff)[_i]), (PG8_LAS unsigned*)(lds + (bufoff) + ldsw + _i * 8192), 16, 0, 0); } while (0)
#define PG8_LDA(dst, b, h) do { _Pragma("unroll") for (int m = 0; m < 4; ++m) _Pragma("unroll") for (int k = 0; k < 2; ++k) dst[m][k] = *(const PG8_LAS bf16x8*)(lds + PG8_SA(b, h) + aoff + m * 2048 + k * 1024); } while (0)
#define PG8_LDB(dst, b, h) do { _Pragma("unroll") for (int n = 0; n < 2; ++n) _Pragma("unroll") for (int k = 0; k < 2; ++k) dst[n][k] = *(const PG8_LAS bf16x8*)(lds + PG8_SB(b, h) + boff + n * 2048 + k * 1024); } while (0)
#define PG8_MMA(ai, bj, At, Bt) do { __builtin_amdgcn_s_setprio(1); _Pragma("unroll") for (int m = 0; m < 4; ++m) _Pragma("unroll") for (int n = 0; n < 2; ++n) _Pragma("unroll") for (int k = 0; k < 2; ++k) \
        acc[ai][bj][m][n] = __builtin_amdgcn_mfma_f32_16x16x32_bf16(Bt[n][k], At[m][k], acc[ai][bj][m][n], 0, 0, 0); __builtin_amdgcn_s_setprio(0); } while (0)
#define PG8_WAIT_V(n) asm volatile("s_waitcnt vmcnt(" #n ")" ::: "memory")
#define PG8_WAIT_L(n) asm volatile("s_waitcnt lgkmcnt(" #n ")" ::: "memory")
#define PG8_BAR __builtin_amdgcn_s_barrier()
#define PG8_SCHED __builtin_amdgcn_sched_barrier(0)
    Unit cur, nxt; int ui = 0;
    if (!S.next(0, cur)) return;
    f32x4 acc[2][2][4][2];
#pragma unroll
    for (int a = 0; a < 2; ++a)
#pragma unroll
        for (int b = 0; b < 2; ++b)
#pragma unroll
            for (int m = 0; m < 4; ++m)
#pragma unroll
                for (int n = 0; n < 2; ++n) acc[a][b][m][n] = (f32x4){0.f, 0.f, 0.f, 0.f};
    bf16x8 At[4][2], B0[2][2], B1[2][2];
    const char* cA = (const char*)g.A + (size_t)cur.pm * tstep; const char* cB = (const char*)g.Bt + (size_t)cur.pn * tstep;
    S.a_ready(cur);
    if constexpr (SP2) {
        PG8_STAGE(PG8_SB(0, 0), cB, voffB); PG8_STAGE(PG8_SB(0, 1), cB + hstep, voffB); PG8_STAGE(PG8_SA(0, 0), cA, voffA); PG8_STAGE(PG8_SA(0, 1), cA + hstep, voffA);
        if (wr == 1) PG8_BAR;
        PG8_WAIT_V(2); PG8_BAR;
        PG8_STAGE(PG8_SB(1, 0), cB + kstep, voffB); PG8_STAGE(PG8_SA(1, 0), cA + kstep, voffA); PG8_STAGE(PG8_SB(1, 1), cB + hstep + kstep, voffB);
        PG8_WAIT_V(6); PG8_BAR;
    } else {
        PG8_STAGE(PG8_SB(0, 0), cB, voffB); PG8_STAGE(PG8_SA(0, 0), cA, voffA); PG8_STAGE(PG8_SB(0, 1), cB + hstep, voffB); PG8_STAGE(PG8_SA(0, 1), cA + hstep, voffA);
        if (wr == 1) PG8_BAR;
        PG8_WAIT_V(4); PG8_BAR;
        PG8_STAGE(PG8_SB(1, 0), cB + kstep, voffB); PG8_STAGE(PG8_SA(1, 0), cA + kstep, voffA); PG8_STAGE(PG8_SB(1, 1), cB + hstep + kstep, voffB);
        PG8_WAIT_V(6); PG8_BAR;
    }
    for (;;) {
        const bool has_next = S.next(ui + 1, nxt);
        const char* nA = has_next ? (const char*)g.A + (size_t)nxt.pm * tstep : cA; const char* nB = has_next ? (const char*)g.Bt + (size_t)nxt.pn * tstep : cB;
        for (int t = 0; t < nt; t += 2) {
            const bool last = (t == nt - 2);
            const char* a1 = cA + (size_t)(t + 1) * kstep;
            const char* a2 = last ? nA : cA + (size_t)(t + 2) * kstep; const char* b2 = last ? nB : cB + (size_t)(t + 2) * kstep;
            const char* a3 = a2 + kstep; const char* b3 = b2 + kstep;
            if (last && has_next) S.a_ready(nxt);
            if constexpr (SP2) {
            PG8_LDB(B0, 0, 0); PG8_LDB(B1, 0, 1); PG8_SCHED; PG8_LDA(At, 0, 0); PG8_STAGE(PG8_SA(1, 1), a1 + hstep, voffA);
            PG8_WAIT_V(8); PG8_WAIT_L(0); PG8_BAR; PG8_MMA(0, 0, At, B0); PG8_MMA(0, 1, At, B1); PG8_BAR; PG8_SCHED;
            PG8_LDA(At, 0, 1); PG8_STAGE(PG8_SB(0, 0), b2, voffB); PG8_STAGE(PG8_SB(0, 1), b2 + hstep, voffB); PG8_STAGE(PG8_SA(0, 0), a2, voffA);
            PG8_WAIT_V(8); PG8_WAIT_L(0); PG8_BAR; PG8_MMA(1, 0, At, B0); PG8_MMA(1, 1, At, B1); PG8_BAR; PG8_SCHED;
            PG8_LDB(B0, 1, 0); PG8_LDB(B1, 1, 1); PG8_SCHED; PG8_LDA(At, 1, 0); PG8_STAGE(PG8_SA(0, 1), a2 + hstep, voffA);
            PG8_WAIT_V(8); PG8_WAIT_L(0); PG8_BAR; PG8_MMA(0, 0, At, B0); PG8_MMA(0, 1, At, B1); PG8_BAR; PG8_SCHED;
            PG8_LDA(At, 1, 1); PG8_STAGE(PG8_SB(1, 0), b3, voffB); PG8_STAGE(PG8_SB(1, 1), b3 + hstep, voffB); PG8_STAGE(PG8_SA(1, 0), a3, voffA);
            PG8_WAIT_V(8); PG8_WAIT_L(0); PG8_BAR; PG8_MMA(1, 0, At, B0); PG8_MMA(1, 1, At, B1); PG8_BAR; PG8_SCHED;
            } else {
            PG8_LDB(B0, 0, 0); PG8_SCHED; PG8_LDA(At, 0, 0); PG8_STAGE(PG8_SA(1, 1), a1 + hstep, voffA);
            PG8_WAIT_L(8); PG8_BAR; PG8_WAIT_L(0); PG8_MMA(0, 0, At, B0); PG8_BAR; PG8_SCHED;
            PG8_LDB(B1, 0, 1); PG8_STAGE(PG8_SB(0, 0), b2, voffB);
            PG8_BAR; PG8_WAIT_L(0); PG8_MMA(0, 1, At, B1); PG8_BAR;
            PG8_LDA(At, 0, 1); PG8_STAGE(PG8_SA(0, 0), a2, voffA);
            PG8_BAR; PG8_WAIT_L(0); PG8_MMA(1, 0, At, B0); PG8_BAR; PG8_SCHED;
            PG8_STAGE(PG8_SB(0, 1), b2 + hstep, voffB);
            PG8_WAIT_V(6); PG8_BAR; PG8_MMA(1, 1, At, B1); PG8_BAR;
            PG8_LDB(B0, 1, 0); PG8_SCHED; PG8_LDA(At, 1, 0); PG8_STAGE(PG8_SA(0, 1), a2 + hstep, voffA);
            PG8_WAIT_L(8); PG8_BAR; PG8_WAIT_L(0); PG8_MMA(0, 0, At, B0); PG8_BAR; PG8_SCHED;
            PG8_LDB(B1, 1, 1); PG8_STAGE(PG8_SB(1, 0), b3, voffB);
            PG8_BAR; PG8_WAIT_L(0); PG8_MMA(0, 1, At, B1); PG8_BAR;
            PG8_LDA(At, 1, 1); PG8_STAGE(PG8_SA(1, 0), a3, voffA);
            PG8_BAR; PG8_WAIT_L(0); PG8_MMA(1, 0, At, B0); PG8_BAR; PG8_SCHED;
            PG8_STAGE(PG8_SB(1, 1), b3 + hstep, voffB);
            PG8_WAIT_V(6); PG8_BAR; PG8_MMA(1, 1, At, B1); PG8_BAR;
            }
        }
        if constexpr (ALIGN_EPI) { if (wr == 0) PG8_BAR; }
        if constexpr (!Epi::AFTER_DRAIN) { E(acc, cur, wr, wc, fr, fq); S.done(cur); }
        if (!has_next) break;
#pragma unroll
        for (int a = 0; a < 2; ++a)
#pragma unroll
            for (int b = 0; b < 2; ++b)
#pragma unroll
                for (int m = 0; m < 4; ++m)
#pragma unroll
                    for (int n = 0; n < 2; ++n) acc[a][b][m][n] = (f32x4){0.f, 0.f, 0.f, 0.f};
        cur = nxt; cA = nA; cB = nB; ++ui;
        if constexpr (ALIGN_EPI) { if (wr == 1) PG8_BAR; }
    }
    PG8_WAIT_V(0);
    if constexpr (!ALIGN_EPI) { if (wr == 0) PG8_BAR; }
    PG8_BAR;
    if constexpr (Epi::AFTER_DRAIN) { E.fused(acc, cur, wr, wc, fr, fq, lds, wid, lane); S.done(cur); }
#undef PG8_SA
#undef PG8_SB
#undef PG8_STAGE
#undef PG8_LDA
#undef PG8_LDB
#undef PG8_MMA
#undef PG8_WAIT_V
#undef PG8_WAIT_L
#undef PG8_BAR
#undef PG8_SCHED
}
}
constexpr int NWAVES = 8, NTHR = 512;
constexpr int BATCH = 8, SEQ = 4096, DM = 2048, M = BATCH * SEQ;
constexpr int EIN = 5408, EIN_PAD = 5632;
constexpr int LRK = 384, LRN = 3072;
constexpr int CW = 4096, CHD = 512;
constexpr int DFF = 5632, GUN = 2 * DFF;
constexpr int MH = M / 2;
constexpr size_t MiB = 1u << 20;
constexpr size_t WS_CTL = 0, CTL_ZERO_BYTES = 128 * 1024;
constexpr size_t WS_W_IN_O = 1 * MiB, WS_W_OUT_O = 33 * MiB, WS_W_GU1 = 49 * MiB, WS_W_DN1 = 93 * MiB;
constexpr size_t WS_SMALL = 115 * MiB;
constexpr size_t WS_W_LR = WS_SMALL, WS_W_RG = WS_SMALL + 5 * MiB / 2, WS_GT = WS_SMALL + 3 * MiB, WS_P4 = WS_SMALL + 13 * MiB / 4, WS_GATES = WS_SMALL + 7 * MiB / 2, WS_LRB = WS_SMALL + 11 * MiB / 2;
constexpr size_t WS_H = 121 * MiB;
constexpr size_t WS_BIG = 249 * MiB;
constexpr size_t WS_PROJ = WS_BIG, WS_LRA = WS_BIG + 352 * MiB, WS_LR = WS_BIG + 376 * MiB;
constexpr size_t WS_GU = WS_BIG, WS_U = WS_BIG + 352 * MiB;
constexpr size_t WS_XM = WS_BIG, WS_XC = WS_BIG + 256 * MiB, WS_KPP = WS_BIG + 512 * MiB;
constexpr size_t WS_W_IN_E = 928 * MiB, WS_W_OUT_E = 950 * MiB, WS_W_GU0 = 958 * MiB, WS_W_DN0 = 1002 * MiB, WS_END = 1024 * MiB;
static_assert(WS_LR + (size_t)M * LRN * 2 <= WS_W_IN_E && WS_U + (size_t)MH * DFF * 2 <= WS_W_IN_E && WS_KPP + (size_t)M * CW * 2 <= WS_END, "d_ws map");
constexpr int LDS_BYTES = 163840, MISC_OFF = LDS_BYTES - 256;

#define GAS __attribute__((address_space(1)))
#define LAS __attribute__((address_space(3)))
typedef unsigned short bf16;
typedef unsigned v4u __attribute__((ext_vector_type(4)));
typedef float f32x4 __attribute__((ext_vector_type(4)));
typedef short bf16x8 __attribute__((ext_vector_type(8)));
typedef GAS unsigned gu32;
typedef GAS unsigned long long gu64;
#define RLX_AGENT __ATOMIC_RELAXED, __HIP_MEMORY_SCOPE_AGENT
#define LDS_WAIT() asm volatile("s_waitcnt lgkmcnt(0)" ::: "memory")
#define VM_WAIT() asm volatile("s_waitcnt vmcnt(0)" ::: "memory")
__device__ __forceinline__ unsigned long long rt() { return __builtin_amdgcn_s_memrealtime(); }
__device__ __forceinline__ unsigned f2bf(float f) { unsigned u = __builtin_bit_cast(unsigned, f); return (u + 0x7fffu + ((u >> 16) & 1u)) >> 16; }
__device__ __forceinline__ unsigned pk2(float lo, float hi) { return f2bf(lo) | (f2bf(hi) << 16); }
#define XB_TMO      128
#define XB_XCNT(j)  (256  + 64 * (j))
#define XB_XSUB(j)  (1280 + 64 * (j))
#define XB_XGEN(j)  (2304 + 64 * (j))
#define XB_TOP      3328
#define XB_TOPGEN   3392
#define XCD_BAR_WORDS 3456
#define XB_SPIN_CAP (1u << 18)

__device__ __forceinline__ unsigned xb_ld(unsigned* p)              { return __hip_atomic_load(p, __ATOMIC_RELAXED, __HIP_MEMORY_SCOPE_AGENT); }
__device__ __forceinline__ unsigned xb_add(unsigned* p, unsigned v) { return __hip_atomic_fetch_add(p, v, __ATOMIC_RELAXED, __HIP_MEMORY_SCOPE_AGENT); }
__device__ __forceinline__ unsigned xb_xcc_id() { return (unsigned)__builtin_amdgcn_s_getreg((3 << 11) | 20) & 0xFu; }
#define XB_SPIN(cond, bar) do { unsigned _sp = 0; while (cond) { __builtin_amdgcn_s_sleep(1); \
    if ((++_sp & 255u) == 0u) { if (xb_ld(&(bar)[XB_TMO])) break; if (_sp > XB_SPIN_CAP) { atomicAdd(&(bar)[XB_TMO], 1u); break; } } } } while (0)

struct XcdBarrier {
    unsigned* bar; unsigned x;
    volatile LAS unsigned* st;
};

__device__ __forceinline__ XcdBarrier xcd_barrier_post(unsigned* bar, volatile LAS unsigned* st) {
    XcdBarrier b; b.bar = bar; b.x = xb_xcc_id(); b.st = st;
    if (threadIdx.x == 0) (void)xb_add(&bar[XB_XCNT(b.x)], 1u);
    return b;
}
__device__ __forceinline__ void xcd_barrier_complete(unsigned* bar, unsigned x, unsigned& nloc, unsigned& nx) {
    const unsigned G = gridDim.x * gridDim.y * gridDim.z;
    unsigned sum, cnt, mine, sp = 0u;
    for (;;) {
        sum = 0u; cnt = 0u; mine = 0u;
#pragma unroll
        for (unsigned j = 0; j < 16; ++j) { const unsigned c = xb_ld(&bar[XB_XCNT(j)]); sum += c; cnt += (c > 0u) ? 1u : 0u; mine = (j == x) ? c : mine; }
        if (sum == G) break;
        __builtin_amdgcn_s_sleep(1);
        if ((++sp & 255u) == 0u) { if (xb_ld(&bar[XB_TMO])) break; if (sp > XB_SPIN_CAP) { atomicAdd(&bar[XB_TMO], 1u); break; } }
    }
    nloc = mine > 0u ? mine : 1u; nx = cnt > 0u ? cnt : 1u;
}

__device__ __forceinline__ void xcd_barrier(const XcdBarrier& b) {
    asm volatile("s_waitcnt vmcnt(0)" ::: "memory");
    __syncthreads();
    if (threadIdx.x == 0) {
        unsigned* bar = b.bar;
        __builtin_amdgcn_s_waitcnt(0);
        unsigned nloc = b.st[0], nx = b.st[1];
        if (nloc == 0u) { xcd_barrier_complete(bar, b.x, nloc, nx); b.st[0] = nloc; b.st[1] = nx; }
        const unsigned old = xb_add(&bar[XB_XSUB(b.x)], 1u);
        const unsigned gen = old / nloc;
        if (old + 1u == (gen + 1u) * nloc) {
            __builtin_amdgcn_fence(__ATOMIC_RELEASE, "agent");
            asm volatile("s_waitcnt vmcnt(0)" ::: "memory");
            const unsigned og = xb_add(&bar[XB_TOP], 1u);
            const unsigned tg = og / nx;
            if (og + 1u == (tg + 1u) * nx) xb_add(&bar[XB_TOPGEN], 1u);
            else XB_SPIN(xb_ld(&bar[XB_TOPGEN]) == tg, bar);
            __builtin_amdgcn_fence(__ATOMIC_ACQUIRE, "agent");
            xb_add(&bar[XB_XGEN(b.x)], 1u);
            asm volatile("s_waitcnt vmcnt(0)" ::: "memory");
        } else {
            XB_SPIN(xb_ld(&bar[XB_XGEN(b.x)]) == gen, bar);
            __builtin_amdgcn_fence(__ATOMIC_ACQUIRE, "agent");
            asm volatile("s_waitcnt vmcnt(0)" ::: "memory");
        }
    }
    __syncthreads();
}

typedef float f32x2 __attribute__((ext_vector_type(2)));
typedef short s16x4 __attribute__((ext_vector_type(4)));
typedef unsigned v2u __attribute__((ext_vector_type(2)));
struct Frame {
    LAS unsigned char* lds;
    int tid, lane, wave, G, gw, NGW;
};
__device__ __forceinline__ float wave_sum(float v) {
#pragma unroll
    for (int o = 1; o < 64; o <<= 1) v += __shfl_xor(v, o);
    return v;
}
__device__ __forceinline__ float bflo(unsigned w) { return __uint_as_float(w << 16); }
__device__ __forceinline__ float bfhi(unsigned w) { return __uint_as_float(w & 0xffff0000u); }
__device__ __forceinline__ float bf1(unsigned short b) { return __uint_as_float(((unsigned)b) << 16); }
__device__ __forceinline__ unsigned cvtpk(float lo, float hi) { return pg8::cvt_pk_bf16(lo, hi); }
__device__ __forceinline__ float fsig(float x) { return __builtin_amdgcn_rcpf(1.0f + __expf(-x)); }
__device__ __forceinline__ float fsilu(float x) { return x * fsig(x); }
__device__ __forceinline__ float ftanh(float x) { const float xc = fminf(fmaxf(x, -15.f), 15.f); const float t = __expf(2.f * xc); return (t - 1.f) * __builtin_amdgcn_rcpf(t + 1.f); }
__device__ __forceinline__ float fgelu_tanh(float x) { return 0.5f * x * (1.f + ftanh(0.7978845608f * (x + 0.044715f * x * x * x))); }

__device__ __forceinline__ void p0_transpose_item(const float* W, int K, int N, bf16* WT, int drow, LAS float* scr, int kb, int n0, int lane) {
    const int k0 = 64 * kb;
#pragma unroll 8
    for (int i = 0; i < 32; ++i) { const int kk = 2 * i + (lane >> 5); scr[kk * 33 + (lane & 31)] = W[(size_t)(k0 + kk) * N + n0 + (lane & 31)]; }
    LDS_WAIT(); asm volatile("" ::: "memory");
    const int c = lane & 7;
#pragma unroll
    for (int j = 0; j < 4; ++j) { const int n = (lane >> 3) + 8 * j; const LAS float* s = scr + (8 * c) * 33 + n;
        v4u o; o.x = pk2(s[0 * 33], s[1 * 33]); o.y = pk2(s[2 * 33], s[3 * 33]); o.z = pk2(s[4 * 33], s[5 * 33]); o.w = pk2(s[6 * 33], s[7 * 33]);
        *(GAS v4u*)(WT + (size_t)(drow + n) * K + k0 + 8 * c) = o; }
    LDS_WAIT(); asm volatile("" ::: "memory");
}
__device__ __forceinline__ void p0_matrix(Frame& F, const float* W, int K, int N, bf16* WT, int mode, LAS float* scr) {
    const int nblk = N / 32, items = (K / 64) * nblk;
    for (int it = F.gw; it < items; it += F.NGW) {
        const int kb = it / nblk, n0 = 32 * (it % nblk);
        const int drow = mode == 0 ? n0 : (256 * (n0 >> 7) + (n0 & 127) + (mode == 2 ? 128 : 0));
        p0_transpose_item(W, K, N, WT, drow, scr, kb, n0, F.lane);
    }
}
struct Ptrs {
    const float* in[41]; float* out; unsigned char* ws;
};
#define IN_X 0
#define IN_EVEN_NORM 1
#define IN_EVEN_W_IN 2
#define IN_A_CONV_W 3
#define IN_A_CONV_B 4
#define IN_A_W_R 5
#define IN_A_B_R 6
#define IN_A_W_I 7
#define IN_A_B_I 8
#define IN_A_LAMBDA 9
#define IN_B_MU 10
#define IN_B_W0 11
#define IN_B_W_UP 12
#define IN_B_A0 13
#define IN_B_A_UP 14
#define IN_B_G_UP 15
#define IN_B_K_K 16
#define IN_B_K_A 17
#define IN_B_R_K 18
#define IN_B_LN_W 19
#define IN_B_LN_B 20
#define IN_EVEN_W_OUT 21
#define IN_ODD_NORM 22
#define IN_ODD_W_IN 23
#define IN_C_CONV_W 24
#define IN_C_CONV_B 25
#define IN_C_W_Q 26
#define IN_C_W_K 27
#define IN_C_W_V 28
#define IN_C_W_IF 29
#define IN_C_B_IF 30
#define IN_C_LN_W 31
#define IN_C_SKIP 32
#define IN_ODD_W_OUT 33
#define IN_FFN_NORM 34
#define IN_FFN_W_GATE 35
#define IN_FFN_W_UP 36
#define IN_FFN_CONV_W 37
#define IN_FFN_CONV_B 38
#define IN_FFN_W_DOWN 39
#define IN_FINAL_NORM 40

__device__ __forceinline__ void ph_prologue(Frame& F, const Ptrs& P) {
    LAS float* scr = (LAS float*)(F.lds + F.wave * 16384);
    unsigned char* ws = P.ws;
    p0_matrix(F, P.in[IN_EVEN_W_IN], DM, EIN, (bf16*)(ws + WS_W_IN_E), 0, scr);
    p0_matrix(F, P.in[IN_EVEN_W_OUT], DM, DM, (bf16*)(ws + WS_W_OUT_E), 0, scr);
    p0_matrix(F, P.in[IN_FFN_W_GATE], DM, DFF, (bf16*)(ws + WS_W_GU0), 1, scr);
    p0_matrix(F, P.in[IN_FFN_W_UP], DM, DFF, (bf16*)(ws + WS_W_GU0), 2, scr);
    p0_matrix(F, P.in[IN_FFN_W_DOWN], DFF, DM, (bf16*)(ws + WS_W_DN0), 0, scr);
    p0_matrix(F, P.in[IN_FFN_W_GATE] + (size_t)DM * DFF, DM, DFF, (bf16*)(ws + WS_W_GU1), 1, scr);
    p0_matrix(F, P.in[IN_FFN_W_UP] + (size_t)DM * DFF, DM, DFF, (bf16*)(ws + WS_W_GU1), 2, scr);
    p0_matrix(F, P.in[IN_FFN_W_DOWN] + (size_t)DFF * DM, DFF, DM, (bf16*)(ws + WS_W_DN1), 0, scr);
    p0_matrix(F, P.in[IN_ODD_W_IN], DM, 2 * CW, (bf16*)(ws + WS_W_IN_O), 0, scr);
    p0_matrix(F, P.in[IN_ODD_W_OUT], CW, DM, (bf16*)(ws + WS_W_OUT_O), 0, scr);
    const size_t gt = (size_t)F.gw * 64 + F.lane, GT = (size_t)F.NGW * 64;
    { v4u* z = (v4u*)(ws + WS_W_IN_E + (size_t)EIN * DM * 2); const size_t n = (size_t)(EIN_PAD - EIN) * DM * 2 / 16; for (size_t i = gt; i < n; i += GT) z[i] = (v4u){0u, 0u, 0u, 0u}; }
    { bf16* B = (bf16*)(ws + WS_W_LR); const float* wup = P.in[IN_B_W_UP]; const float* aup = P.in[IN_B_A_UP]; const float* gup = P.in[IN_B_G_UP];
      for (size_t i = gt; i < (size_t)LRN * LRK; i += GT) { const int n = (int)(i / LRK), k = (int)(i % LRK); float v = 0.f;
          if (n < 1024) { if (k < 64) v = wup[(size_t)k * 1024 + n]; }
          else if (n < 2048) { if (k >= 64 && k < 128) v = aup[(size_t)(k - 64) * 1024 + (n - 1024)]; }
          else { if (k >= 128 && k < 288) v = gup[(size_t)(k - 128) * 1024 + (n - 2048)]; }
          B[i] = (bf16)f2bf(v); } }
    { float* lb = (float*)(ws + WS_LRB); for (size_t i = gt; i < (size_t)LRN; i += GT) lb[i] = i < 1024 ? P.in[IN_B_W0][i] : (i < 2048 ? P.in[IN_B_A0][i - 1024] : 0.f); }
    { bf16* B = (bf16*)(ws + WS_W_RG); const float* wr = P.in[IN_A_W_R]; const float* wi = P.in[IN_A_W_I];
      for (size_t i = gt; i < (size_t)2 * 8 * 128 * 128; i += GT) { const int which = (int)(i >> 17), g = (int)((i >> 14) & 7), n = (int)((i >> 7) & 127), k = (int)(i & 127);
          const float* w = which ? wi : wr; B[i] = (bf16)f2bf(w[((size_t)g * 128 + k) * 128 + n]); } }
    { float* P4 = (float*)(ws + WS_P4); const float* wq = P.in[IN_C_W_Q]; const float* wk = P.in[IN_C_W_K];
      for (size_t i = gt; i < (size_t)1024 * 16; i += GT) { const int j = (int)(i >> 4), b = (int)((i >> 2) & 3), ii = (int)(i & 3); float s = 0.f;
#pragma unroll
          for (int a = 0; a < 4; ++a) s += wk[j * 16 + b * 4 + a] * wq[j * 16 + ii * 4 + a];
          P4[i] = s * 0.04419417382f; } }
    { bf16* Gt = (bf16*)(ws + WS_GT); const float* wq = P.in[IN_C_W_Q]; const float* wk = P.in[IN_C_W_K]; const float* wv = P.in[IN_C_W_V]; const float* wif = P.in[IN_C_W_IF];
      for (size_t i = gt; i < (size_t)16 * 8192; i += GT) { const int g = (int)(i >> 13), kidx = (int)(i & 8191), c = kidx & 4095, j = c >> 2, ii = c & 3; float s = 0.f;
          if (kidx < 4096) {
#pragma unroll
              for (int a = 0; a < 4; ++a) s += wq[j * 16 + ii * 4 + a] * wif[((size_t)0 * CW + 4 * j + a) * 16 + g] + wk[j * 16 + ii * 4 + a] * wif[((size_t)1 * CW + 4 * j + a) * 16 + g];
          } else {
#pragma unroll
              for (int a = 0; a < 4; ++a) s += wv[j * 16 + ii * 4 + a] * wif[((size_t)2 * CW + 4 * j + a) * 16 + g];
          }
          Gt[i] = (bf16)f2bf(s); } }
}
__device__ __forceinline__ void ph_rmsnorm_bf16(Frame& F, const float* src, const float* gain, bf16* dst) {
    for (int m = F.gw; m < M; m += F.NGW) {
        const GAS f32x4* xr = (const GAS f32x4*)(src + (size_t)m * DM) + F.lane;
        f32x4 v[8]; float s = 0.f;
#pragma unroll
        for (int j = 0; j < 8; ++j) { v[j] = xr[64 * j]; s += (v[j].x * v[j].x + v[j].y * v[j].y) + (v[j].z * v[j].z + v[j].w * v[j].w); }
        const float rstd = rsqrtf(wave_sum(s) * (1.f / DM) + 1e-6f);
        GAS v2u* o8 = (GAS v2u*)(dst + (size_t)m * DM) + F.lane;
#pragma unroll
        for (int j = 0; j < 8; ++j) { const f32x4 g = ((const GAS f32x4*)gain)[F.lane + 64 * j];
            v2u o; o.x = cvtpk(v[j].x * rstd * g.x, v[j].y * rstd * g.y); o.y = cvtpk(v[j].z * rstd * g.z, v[j].w * rstd * g.w); o8[64 * j] = o; }
    }
}
__device__ __forceinline__ void ph_rmsnorm_f32_inplace(Frame& F, float* x, const float* gain) {
    for (int m = F.gw; m < M; m += F.NGW) {
        GAS f32x4* xr = (GAS f32x4*)(x + (size_t)m * DM) + F.lane;
        f32x4 v[8]; float s = 0.f;
#pragma unroll
        for (int j = 0; j < 8; ++j) { v[j] = xr[64 * j]; s += (v[j].x * v[j].x + v[j].y * v[j].y) + (v[j].z * v[j].z + v[j].w * v[j].w); }
        const float rstd = rsqrtf(wave_sum(s) * (1.f / DM) + 1e-6f);
#pragma unroll
        for (int j = 0; j < 8; ++j) { const f32x4 g = ((const GAS f32x4*)gain)[F.lane + 64 * j]; xr[64 * j] = v[j] * rstd * g; }
    }
}
__device__ __forceinline__ void ph_lra(Frame& F, const Ptrs& P) {
    const bf16* proj = (const bf16*)(P.ws + WS_PROJ); bf16* lra = (bf16*)(P.ws + WS_LRA); const float* mu = P.in[IN_B_MU];
    const size_t gt = (size_t)F.gw * 64 + F.lane, GT = (size_t)F.NGW * 64;
    for (size_t i = gt; i < (size_t)M * 48; i += GT) {
        const int m = (int)(i / 48), g8 = (int)(i % 48), c0 = 8 * g8; v4u o = (v4u){0u, 0u, 0u, 0u};
        if (c0 < 288) {
            const v4u cur = *(const GAS v4u*)(proj + (size_t)m * EIN_PAD + 5120 + c0);
            v4u prv = (v4u){0u, 0u, 0u, 0u}; if ((m & (SEQ - 1)) != 0) prv = *(const GAS v4u*)(proj + (size_t)(m - 1) * EIN_PAD + 5120 + c0);
            const f32x4 mu0 = *(const GAS f32x4*)(mu + 3072 + c0), mu1 = *(const GAS f32x4*)(mu + 3072 + c0 + 4);
            float v[8];
#pragma unroll
            for (int j = 0; j < 4; ++j) { const float c_lo = bflo(cur[j]), c_hi = bfhi(cur[j]), p_lo = bflo(prv[j]), p_hi = bfhi(prv[j]);
                const float m_lo = (2 * j < 4) ? mu0[2 * j] : mu1[2 * j - 4], m_hi = (2 * j + 1 < 4) ? mu0[2 * j + 1] : mu1[2 * j + 1 - 4];
                v[2 * j] = c_lo + (p_lo - c_lo) * m_lo; v[2 * j + 1] = c_hi + (p_hi - c_hi) * m_hi; }
#pragma unroll
            for (int j = 0; j < 8; ++j) v[j] = c0 < 64 ? ftanh(v[j]) : (c0 < 128 ? v[j] : fsig(v[j]));
            o.x = cvtpk(v[0], v[1]); o.y = cvtpk(v[2], v[3]); o.z = cvtpk(v[4], v[5]); o.w = cvtpk(v[6], v[7]);
        }
        *(GAS v4u*)(lra + (size_t)m * LRK + c0) = o;
    }
}
__device__ __forceinline__ void ph_ffn_act(Frame& F, const bf16* gu, bf16* u, const float* cw, const float* cb) {
    const size_t gt = (size_t)F.gw * 64 + F.lane, GT = (size_t)F.NGW * 64;
    for (size_t i = gt; i < (size_t)MH * (DFF / 8); i += GT) {
        const int r = (int)(i / (DFF / 8)), c0 = 8 * (int)(i % (DFF / 8)), t = r & (SEQ - 1);
        const size_t gcol = (size_t)256 * (c0 >> 7) + (c0 & 127);
        const bf16* gp = gu + (size_t)r * GUN + gcol;
        const v4u g2 = *(const GAS v4u*)gp, up = *(const GAS v4u*)(gp + 128);
        v4u g1 = (v4u){0u, 0u, 0u, 0u}, g0 = (v4u){0u, 0u, 0u, 0u};
        if (t >= 1) g1 = *(const GAS v4u*)(gp - GUN);
        if (t >= 2) g0 = *(const GAS v4u*)(gp - 2 * (size_t)GUN);
        float o[8];
#pragma unroll
        for (int j = 0; j < 8; ++j) { const int c = c0 + j; const unsigned a0 = g0[j >> 1], a1 = g1[j >> 1], a2 = g2[j >> 1], uu = up[j >> 1];
            const float x0 = (j & 1) ? bfhi(a0) : bflo(a0), x1 = (j & 1) ? bfhi(a1) : bflo(a1), x2 = (j & 1) ? bfhi(a2) : bflo(a2), uv = (j & 1) ? bfhi(uu) : bflo(uu);
            const float pre = cb[c] + cw[c] * x0 + cw[DFF + c] * x1 + cw[2 * DFF + c] * x2;
            o[j] = fsilu(pre) * uv; }
        v4u w; w.x = cvtpk(o[0], o[1]); w.y = cvtpk(o[2], o[3]); w.z = cvtpk(o[4], o[5]); w.w = cvtpk(o[6], o[7]);
        *(GAS v4u*)(u + (size_t)r * DFF + c0) = w;
    }
}

constexpr int RW_R = 0, RW_W = 16384, RW_K = 32768, RW_A = 49152, RW_B = 65536, RW_V = 81920, RW_Y = 98304, RW_BONUS = 114688;
__device__ __forceinline__ void rwkv_unit(Frame& F, const Ptrs& P, int unit) {
    const int b = unit >> 4, h = unit & 15, col = h * 64 + F.lane;
    const bf16* proj = (const bf16*)(P.ws + WS_PROJ); const bf16* lr = (const bf16*)(P.ws + WS_LR); bf16* ycat = (bf16*)(P.ws + WS_H);
    const float* mu = P.in[IN_B_MU];
    const float mu_r = mu[col], mu_k = mu[1024 + col], mu_v = mu[2048 + col];
    const float k_k = P.in[IN_B_K_K][col], k_a = P.in[IN_B_K_A][col], r_k = P.in[IN_B_R_K][col], ln_w = P.in[IN_B_LN_W][col], ln_b = P.in[IN_B_LN_B][col];
    LAS float* Rb = (LAS float*)(F.lds + RW_R); LAS float* Wb = (LAS float*)(F.lds + RW_W); LAS float* Kb = (LAS float*)(F.lds + RW_K);
    LAS float* Ab = (LAS float*)(F.lds + RW_A); LAS float* Bb = (LAS float*)(F.lds + RW_B); LAS float* Vb = (LAS float*)(F.lds + RW_V);
    LAS float* Yb = (LAS float*)(F.lds + RW_Y); LAS float* Bon = (LAS float*)(F.lds + RW_BONUS);
    float s[64];
#pragma unroll
    for (int k = 0; k < 64; ++k) s[k] = 0.f;
    for (int ch = 0; ch < SEQ / 64; ++ch) {
        const int t0 = ch * 64;
#pragma unroll 2
        for (int i = 0; i < 8; ++i) {
            const int tt = F.wave * 8 + i, t = t0 + tt; const size_t m = (size_t)b * SEQ + t;
            const bf16* pr = proj + m * EIN_PAD + 2048 + col;
            float r = bf1(pr[0]), k = bf1(pr[1024]), v = bf1(pr[2048]);
            float rp = 0.f, kp = 0.f, vp = 0.f;
            if (t > 0) { rp = bf1(pr[-EIN_PAD]); kp = bf1(pr[1024 - EIN_PAD]); vp = bf1(pr[2048 - EIN_PAD]); }
            r += (rp - r) * mu_r; k += (kp - k) * mu_k; v += (vp - v) * mu_v;
            const float lw = -0.60653066f * fsig(bf1(lr[m * LRN + col])), a = fsig(bf1(lr[m * LRN + 1024 + col]));
            float kk = k * k_k; const float ss = wave_sum(kk * kk); kk *= rsqrtf(fmaxf(ss, 1e-12f));
            const float kq = k * (1.f + (a - 1.f) * k_a);
            Rb[tt * 64 + F.lane] = r; Wb[tt * 64 + F.lane] = __expf(lw); Kb[tt * 64 + F.lane] = kq; Ab[tt * 64 + F.lane] = -kk; Bb[tt * 64 + F.lane] = kk * a; Vb[tt * 64 + F.lane] = v;
            const float bo = wave_sum(r * kq * r_k); if (F.lane == 0) Bon[tt] = bo;
        }
        __syncthreads();
        if (F.wave == 0) {
            for (int tt = 0; tt < 64; ++tt) {
                const LAS f32x4* A4 = (const LAS f32x4*)(Ab + tt * 64); const LAS f32x4* W4 = (const LAS f32x4*)(Wb + tt * 64); const LAS f32x4* B4 = (const LAS f32x4*)(Bb + tt * 64);
                const LAS f32x4* K4 = (const LAS f32x4*)(Kb + tt * 64); const LAS f32x4* R4 = (const LAS f32x4*)(Rb + tt * 64);
                float sa0 = 0.f, sa1 = 0.f, sa2 = 0.f, sa3 = 0.f;
#pragma unroll
                for (int q = 0; q < 16; ++q) { const f32x4 a = A4[q]; sa0 += s[4 * q] * a.x; sa1 += s[4 * q + 1] * a.y; sa2 += s[4 * q + 2] * a.z; sa3 += s[4 * q + 3] * a.w; }
                const float sa = (sa0 + sa1) + (sa2 + sa3), vv = Vb[tt * 64 + F.lane];
                float y0 = 0.f, y1 = 0.f, y2 = 0.f, y3 = 0.f;
#pragma unroll
                for (int q = 0; q < 16; ++q) { const f32x4 w = W4[q], bb = B4[q], kk = K4[q], rr = R4[q];
                    s[4 * q] = s[4 * q] * w.x + sa * bb.x + vv * kk.x; s[4 * q + 1] = s[4 * q + 1] * w.y + sa * bb.y + vv * kk.y;
                    s[4 * q + 2] = s[4 * q + 2] * w.z + sa * bb.z + vv * kk.z; s[4 * q + 3] = s[4 * q + 3] * w.w + sa * bb.w + vv * kk.w;
                    y0 += s[4 * q] * rr.x; y1 += s[4 * q + 1] * rr.y; y2 += s[4 * q + 2] * rr.z; y3 += s[4 * q + 3] * rr.w; }
                Yb[tt * 64 + F.lane] = (y0 + y1) + (y2 + y3);
            }
        }
        __syncthreads();
#pragma unroll 2
        for (int i = 0; i < 8; ++i) {
            const int tt = F.wave * 8 + i; const size_t m = (size_t)b * SEQ + t0 + tt;
            const float y = Yb[tt * 64 + F.lane]; const float mean = wave_sum(y) * (1.f / 64.f); const float d = y - mean; const float var = wave_sum(d * d) * (1.f / 64.f);
            float o = d * rsqrtf(var + 64e-5f) * ln_w + ln_b; o += Bon[tt] * Vb[tt * 64 + F.lane];
            o *= bf1(lr[m * LRN + 2048 + col]);
            ycat[m * DM + 1024 + col] = (bf16)f2bf(o);
        }
        __syncthreads();
    }
}
constexpr int RG_XCB = 0, RG_XCF = 20480, RG_A = 53248, RG_U = 86016;
__device__ __forceinline__ void rglru_unit(Frame& F, const Ptrs& P, int unit) {
    const int b = unit >> 3, blk = unit & 7, cb0 = blk * 128;
    const bf16* proj = (const bf16*)(P.ws + WS_PROJ); bf16* ycat = (bf16*)(P.ws + WS_H);
    const float* cw = P.in[IN_A_CONV_W]; const float* cbias = P.in[IN_A_CONV_B];
    const int r16 = F.lane & 15, g4 = F.lane >> 4;
    LAS bf16* XCB = (LAS bf16*)(F.lds + RG_XCB); LAS float* XCF = (LAS float*)(F.lds + RG_XCF); LAS float* AB = (LAS float*)(F.lds + RG_A); LAS float* UB = (LAS float*)(F.lds + RG_U);
    const bf16* wrg = (const bf16*)(P.ws + WS_W_RG);
    pg8::bf16x8 Br[4], Bi[4];
#pragma unroll
    for (int ks = 0; ks < 4; ++ks) { const size_t o = ((size_t)blk * 128 + 16 * F.wave + r16) * 128 + 32 * ks + 8 * g4;
        Br[ks] = *(const pg8::bf16x8*)(wrg + o); Bi[ks] = *(const pg8::bf16x8*)(wrg + (size_t)8 * 128 * 128 + o); }
    const int cn = cb0 + 16 * F.wave + r16;
    const float b_r = P.in[IN_A_B_R][cn], b_i = P.in[IN_A_B_I][cn];
    const float lam = P.in[IN_A_LAMBDA][cn]; const float sp8 = 8.f * log1pf(expf(-lam));
    float hcar = 0.f;
    const int ct = (F.tid & 7) * 16, tr = F.tid >> 3;
    for (int ch = 0; ch < SEQ / 64; ++ch) {
        const int t0 = ch * 64;
        {
            const int t = t0 + tr; const size_t m = (size_t)b * SEQ + t;
            float acc[16];
#pragma unroll
            for (int j = 0; j < 16; ++j) acc[j] = cbias[cb0 + ct + j];
#pragma unroll
            for (int jj = 0; jj < 4; ++jj) { const int ts = t - 3 + jj; if (ts >= 0) {
                const v4u x0 = *(const GAS v4u*)(proj + (m - 3 + jj) * EIN_PAD + cb0 + ct), x1 = *(const GAS v4u*)(proj + (m - 3 + jj) * EIN_PAD + cb0 + ct + 8);
                const float* w = cw + jj * 1024 + cb0 + ct;
#pragma unroll
                for (int j = 0; j < 4; ++j) { acc[2 * j] += w[2 * j] * bflo(x0[j]); acc[2 * j + 1] += w[2 * j + 1] * bfhi(x0[j]); acc[8 + 2 * j] += w[8 + 2 * j] * bflo(x1[j]); acc[8 + 2 * j + 1] += w[8 + 2 * j + 1] * bfhi(x1[j]); } } }
#pragma unroll
            for (int j = 0; j < 16; ++j) XCF[tr * 128 + ct + j] = acc[j];
            v4u p0, p1; p0.x = cvtpk(acc[0], acc[1]); p0.y = cvtpk(acc[2], acc[3]); p0.z = cvtpk(acc[4], acc[5]); p0.w = cvtpk(acc[6], acc[7]);
            p1.x = cvtpk(acc[8], acc[9]); p1.y = cvtpk(acc[10], acc[11]); p1.z = cvtpk(acc[12], acc[13]); p1.w = cvtpk(acc[14], acc[15]);
            *(LAS v4u*)(XCB + tr * 136 + ct) = p0; *(LAS v4u*)(XCB + tr * 136 + ct + 8) = p1;
        }
        __syncthreads();
        {
#pragma unroll
            for (int mt = 0; mt < 4; ++mt) {
                pg8::f32x4 ar = {0.f, 0.f, 0.f, 0.f}, ai = {0.f, 0.f, 0.f, 0.f};
#pragma unroll
                for (int ks = 0; ks < 4; ++ks) { const pg8::bf16x8 a = *(const LAS pg8::bf16x8*)(XCB + (16 * mt + r16) * 136 + 32 * ks + 8 * g4);
                    ar = __builtin_amdgcn_mfma_f32_16x16x32_bf16(a, Br[ks], ar, 0, 0, 0); ai = __builtin_amdgcn_mfma_f32_16x16x32_bf16(a, Bi[ks], ai, 0, 0, 0); }
#pragma unroll
                for (int rg = 0; rg < 4; ++rg) { const int tt = 16 * mt + 4 * g4 + rg, cl = 16 * F.wave + r16;
                    const float rr = fsig(ar[rg] + b_r), ii = fsig(ai[rg] + b_i); const float la = -sp8 * rr; const float a = __expf(la);
                    const float mult = sqrtf(fmaxf(-expm1f(2.f * la), 0.f));
                    AB[tt * 128 + cl] = a; UB[tt * 128 + cl] = mult * ii * XCF[tt * 128 + cl]; }
            }
        }
        __syncthreads();
        if (F.tid < 128) {
#pragma unroll 8
            for (int tt = 0; tt < 64; ++tt) { hcar = AB[tt * 128 + F.tid] * hcar + UB[tt * 128 + F.tid]; UB[tt * 128 + F.tid] = hcar; }
        }
        __syncthreads();
        {
            const size_t m = (size_t)b * SEQ + t0 + tr;
            const v4u g0 = *(const GAS v4u*)(proj + m * EIN_PAD + 1024 + cb0 + ct), g1 = *(const GAS v4u*)(proj + m * EIN_PAD + 1024 + cb0 + ct + 8);
            float o[16];
#pragma unroll
            for (int j = 0; j < 4; ++j) { o[2 * j] = bflo(g0[j]); o[2 * j + 1] = bfhi(g0[j]); o[8 + 2 * j] = bflo(g1[j]); o[8 + 2 * j + 1] = bfhi(g1[j]); }
#pragma unroll
            for (int j = 0; j < 16; ++j) o[j] = UB[tr * 128 + ct + j] * fgelu_tanh(o[j]);
            v4u p0, p1; p0.x = cvtpk(o[0], o[1]); p0.y = cvtpk(o[2], o[3]); p0.z = cvtpk(o[4], o[5]); p0.w = cvtpk(o[6], o[7]);
            p1.x = cvtpk(o[8], o[9]); p1.y = cvtpk(o[10], o[11]); p1.z = cvtpk(o[12], o[13]); p1.w = cvtpk(o[14], o[15]);
            *(GAS v4u*)(ycat + m * DM + cb0 + ct) = p0; *(GAS v4u*)(ycat + m * DM + cb0 + ct + 8) = p1;
        }
    }
}

__device__ __forceinline__ void ph_mlstm_pre(Frame& F, const Ptrs& P) {
    const bf16* xm = (const bf16*)(P.ws + WS_XM); bf16* xc = (bf16*)(P.ws + WS_XC); bf16* kpp = (bf16*)(P.ws + WS_KPP);
    const bf16* Gt = (const bf16*)(P.ws + WS_GT); const float* P4 = (const float*)(P.ws + WS_P4); float* gates = (float*)(P.ws + WS_GATES);
    const float* cw = P.in[IN_C_CONV_W]; const float* cbias = P.in[IN_C_CONV_B];
    const int r = F.lane & 15, g = F.lane >> 4;
    for (int tile = F.gw; tile < M / 16; tile += F.NGW) {
        const int m = tile * 16 + r, t = m & (SEQ - 1);
        pg8::f32x4 acc = {0.f, 0.f, 0.f, 0.f};
        const bf16* xrow = xm + (size_t)m * CW;
#pragma unroll 2
        for (int s = 0; s < 128; ++s) {
            const int c0 = 32 * s + 8 * g;
            v4u x[4];
#pragma unroll
            for (int jj = 0; jj < 4; ++jj) { x[jj] = (v4u){0u, 0u, 0u, 0u}; if (t - 3 + jj >= 0) x[jj] = *(const GAS v4u*)(xrow + (ptrdiff_t)(jj - 3) * CW + c0); }
            float a[8];
            { const f32x4 b0 = *(const GAS f32x4*)(cbias + c0), b1 = *(const GAS f32x4*)(cbias + c0 + 4);
              a[0] = b0.x; a[1] = b0.y; a[2] = b0.z; a[3] = b0.w; a[4] = b1.x; a[5] = b1.y; a[6] = b1.z; a[7] = b1.w; }
#pragma unroll
            for (int jj = 0; jj < 4; ++jj) { const f32x4 w0 = *(const GAS f32x4*)(cw + jj * CW + c0), w1 = *(const GAS f32x4*)(cw + jj * CW + c0 + 4);
                a[0] += w0.x * bflo(x[jj][0]); a[1] += w0.y * bfhi(x[jj][0]); a[2] += w0.z * bflo(x[jj][1]); a[3] += w0.w * bfhi(x[jj][1]);
                a[4] += w1.x * bflo(x[jj][2]); a[5] += w1.y * bfhi(x[jj][2]); a[6] += w1.z * bflo(x[jj][3]); a[7] += w1.w * bfhi(x[jj][3]); }
#pragma unroll
            for (int j = 0; j < 8; ++j) a[j] = fsilu(a[j]);
            v4u xcp; xcp.x = cvtpk(a[0], a[1]); xcp.y = cvtpk(a[2], a[3]); xcp.z = cvtpk(a[4], a[5]); xcp.w = cvtpk(a[6], a[7]);
            float ar[8];
#pragma unroll
            for (int j = 0; j < 4; ++j) { ar[2 * j] = bflo(xcp[j]); ar[2 * j + 1] = bfhi(xcp[j]); }
            float kq[8];
#pragma unroll
            for (int bq = 0; bq < 2; ++bq) { const float* p4 = P4 + (size_t)(c0 / 4 + bq) * 16;
                const f32x4 q0 = *(const GAS f32x4*)(p4), q1 = *(const GAS f32x4*)(p4 + 4), q2 = *(const GAS f32x4*)(p4 + 8), q3 = *(const GAS f32x4*)(p4 + 12);
                const f32x4 o = q0 * ar[4 * bq] + q1 * ar[4 * bq + 1] + q2 * ar[4 * bq + 2] + q3 * ar[4 * bq + 3];
                kq[4 * bq] = o.x; kq[4 * bq + 1] = o.y; kq[4 * bq + 2] = o.z; kq[4 * bq + 3] = o.w; }
            v4u kp; kp.x = cvtpk(kq[0], kq[1]); kp.y = cvtpk(kq[2], kq[3]); kp.z = cvtpk(kq[4], kq[5]); kp.w = cvtpk(kq[6], kq[7]);
            *(GAS v4u*)(xc + (size_t)m * CW + c0) = xcp; *(GAS v4u*)(kpp + (size_t)m * CW + c0) = kp;
            const v4u g1 = *(const GAS v4u*)(Gt + (size_t)r * 8192 + c0), g2 = *(const GAS v4u*)(Gt + (size_t)r * 8192 + 4096 + c0);
            acc = __builtin_amdgcn_mfma_f32_16x16x32_bf16(__builtin_bit_cast(pg8::bf16x8, xcp), __builtin_bit_cast(pg8::bf16x8, g1), acc, 0, 0, 0);
            acc = __builtin_amdgcn_mfma_f32_16x16x32_bf16(__builtin_bit_cast(pg8::bf16x8, x[3]), __builtin_bit_cast(pg8::bf16x8, g2), acc, 0, 0, 0);
        }
        const float bi = P.in[IN_C_B_IF][r];
#pragma unroll
        for (int rg = 0; rg < 4; ++rg) gates[(size_t)(tile * 16 + 4 * g + rg) * 16 + r] = acc[rg] + bi;
    }
}
__device__ __forceinline__ void ph_mlstm_post(Frame& F, const Ptrs& P) {
    const bf16* hc = (const bf16*)(P.ws + WS_XM); bf16* xc = (bf16*)(P.ws + WS_XC);
    const float* lnw = P.in[IN_C_LN_W]; const float* skip = P.in[IN_C_SKIP];
    for (int m = F.gw; m < M; m += F.NGW) {
#pragma unroll 2
        for (int hh = 0; hh < 8; ++hh) {
            const int c0 = hh * CHD + 8 * F.lane;
            const v4u hv = *(const GAS v4u*)(hc + (size_t)m * CW + c0), xv = *(const GAS v4u*)(xc + (size_t)m * CW + c0);
            float x[8]; float s = 0.f;
#pragma unroll
            for (int j = 0; j < 4; ++j) { x[2 * j] = bflo(hv[j]); x[2 * j + 1] = bfhi(hv[j]); s += x[2 * j] + x[2 * j + 1]; }
            const float mean = wave_sum(s) * (1.f / CHD); float q = 0.f;
#pragma unroll
            for (int j = 0; j < 8; ++j) { x[j] -= mean; q += x[j] * x[j]; }
            const float rstd = rsqrtf(wave_sum(q) * (1.f / CHD) + 1e-6f);
            const f32x4 w0 = *(const GAS f32x4*)(lnw + c0), w1 = *(const GAS f32x4*)(lnw + c0 + 4), s0 = *(const GAS f32x4*)(skip + c0), s1 = *(const GAS f32x4*)(skip + c0 + 4);
            float o[8];
            o[0] = x[0] * rstd * w0.x + s0.x * bflo(xv[0]); o[1] = x[1] * rstd * w0.y + s0.y * bfhi(xv[0]); o[2] = x[2] * rstd * w0.z + s0.z * bflo(xv[1]); o[3] = x[3] * rstd * w0.w + s0.w * bfhi(xv[1]);
            o[4] = x[4] * rstd * w1.x + s1.x * bflo(xv[2]); o[5] = x[5] * rstd * w1.y + s1.y * bfhi(xv[2]); o[6] = x[6] * rstd * w1.z + s1.z * bflo(xv[3]); o[7] = x[7] * rstd * w1.w + s1.w * bfhi(xv[3]);
            v4u w; w.x = cvtpk(o[0], o[1]); w.y = cvtpk(o[2], o[3]); w.z = cvtpk(o[4], o[5]); w.w = cvtpk(o[6], o[7]);
            *(GAS v4u*)(xc + (size_t)m * CW + c0) = w;
        }
    }
}
constexpr int ML_QP = 0, ML_KP = 66560, ML_VTE = 133120, ML_MISC = 151552, ML_QSTR = 520, ML_VSTR = 72;
constexpr int MS_E = 0, MS_ROWF = 64, MS_SC = 128, MS_FLOOR = 192, MS_RS = 256, MS_QN = 320, MS_SCAL = 384, MS_N = 400;
__device__ __forceinline__ float bperm(int srclane, float x) { return __int_as_float(__builtin_amdgcn_ds_bpermute(srclane << 2, __float_as_int(x))); }
__device__ __forceinline__ void mlstm_unit(Frame& F, const Ptrs& P, int unit) {
    const int j = unit & 3, hh = (unit >> 2) & 7, b = unit >> 5;
    const bf16* xcg = (const bf16*)(P.ws + WS_XC); const bf16* kpg = (const bf16*)(P.ws + WS_KPP); bf16* xm = (bf16*)(P.ws + WS_XM);
    const float* gates = (const float*)(P.ws + WS_GATES); const float* wv = P.in[IN_C_W_V];
    LAS bf16* QP = (LAS bf16*)(F.lds + ML_QP); LAS bf16* KP = (LAS bf16*)(F.lds + ML_KP); LAS bf16* VTE = (LAS bf16*)(F.lds + ML_VTE); LAS bf16* SD = QP;
    LAS float* MS = (LAS float*)(F.lds + ML_MISC);
    const int w = F.wave;
    const int hc0 = hh * CHD, vc0 = hc0 + 128 * j;
    v2u Cb[32];
#pragma unroll
    for (int i = 0; i < 32; ++i) Cb[i] = (v2u){0u, 0u};
    MS[MS_N + F.tid] = 0.f; if (F.tid == 0) { MS[MS_SCAL + 2] = 0.f; MS[MS_SCAL + 3] = 0.f; }
    __syncthreads();
    for (int ch = 0; ch < SEQ / 64; ++ch) {
        const size_t m0 = (size_t)b * SEQ + ch * 64;
        int tid = F.tid; asm volatile("" : "+v"(tid));
        const int lid = tid & 63, r = lid & 15, g = lid >> 4;
#pragma unroll 2
        for (int it = 0; it < 8; ++it) { const int id = it * NTHR + tid, row = id >> 6, cchunk = id & 63;
            const v4u q = *(const GAS v4u*)(xcg + (m0 + row) * CW + hc0 + 8 * cchunk), k = *(const GAS v4u*)(kpg + (m0 + row) * CW + hc0 + 8 * cchunk);
            *(LAS v4u*)(QP + row * ML_QSTR + 8 * cchunk) = q; *(LAS v4u*)(KP + row * ML_QSTR + 8 * cchunk) = k; }
        if (w == 0) {
            const int s = lid; const float mprev = MS[MS_SCAL + 2 + (ch & 1)];
            const float ipre = gates[(m0 + s) * 16 + hh], fpre = gates[(m0 + s) * 16 + 8 + hh];
            const float lf = fminf(fpre, 0.f) - log1pf(__expf(-fabsf(fpre)));
            float bcum = lf;
#pragma unroll
            for (int o = 1; o < 64; o <<= 1) { const float tv = bperm(s - o, bcum); if (s >= o) bcum += tv; }
            float pm = ipre - bcum;
#pragma unroll
            for (int o = 1; o < 64; o <<= 1) { const float tv = bperm(s - o, pm); if (s >= o) pm = fmaxf(pm, tv); }
            const float blast = __int_as_float(__builtin_amdgcn_readlane(__float_as_int(bcum), 63)), pmlast = __int_as_float(__builtin_amdgcn_readlane(__float_as_int(pm), 63));
            const float mt = fmaxf(bcum + mprev, bcum + pm);
            const float mnew = fmaxf(blast + mprev, blast + pmlast);
            MS[MS_E + s] = __expf(blast - bcum + ipre - mnew);
            MS[MS_ROWF + s] = __expf(bcum - blast + mnew - mt);
            MS[MS_SC + s] = __expf(bcum + mprev - mt);
            MS[MS_FLOOR + s] = __expf(-mt);
            MS[MS_RS + s] = 0.f;
            if (s == 0) { MS[MS_SCAL + 0] = __expf(blast + mprev - mnew); MS[MS_SCAL + 2 + ((ch + 1) & 1)] = mnew; }
        }
        __syncthreads();
        { const int s = tid >> 3, vb = (tid & 7) * 16; const float es = MS[MS_E + s];
          const v4u x0 = *(const GAS v4u*)(xm + (m0 + s) * CW + vc0 + vb), x1 = *(const GAS v4u*)(xm + (m0 + s) * CW + vc0 + vb + 8);
          float xin[16];
#pragma unroll
          for (int q = 0; q < 4; ++q) { xin[2 * q] = bflo(x0[q]); xin[2 * q + 1] = bfhi(x0[q]); xin[8 + 2 * q] = bflo(x1[q]); xin[8 + 2 * q + 1] = bfhi(x1[q]); }
#pragma unroll
          for (int bq = 0; bq < 4; ++bq) { const float* wb = wv + (size_t)((vc0 + vb) / 4 + bq) * 16;
              const f32x4 q0 = *(const GAS f32x4*)(wb), q1 = *(const GAS f32x4*)(wb + 4), q2 = *(const GAS f32x4*)(wb + 8), q3 = *(const GAS f32x4*)(wb + 12);
              const f32x4 o = (q0 * xin[4 * bq] + q1 * xin[4 * bq + 1] + q2 * xin[4 * bq + 2] + q3 * xin[4 * bq + 3]) * es;
              VTE[(vb + 4 * bq + 0) * ML_VSTR + s] = (bf16)f2bf(o.x); VTE[(vb + 4 * bq + 1) * ML_VSTR + s] = (bf16)f2bf(o.y);
              VTE[(vb + 4 * bq + 2) * ML_VSTR + s] = (bf16)f2bf(o.z); VTE[(vb + 4 * bq + 3) * ML_VSTR + s] = (bf16)f2bf(o.w); } }
        { const int t = tid >> 3, p = tid & 7; float acc = 0.f;
#pragma unroll
          for (int q = 0; q < 8; ++q) { const v4u qv = *(const LAS v4u*)(QP + t * ML_QSTR + 64 * p + 8 * q); const LAS f32x4* nv = (const LAS f32x4*)(MS + MS_N + 64 * p + 8 * q); const f32x4 n0 = nv[0], n1 = nv[1];
              acc += bflo(qv[0]) * n0.x + bfhi(qv[0]) * n0.y + bflo(qv[1]) * n0.z + bfhi(qv[1]) * n0.w + bflo(qv[2]) * n1.x + bfhi(qv[2]) * n1.y + bflo(qv[3]) * n1.z + bfhi(qv[3]) * n1.w; }
          acc += bperm(lid ^ 1, acc); acc += bperm(lid ^ 2, acc); acc += bperm(lid ^ 4, acc);
          if (p == 0) MS[MS_QN + t] = acc; }
        __builtin_amdgcn_sched_barrier(0);
        const int tm = w >> 1, tn0 = 2 * (w & 1);
        pg8::f32x4 S0 = {0.f, 0.f, 0.f, 0.f}, S1 = {0.f, 0.f, 0.f, 0.f};
        if (tn0 <= tm) {
#pragma unroll 2
            for (int ks = 0; ks < 16; ++ks) { const pg8::bf16x8 a = *(const LAS pg8::bf16x8*)(QP + (16 * tm + r) * ML_QSTR + 32 * ks + 8 * g);
                const pg8::bf16x8 b0 = *(const LAS pg8::bf16x8*)(KP + (16 * tn0 + r) * ML_QSTR + 32 * ks + 8 * g), b1 = *(const LAS pg8::bf16x8*)(KP + (16 * tn0 + 16 + r) * ML_QSTR + 32 * ks + 8 * g);
                S0 = __builtin_amdgcn_mfma_f32_16x16x32_bf16(a, b0, S0, 0, 0, 0); S1 = __builtin_amdgcn_mfma_f32_16x16x32_bf16(a, b1, S1, 0, 0, 0); }
            const float e0 = MS[MS_E + 16 * tn0 + r], e1 = MS[MS_E + 16 * tn0 + 16 + r];
#pragma unroll
            for (int rg = 0; rg < 4; ++rg) { const int t = 16 * tm + 4 * g + rg;
                if (16 * tn0 + r > t) S0[rg] = 0.f; if (16 * tn0 + 16 + r > t) S1[rg] = 0.f;
                float rs = S0[rg] * e0 + S1[rg] * e1;
                rs += bperm(lid ^ 1, rs); rs += bperm(lid ^ 2, rs); rs += bperm(lid ^ 4, rs); rs += bperm(lid ^ 8, rs);
                if (r == 0) __hip_atomic_fetch_add(&MS[MS_RS + t], rs, __ATOMIC_RELAXED, __HIP_MEMORY_SCOPE_WORKGROUP); }
        }
        __builtin_amdgcn_sched_barrier(0);
        pg8::f32x4 N2[4];
#pragma unroll
        for (int i = 0; i < 4; ++i) N2[i] = (pg8::f32x4){0.f, 0.f, 0.f, 0.f};
#pragma unroll
        for (int ks = 0; ks < 16; ++ks) {
            v4u bp; bp.x = Cb[2 * ks].x; bp.y = Cb[2 * ks].y; bp.z = Cb[2 * ks + 1].x; bp.w = Cb[2 * ks + 1].y;
            const pg8::bf16x8 bfrag = __builtin_bit_cast(pg8::bf16x8, bp);
#pragma unroll
            for (int tq = 0; tq < 4; ++tq) { const LAS bf16* qrow = QP + (16 * tq + r) * ML_QSTR + 32 * ks + 4 * g;
                const v2u a0 = *(const LAS v2u*)(qrow), a1 = *(const LAS v2u*)(qrow + 16); v4u ap; ap.x = a0.x; ap.y = a0.y; ap.z = a1.x; ap.w = a1.y;
                N2[tq] = __builtin_amdgcn_mfma_f32_16x16x32_bf16(__builtin_bit_cast(pg8::bf16x8, ap), bfrag, N2[tq], 0, 0, 0); }
            __builtin_amdgcn_sched_barrier(0);
        }
        __syncthreads();
        if (tn0 <= tm) {
#pragma unroll
            for (int rg = 0; rg < 4; ++rg) { const int t = 16 * tm + 4 * g + rg; SD[t * ML_VSTR + 16 * tn0 + r] = (bf16)f2bf(S0[rg]); SD[t * ML_VSTR + 16 * tn0 + 16 + r] = (bf16)f2bf(S1[rg]); }
        } else {
#pragma unroll
            for (int rg = 0; rg < 4; ++rg) { const int t = 16 * tm + 4 * g + rg; SD[t * ML_VSTR + 16 * tn0 + r] = 0; SD[t * ML_VSTR + 16 * tn0 + 16 + r] = 0; }
        }
        __syncthreads();
        const float decay = MS[MS_SCAL + 0];
#pragma unroll
        for (int i = 0; i < 4; ++i) N2[i] = N2[i] * decay;
#pragma unroll
        for (int ks = 0; ks < 2; ++ks) { const pg8::bf16x8 vb = *(const LAS pg8::bf16x8*)(VTE + (16 * w + r) * ML_VSTR + 32 * ks + 8 * g);
#pragma unroll
            for (int tq = 0; tq < 4; ++tq) { const pg8::bf16x8 a = *(const LAS pg8::bf16x8*)(SD + (16 * tq + r) * ML_VSTR + 32 * ks + 8 * g);
                N2[tq] = __builtin_amdgcn_mfma_f32_16x16x32_bf16(a, vb, N2[tq], 0, 0, 0); } }
#pragma unroll
        for (int tq = 0; tq < 4; ++tq)
#pragma unroll
            for (int rg = 0; rg < 4; ++rg) { const int t = 16 * tq + 4 * g + rg; const float rowf = MS[MS_ROWF + t], sc = MS[MS_SC + t];
                const float num = rowf * N2[tq][rg], den = rowf * MS[MS_RS + t] + sc * MS[MS_QN + t];
                const float hval = num / fmaxf(fabsf(den), MS[MS_FLOOR + t]);
                xm[(m0 + t) * CW + vc0 + 16 * w + r] = (bf16)f2bf(hval); }
        __builtin_amdgcn_sched_barrier(0);
        { const pg8::bf16x8 vb0 = *(const LAS pg8::bf16x8*)(VTE + (16 * w + r) * ML_VSTR + 8 * g), vb1 = *(const LAS pg8::bf16x8*)(VTE + (16 * w + r) * ML_VSTR + 32 + 8 * g);
          const int q4 = r >> 2, p4 = r & 3;
#pragma unroll
          for (int kb = 0; kb < 32; ++kb) {
              const LAS bf16* base = KP + (8 * g + q4) * ML_QSTR + 16 * kb + 4 * p4;
              const s16x4 t00 = __builtin_amdgcn_ds_read_tr16_b64_v4i16((LAS s16x4*)(base)), t01 = __builtin_amdgcn_ds_read_tr16_b64_v4i16((LAS s16x4*)(base + 4 * ML_QSTR));
              const s16x4 t10 = __builtin_amdgcn_ds_read_tr16_b64_v4i16((LAS s16x4*)(base + 32 * ML_QSTR)), t11 = __builtin_amdgcn_ds_read_tr16_b64_v4i16((LAS s16x4*)(base + 36 * ML_QSTR));
              pg8::bf16x8 a0, a1;
              a0[0] = t00[0]; a0[1] = t00[1]; a0[2] = t00[2]; a0[3] = t00[3]; a0[4] = t01[0]; a0[5] = t01[1]; a0[6] = t01[2]; a0[7] = t01[3];
              a1[0] = t10[0]; a1[1] = t10[1]; a1[2] = t10[2]; a1[3] = t10[3]; a1[4] = t11[0]; a1[5] = t11[1]; a1[6] = t11[2]; a1[7] = t11[3];
              pg8::f32x4 c = (pg8::f32x4){bflo(Cb[kb].x), bfhi(Cb[kb].x), bflo(Cb[kb].y), bfhi(Cb[kb].y)} * decay;
              c = __builtin_amdgcn_mfma_f32_16x16x32_bf16(a0, vb0, c, 0, 0, 0);
              c = __builtin_amdgcn_mfma_f32_16x16x32_bf16(a1, vb1, c, 0, 0, 0);
              Cb[kb].x = cvtpk(c[0], c[1]); Cb[kb].y = cvtpk(c[2], c[3]);
              if ((kb & 3) == 3) __builtin_amdgcn_sched_barrier(0);
          }
          float nk = MS[MS_N + tid] * decay;
#pragma unroll 8
          for (int s = 0; s < 64; ++s) nk += MS[MS_E + s] * bf1(KP[s * ML_QSTR + tid]);
          MS[MS_N + tid] = nk; }
        __syncthreads();
    }
}

#ifndef SITE_MASK
#define SITE_MASK 0xFFFFFFFFu
#endif
#define SITE_ON(n) (((SITE_MASK) >> (n)) & 1u)
constexpr int N_PHASES = 28;
struct Args { Ptrs p; int ph_lo, ph_hi, li, pad; };
__device__ __forceinline__ Frame mk_frame(LAS unsigned char* lds) {
    Frame F; F.lds = lds; int t = threadIdx.x; asm volatile("" : "+v"(t));
    F.tid = t; F.lane = t & 63; F.wave = __builtin_amdgcn_readfirstlane(t >> 6);
    F.G = gridDim.x; F.gw = blockIdx.x * NWAVES + F.wave; F.NGW = F.G * NWAVES; return F;
}
template <class Epi> __device__ __forceinline__ void run_gemm(Frame& F, const bf16* A, const bf16* Bt, int Mr, int N, int K, const Epi& E) {
    pg8::Gemm g{A, Bt, Mr, N, K}; pg8::StaticOrder S; S.init(Mr, N, F.G, (int)blockIdx.x);
    pg8::gemm_phase<Epi, pg8::StaticOrder, true, true>(F.lds, g, S, E);
}
__global__ void __launch_bounds__(NTHR, 2) fwd_kernel(Args args) {
    extern __shared__ __attribute__((aligned(16))) unsigned char lds_raw[];
    const Ptrs& P = args.p; unsigned char* ws = P.ws;
    volatile LAS unsigned* MISC = (volatile LAS unsigned*)((LAS unsigned char*)lds_raw + MISC_OFF);
    if (threadIdx.x < 64) MISC[threadIdx.x] = 0u;
    __syncthreads();
    XcdBarrier bar = xcd_barrier_post((unsigned*)(ws + WS_CTL) + 1024 + args.li * 4096, MISC + 8);
    const int lo = args.ph_lo, hi = args.ph_hi;
    int ph = 0;
#define PHASE_BEGIN if (ph >= lo && ph < hi) { Frame F = mk_frame((LAS unsigned char*)lds_raw);
#define PHASE_END   if (ph + 1 < hi) xcd_barrier(bar); } ++ph;

    PHASE_BEGIN
#if SITE_ON(0)
 ph_prologue(F, P); ph_rmsnorm_bf16(F, P.in[IN_X], P.in[IN_EVEN_NORM], (bf16*)(ws + WS_H));
#endif
    PHASE_END
    PHASE_BEGIN
#if SITE_ON(1)
 { pg8::EpiBf16<0> E{(bf16*)(ws + WS_PROJ), EIN_PAD, nullptr, 0, 0, 1.f}; run_gemm(F, (const bf16*)(ws + WS_H), (const bf16*)(ws + WS_W_IN_E), M, EIN_PAD, DM, E); }
#endif
    PHASE_END
    PHASE_BEGIN
#if SITE_ON(2)
 ph_lra(F, P);
#endif
    PHASE_END
    PHASE_BEGIN
#if SITE_ON(3)
 { pg8::EpiBf16<0> E{(bf16*)(ws + WS_LR), LRN, (const float*)(ws + WS_LRB), 0, 0, 1.f}; run_gemm(F, (const bf16*)(ws + WS_LRA), (const bf16*)(ws + WS_W_LR), M, LRN, LRK, E); }
#endif
    PHASE_END
    PHASE_BEGIN
#if SITE_ON(4)
 for (int u = blockIdx.x; u < 192; u += F.G) { if (u < 128) rwkv_unit(F, P, u); else rglru_unit(F, P, u - 128); __syncthreads(); }
#endif
    PHASE_END
    PHASE_BEGIN
#if SITE_ON(5)
 { pg8::EpiRes E{P.in[IN_X], P.out, DM}; run_gemm(F, (const bf16*)(ws + WS_H), (const bf16*)(ws + WS_W_OUT_E), M, DM, DM, E); }
#endif
    PHASE_END
    for (int layer = 0; layer < 2; ++layer) {
        if (layer == 1) {
            PHASE_BEGIN
#if SITE_ON(6)
 ph_rmsnorm_bf16(F, P.out, P.in[IN_ODD_NORM], (bf16*)(ws + WS_H));
#endif
    PHASE_END
            PHASE_BEGIN
#if SITE_ON(7)
 { pg8::EpiBf16<0> E{(bf16*)(ws + WS_XM), CW, nullptr, 0, 0, 1.f}; run_gemm(F, (const bf16*)(ws + WS_H), (const bf16*)(ws + WS_W_IN_O), M, CW, DM, E); }
#endif
    PHASE_END
            PHASE_BEGIN
#if SITE_ON(8)
 ph_mlstm_pre(F, P);
#endif
    PHASE_END
            PHASE_BEGIN
#if SITE_ON(9)
 for (int u = blockIdx.x; u < 256; u += F.G) { const int x = u & 7, y = u >> 3, hd = 8 * (y >> 2) + x; mlstm_unit(F, P, (hd << 2) | (y & 3)); }
#endif
    PHASE_END
            PHASE_BEGIN
#if SITE_ON(10)
 ph_mlstm_post(F, P);
#endif
    PHASE_END
            PHASE_BEGIN
#if SITE_ON(11)
 { pg8::EpiZMul E{(bf16*)(ws + WS_XC), CW}; run_gemm(F, (const bf16*)(ws + WS_H), (const bf16*)(ws + WS_W_IN_O) + (size_t)CW * DM, M, CW, DM, E); }
#endif
    PHASE_END
            PHASE_BEGIN
#if SITE_ON(12)
 { pg8::EpiRes E{P.out, P.out, DM}; run_gemm(F, (const bf16*)(ws + WS_XC), (const bf16*)(ws + WS_W_OUT_O), M, DM, CW, E); }
#endif
    PHASE_END
        }
        PHASE_BEGIN
#if SITE_ON(13)
 ph_rmsnorm_bf16(F, P.out, P.in[IN_FFN_NORM] + layer * DM, (bf16*)(ws + WS_H));
#endif
    PHASE_END
        const bf16* wgu = (const bf16*)(ws + (layer ? WS_W_GU1 : WS_W_GU0)); const bf16* wdn = (const bf16*)(ws + (layer ? WS_W_DN1 : WS_W_DN0));
        for (int half = 0; half < 2; ++half) {
            PHASE_BEGIN
#if SITE_ON(14)
 { pg8::EpiBf16<0> E{(bf16*)(ws + WS_GU), GUN, nullptr, 0, 0, 1.f}; run_gemm(F, (const bf16*)(ws + WS_H) + (size_t)half * MH * DM, wgu, MH, GUN, DM, E); }
#endif
    PHASE_END
            PHASE_BEGIN
#if SITE_ON(15)
 ph_ffn_act(F, (const bf16*)(ws + WS_GU), (bf16*)(ws + WS_U), P.in[IN_FFN_CONV_W] + (size_t)layer * 3 * DFF, P.in[IN_FFN_CONV_B] + (size_t)layer * DFF);
#endif
    PHASE_END
            PHASE_BEGIN
#if SITE_ON(16)
 { float* o = P.out + (size_t)half * MH * DM; pg8::EpiRes E{o, o, DM}; run_gemm(F, (const bf16*)(ws + WS_U), wdn, MH, DM, DFF, E); }
#endif
    PHASE_END
        }
    }
    PHASE_BEGIN
#if SITE_ON(17)
 ph_rmsnorm_f32_inplace(F, P.out, P.in[IN_FINAL_NORM]);
#endif
    PHASE_END
#undef PHASE_BEGIN
#undef PHASE_END
}


#ifdef DIAG_PHASES
__global__ void cks_kernel(const unsigned* p0, size_t n0, const unsigned* p1, size_t n1, const unsigned* p2, size_t n2, unsigned long long* slot) {
    unsigned long long s = 0; const size_t gt = (size_t)blockIdx.x * blockDim.x + threadIdx.x, GT = (size_t)gridDim.x * blockDim.x;
    for (size_t i = gt; i < n0; i += GT) s += (unsigned long long)p0[i] * (unsigned long long)((i & 1023) + 1);
    for (size_t i = gt; i < n1; i += GT) s += (unsigned long long)p1[i] * (unsigned long long)((i & 1023) + 1);
    for (size_t i = gt; i < n2; i += GT) s += (unsigned long long)p2[i] * (unsigned long long)((i & 1023) + 1);
    for (int o = 32; o >= 1; o >>= 1) s += __shfl_xor(s, o);
    if ((threadIdx.x & 63) == 0) atomicAdd(slot, s);
}
__global__ void diag_out_kernel(const unsigned long long* slots, float* out, size_t n) {
    int p = 0; for (int i = N_PHASES - 1; i >= 0; --i) if (slots[i] != slots[64 + i]) p = i + 1;
    const float v = 1.0f + (float)p;
    for (size_t i = (size_t)blockIdx.x * blockDim.x + threadIdx.x; i < n; i += (size_t)gridDim.x * blockDim.x) out[i] = v;
}
#endif
extern "C" void kernel_launch(void* const* d_in, const int* in_sizes, int n_in, void* d_out, int out_size, void* d_ws, size_t ws_size, hipStream_t stream) {
    static int grid = 0;
    if (grid == 0) {
        if (n_in != 41 || out_size != M * DM || ws_size < WS_END) { fprintf(stderr, "kernel_launch: unexpected problem (n_in %d, out %d, ws %zu)\n", n_in, out_size, ws_size); grid = -1; return; }
        int dev = 0, cus = 0, per_cu = 0;
        if (hipGetDevice(&dev) != hipSuccess || hipDeviceGetAttribute(&cus, hipDeviceAttributeMultiprocessorCount, dev) != hipSuccess) { grid = -1; return; }
        if (hipFuncSetAttribute((const void*)fwd_kernel, hipFuncAttributeMaxDynamicSharedMemorySize, LDS_BYTES) != hipSuccess) { fprintf(stderr, "kernel_launch: hipFuncSetAttribute failed\n"); grid = -1; return; }
        if (hipOccupancyMaxActiveBlocksPerMultiprocessor(&per_cu, (const void*)fwd_kernel, NTHR, LDS_BYTES) != hipSuccess || per_cu < 1) { fprintf(stderr, "kernel_launch: occupancy query says %d\n", per_cu); (void)hipGetLastError(); }
        grid = cus;
    }
    if (grid < 0) return;
    (void)hipMemsetAsync((char*)d_ws + WS_CTL, 0, CTL_ZERO_BYTES, stream);
    Args a{};
    for (int i = 0; i < 41; ++i) a.p.in[i] = (const float*)d_in[i];
    a.p.out = (float*)d_out; a.p.ws = (unsigned char*)d_ws;
    constexpr int NL = MK_N_LAUNCHES;
#ifdef DIAG_PHASES
    static_assert(NL == N_PHASES, "diag build runs one launch per phase");
    unsigned long long* slots = (unsigned long long*)((char*)d_ws + 65536);
    unsigned char* w8 = (unsigned char*)d_ws;
    for (int run = 0; run < 2; ++run)
    for (int li = 0; li < NL; ++li) {
        a.ph_lo = li; a.ph_hi = li + 1; a.li = 0;
        hipLaunchKernelGGL(fwd_kernel, dim3(grid), dim3(NTHR), LDS_BYTES, stream, a);
        const unsigned *p0 = nullptr, *p1 = nullptr, *p2 = nullptr; size_t n0 = 0, n1 = 0, n2 = 0;
        auto R = [&](size_t off, size_t bytes, const unsigned*& p, size_t& n) { p = (const unsigned*)(w8 + off); n = bytes / 4; };
        const size_t HB = (size_t)M * DM * 2, OB = (size_t)M * DM * 4;
        switch (li) {
            case 0: R(WS_H, HB, p0, n0); R(WS_W_IN_O, 120 * MiB, p1, n1); R(WS_W_IN_E, 96 * MiB, p2, n2); break;
            case 1: R(WS_PROJ, (size_t)M * EIN_PAD * 2, p0, n0); break;
            case 2: R(WS_LRA, (size_t)M * LRK * 2, p0, n0); break;
            case 3: R(WS_LR, (size_t)M * LRN * 2, p0, n0); break;
            case 4: R(WS_H, HB, p0, n0); break;
            case 6: case 13: case 20: R(WS_H, HB, p0, n0); break;
            case 7: case 10: case 21: case 24: R(WS_GU, (size_t)MH * GUN * 2, p0, n0); break;
            case 8: case 11: case 22: case 25: R(WS_U, (size_t)MH * DFF * 2, p0, n0); break;
            case 14: case 16: R(WS_XM, (size_t)M * CW * 2, p0, n0); break;
            case 15: R(WS_XC, (size_t)M * CW * 2, p0, n0); R(WS_KPP, (size_t)M * CW * 2, p1, n1); R(WS_GATES, (size_t)M * 16 * 4, p2, n2); break;
            case 17: case 18: R(WS_XC, (size_t)M * CW * 2, p0, n0); break;
            default: p0 = (const unsigned*)d_out; n0 = OB / 4; break;
        }
        hipLaunchKernelGGL(cks_kernel, dim3(1024), dim3(256), 0, stream, p0, n0, p1, n1, p2, n2, slots + run * 64 + li);
    }
    hipLaunchKernelGGL(diag_out_kernel, dim3(1024), dim3(256), 0, stream, (const unsigned long long*)slots, (float*)d_out, (size_t)M * DM);
#else
    for (int li = 0; li < NL; ++li) {
        a.ph_lo = (int)((long)N_PHASES * li / NL); a.ph_hi = (int)((long)N_PHASES * (li + 1) / NL); a.li = (NL == N_PHASES) ? 0 : (li & 3);
        hipLaunchKernelGGL(fwd_kernel, dim3(grid), dim3(NTHR), LDS_BYTES, stream, a);
    }
#endif
}
```

```cpp
#include <hip/hip_runtime.h>
#include <cstdio>
#include <cstdint>
#ifndef MK_N_LAUNCHES
#define MK_N_LAUNCHES 1
#endif
#ifndef PG8_WGM
#define PG8_WGM 8
#endif
namespace pg8 {
#define PG8_LAS __attribute__((address_space(3)))
typedef unsigned short bf16_t;
typedef short bf16x8 __attribute__((ext_vector_type(8)));
typedef float f32x4 __attribute__((ext_vector_type(4)));
typedef unsigned u32x4 __attribute__((ext_vector_type(4)));
constexpr int BM = 256, BK = 64, HALF = 128, HTB = HALF * BK * 2  , STAGE_BYTES = 8 * HTB, NXCD = 8, WGM = PG8_WGM;

__host__ __device__ __forceinline__ int lds_byte(int r, int c) { const int st = (r >> 4) * 2 + (c >> 5), rr = r & 15, cc = c & 31, ob = rr * 64 + cc * 2; return st * 1024 + (ob ^ (((ob >> 9) & 1) << 5)); }
__host__ __device__ __forceinline__ void stage_rc(int b, int& R, int& C) { const int st = b / 1024, sb = b % 1024, swz = sb ^ (((sb >> 9) & 1) << 5); R = (st >> 1) * 16 + swz / 64; C = (st & 1) * 32 + (swz % 64) / 2; }
__host__ __device__ __forceinline__ int perm32(int rho) { const int n = rho >> 4, i = rho & 15; return 8 * (i >> 2) + 4 * n + (i & 3); }

struct Unit { int pm, pn; };
struct Gemm { const bf16_t* A; const bf16_t* Bt; int M, N, K; };

struct StaticOrder {
    int nM, nN, nwg, G, c;
    __host__ __device__ void init(int M, int N, int G_, int c_) { nM = M / BM; nN = N / BM; nwg = nM * nN; G = G_; c = c_; }
    __host__ __device__ bool next(int i, Unit& u) const {
        const long L = (long)i * G + c; if (L >= nwg) return false;
        int wgid = (int)L; { const int q = nwg / NXCD, r = nwg % NXCD, xcd = wgid % NXCD, off = wgid / NXCD; wgid = (xcd < r ? xcd * (q + 1) : r * (q + 1) + (xcd - r) * q) + off; }
        const int nig = WGM * nN, gid = wgid / nig, fm = gid * WGM, gsz = (nM - fm) < WGM ? (nM - fm) : WGM;
        u.pm = fm + ((wgid % nig) % gsz); u.pn = (wgid % nig) / gsz; return true;
    }
    __device__ __forceinline__ void a_ready(const Unit&) const {}
    __device__ __forceinline__ void done(const Unit&) const {}
};

typedef float f32x2c __attribute__((ext_vector_type(2))); typedef __bf16 bf16x2c __attribute__((ext_vector_type(2)));
__device__ __forceinline__ unsigned cvt_pk_bf16(float lo, float hi) { const f32x2c v = {lo, hi}; return __builtin_bit_cast(unsigned, __builtin_convertvector(v, bf16x2c)); }
typedef float f32x2 __attribute__((ext_vector_type(2)));
__device__ __forceinline__ f32x2 gelu_pk(f32x2 v) {
    const f32x2 av = __builtin_elementwise_abs(v), d = av * 0.2316418882f + 1.0f;
    f32x2 t; t.x = __builtin_amdgcn_rcpf(d.x); t.y = __builtin_amdgcn_rcpf(d.y);
    f32x2 q = t * 0.5307027145f + (-0.7265760135f); q = q * t + 0.7107068705f; q = q * t + (-0.142248368f); q = q * t + 0.127414796f; q = q * t;
    const f32x2 s = (v * v) * (-0.72134752044f);
    f32x2 e; e.x = __builtin_amdgcn_exp2f(s.x); e.y = __builtin_amdgcn_exp2f(s.y);
    const f32x2 m = v * (q * e), r = v - m;
    f32x2 o; o.x = v.x < 0.f ? m.x : r.x; o.y = v.y < 0.f ? m.y : r.y; return o;
}
template <int ACT  > struct EpiBf16 {
    static constexpr bool PERM = true, AFTER_DRAIN = false; static_assert(ACT == 0 || ACT == 1, "EpiBf16: ACT is 0 (none) or 1 (gelu_pk)");
    bf16_t* O; int ldc; const float* bias; int split_cols; size_t split_stride; float scale0; const float* ss = nullptr;
    __device__ __forceinline__ void operator()(const f32x4 (&acc)[2][2][4][2], const Unit& u, int wr, int wc, int fr, int fq) const {
        const int row0 = u.pm * BM + wr * 64 + fr; int colt = u.pn * BM; bf16_t* base = O;
        float sc = 1.f; if (split_cols) { const int t = colt / split_cols; base += (size_t)t * split_stride; colt -= t * split_cols; if (t == 0) sc = scale0; }
        const int col0 = colt + wc * 32 + 8 * fq, bcol0 = u.pn * BM + wc * 32 + 8 * fq;
        f32x4 bv[2][2];
#pragma unroll
        for (int bj = 0; bj < 2; ++bj)
#pragma unroll
            for (int n = 0; n < 2; ++n) bv[bj][n] = bias ? *(const f32x4*)(bias + bcol0 + bj * HALF + 4 * n) : (f32x4){0.f, 0.f, 0.f, 0.f};
#pragma unroll
        for (int ai = 0; ai < 2; ++ai)
#pragma unroll
            for (int m = 0; m < 4; ++m) { bf16_t* rowp = base + (size_t)(row0 + ai * HALF + m * 16) * ldc + col0; const float rs = ss ? rsqrtf(ss[row0 + ai * HALF + m * 16] * (1.f / 2048.f) + 1e-6f) : 1.f;
#pragma unroll
                for (int bj = 0; bj < 2; ++bj) { f32x4 v0 = acc[ai][bj][m][0] * rs + bv[bj][0], v1 = acc[ai][bj][m][1] * rs + bv[bj][1];
                    if (ACT == 1) { f32x2 a = gelu_pk((f32x2){v0[0], v0[1]}), b = gelu_pk((f32x2){v0[2], v0[3]}), c = gelu_pk((f32x2){v1[0], v1[1]}), d = gelu_pk((f32x2){v1[2], v1[3]});
                        v0 = (f32x4){a.x, a.y, b.x, b.y}; v1 = (f32x4){c.x, c.y, d.x, d.y}; }
                    v0 = v0 * sc; v1 = v1 * sc; u32x4 w; w.x = cvt_pk_bf16(v0[0], v0[1]); w.y = cvt_pk_bf16(v0[2], v0[3]); w.z = cvt_pk_bf16(v1[0], v1[1]); w.w = cvt_pk_bf16(v1[2], v1[3]);
                    *(u32x4*)(rowp + bj * HALF) = w; } }
    }
};
__device__ __forceinline__ float fsigmoid(float x) { return __builtin_amdgcn_rcpf(1.0f + __expf(-x)); }
struct EpiRes {
    static constexpr bool PERM = true, AFTER_DRAIN = false;
    const float* res; const bf16_t* resb; float* out; int ldc; bf16_t* hraw; float* ss;
    __device__ __forceinline__ void operator()(const f32x4 (&acc)[2][2][4][2], const Unit& u, int wr, int wc, int fr, int fq) const {
        const int row0 = u.pm * BM + wr * 64 + fr, col0 = u.pn * BM + wc * 32 + 8 * fq;
#pragma unroll
        for (int ai = 0; ai < 2; ++ai)
#pragma unroll
            for (int m = 0; m < 4; ++m) { const size_t off = (size_t)(row0 + ai * HALF + m * 16) * ldc + col0; float sq = 0.f;
#pragma unroll
                for (int bj = 0; bj < 2; ++bj) {
                    f32x4 r0, r1;
                    if (res) { r0 = *(const f32x4*)(res + off + bj * HALF); r1 = *(const f32x4*)(res + off + bj * HALF + 4); }
                    else { const u32x4 rb = *(const u32x4*)(resb + off + bj * HALF);
                        r0 = (f32x4){__uint_as_float(rb.x << 16), __uint_as_float(rb.x & 0xffff0000u), __uint_as_float(rb.y << 16), __uint_as_float(rb.y & 0xffff0000u)};
                        r1 = (f32x4){__uint_as_float(rb.z << 16), __uint_as_float(rb.z & 0xffff0000u), __uint_as_float(rb.w << 16), __uint_as_float(rb.w & 0xffff0000u)}; }
                    const f32x4 o0 = r0 + acc[ai][bj][m][0], o1 = r1 + acc[ai][bj][m][1];
                    if (out) { *(f32x4*)(out + off + bj * HALF) = o0; *(f32x4*)(out + off + bj * HALF + 4) = o1; }
                    if (hraw) { u32x4 w; w.x = cvt_pk_bf16(o0[0], o0[1]); w.y = cvt_pk_bf16(o0[2], o0[3]); w.z = cvt_pk_bf16(o1[0], o1[1]); w.w = cvt_pk_bf16(o1[2], o1[3]); *(u32x4*)(hraw + off + bj * HALF) = w;
                        sq += ((o0[0] * o0[0] + o0[1] * o0[1]) + (o0[2] * o0[2] + o0[3] * o0[3])) + ((o1[0] * o1[0] + o1[1] * o1[1]) + (o1[2] * o1[2] + o1[3] * o1[3])); } }
                if (hraw && ss) { sq += __shfl_xor(sq, 16); sq += __shfl_xor(sq, 32); if (fq == 0) ss[(size_t)(row0 + ai * HALF + m * 16) * 32 + u.pn * 4 + wc] = sq; }
                if (m & 1) asm volatile("" ::: "memory"); }
    }
};
struct EpiLR {
    static constexpr bool PERM = true, AFTER_DRAIN = false;
    bf16_t* O; const float* w0; const float* a0;
    __device__ __forceinline__ void operator()(const f32x4 (&acc)[2][2][4][2], const Unit& u, int wr, int wc, int fr, int fq) const {
        const int row0 = u.pm * BM + wr * 64 + fr, col0 = u.pn * BM + wc * 32 + 8 * fq;
        const int kind = u.pn >> 2;
        const float* bsrc = kind == 0 ? w0 + col0 : a0 + (col0 - 1024);
#pragma unroll
        for (int bj = 0; bj < 2; ++bj) {
            f32x4 bv0 = (f32x4){0.f, 0.f, 0.f, 0.f}, bv1 = bv0;
            if (kind < 2) { bv0 = *(const f32x4*)(bsrc + bj * HALF); bv1 = *(const f32x4*)(bsrc + bj * HALF + 4); }
#pragma unroll
        for (int ai = 0; ai < 2; ++ai)
#pragma unroll
            for (int m = 0; m < 4; ++m) { bf16_t* rowp = O + (size_t)(row0 + ai * HALF + m * 16) * 3072 + col0;
                { f32x4 v0 = acc[ai][bj][m][0] + bv0, v1 = acc[ai][bj][m][1] + bv1;
                    if (kind < 2) {
#pragma unroll
                        for (int j = 0; j < 4; ++j) { v0[j] = fsigmoid(v0[j]); v1[j] = fsigmoid(v1[j]); }
                        if (kind == 0) { v0 = v0 * (-0.60653066f); v1 = v1 * (-0.60653066f); } }
                    u32x4 w; w.x = cvt_pk_bf16(v0[0], v0[1]); w.y = cvt_pk_bf16(v0[2], v0[3]); w.z = cvt_pk_bf16(v1[0], v1[1]); w.w = cvt_pk_bf16(v1[2], v1[3]);
                    *(u32x4*)(rowp + bj * HALF) = w; } }
            asm volatile("" ::: "memory"); }
    }
};
struct EpiZMul {
    static constexpr bool PERM = true, AFTER_DRAIN = false;
    bf16_t* HS; int ldc; const float* ss;
    __device__ __forceinline__ void operator()(const f32x4 (&acc)[2][2][4][2], const Unit& u, int wr, int wc, int fr, int fq) const {
        const int row0 = u.pm * BM + wr * 64 + fr, col0 = u.pn * BM + wc * 32 + 8 * fq;
#pragma unroll
        for (int ai = 0; ai < 2; ++ai)
#pragma unroll
            for (int m = 0; m < 4; ++m) { bf16_t* rowp = HS + (size_t)(row0 + ai * HALF + m * 16) * ldc + col0; const float rs = rsqrtf(ss[row0 + ai * HALF + m * 16] * (1.f / 2048.f) + 1e-6f);
#pragma unroll
                for (int bj = 0; bj < 2; ++bj) { const u32x4 h = *(const u32x4*)(rowp + bj * HALF); f32x4 v0 = acc[ai][bj][m][0] * rs, v1 = acc[ai][bj][m][1] * rs;
                    float hv[8];
#pragma unroll
                    for (int j = 0; j < 4; ++j) { hv[2 * j] = __uint_as_float(h[j] << 16); hv[2 * j + 1] = __uint_as_float(h[j] & 0xffff0000u); }
#pragma unroll
                    for (int j = 0; j < 4; ++j) { v0[j] = hv[j] * v0[j] * fsigmoid(v0[j]); v1[j] = hv[4 + j] * v1[j] * fsigmoid(v1[j]); }
                    u32x4 w; w.x = cvt_pk_bf16(v0[0], v0[1]); w.y = cvt_pk_bf16(v0[2], v0[3]); w.z = cvt_pk_bf16(v1[0], v1[1]); w.w = cvt_pk_bf16(v1[2], v1[3]);
                    *(u32x4*)(rowp + bj * HALF) = w; } }
    }
};

template <int CTRL> __device__ __forceinline__ float dpp_mv(float old, float x) { return __int_as_float(__builtin_amdgcn_update_dpp(__float_as_int(old), __float_as_int(x), CTRL, 0xf, 0xf, false)); }
struct EpiGU {
    static constexpr bool PERM = true, AFTER_DRAIN = false;
    bf16_t* U; const float* cw; const float* cb; float* gtail; float* preh; float* uph; PG8_LAS float* halo; const float* ss;
    __device__ __forceinline__ void operator()(const f32x4 (&acc_)[2][2][4][2], const Unit& u, int wr, int wc, int fr, int fq) const {
        constexpr int DFF_ = 5632;
        f32x4 acc[2][2][4][2];
#pragma unroll
        for (int ai = 0; ai < 2; ++ai)
#pragma unroll
            for (int m = 0; m < 4; ++m) { const float rs = rsqrtf(ss[u.pm * BM + ai * HALF + wr * 64 + m * 16 + fr] * (1.f / 2048.f) + 1e-6f);
#pragma unroll
                for (int bj = 0; bj < 2; ++bj)
#pragma unroll
                    for (int n = 0; n < 2; ++n) acc[ai][bj][m][n] = acc_[ai][bj][m][n] * rs; }
        const int cc = wc * 32 + 8 * fq, col0 = u.pn * 128 + cc;
        const bool seq_start = ((u.pm * BM) & 4095) == 0;
        if (fr >= 14) {
#pragma unroll
            for (int ai = 0; ai < 2; ++ai) { PG8_LAS float* h = halo + ((2 * ai + wr) * 2 + (fr - 14)) * 128 + cc;
                *(PG8_LAS f32x4*)h = acc[ai][0][3][0]; *(PG8_LAS f32x4*)(h + 4) = acc[ai][0][3][1]; }
            if (wr == 1) { float* gt = gtail + ((size_t)u.pm * 2 + (fr - 14)) * DFF_ + col0; *(f32x4*)gt = acc[1][0][3][0]; *(f32x4*)(gt + 4) = acc[1][0][3][1]; }
        }
        asm volatile("s_waitcnt lgkmcnt(0)" ::: "memory"); __builtin_amdgcn_s_barrier(); asm volatile("" ::: "memory");
        f32x4 w0[2], w1[2], w2[2], bb[2];
#pragma unroll
        for (int n = 0; n < 2; ++n) { w0[n] = *(const f32x4*)(cw + col0 + 4 * n); w1[n] = *(const f32x4*)(cw + DFF_ + col0 + 4 * n); w2[n] = *(const f32x4*)(cw + 2 * DFF_ + col0 + 4 * n); bb[n] = *(const f32x4*)(cb + col0 + 4 * n); }
#pragma unroll
        for (int ai = 0; ai < 2; ++ai) {
            const int s = 2 * ai + wr;
            f32x4 P[2] = {(f32x4){0.f, 0.f, 0.f, 0.f}, (f32x4){0.f, 0.f, 0.f, 0.f}};
            if (s > 0 && fr >= 14) { const PG8_LAS float* h = halo + ((s - 1) * 2 + (fr - 14)) * 128 + cc; P[0] = *(const PG8_LAS f32x4*)h; P[1] = *(const PG8_LAS f32x4*)(h + 4); }
#pragma unroll
            for (int m = 0; m < 4; ++m) {
                const int row = u.pm * BM + ai * HALF + wr * 64 + m * 16 + fr;
                f32x4 o[2];
#pragma unroll
                for (int n = 0; n < 2; ++n) { const f32x4 cur = acc[ai][0][m][n], prv = (m == 0) ? P[n] : acc[ai][0][m - 1][n], upv = acc[ai][1][m][n];
#pragma unroll
                    for (int e2 = 0; e2 < 4; ++e2) {
                        const float g1 = dpp_mv<0x111>(dpp_mv<0x121>(0.f, prv[e2]), cur[e2]);
                        const float g2 = dpp_mv<0x112>(dpp_mv<0x122>(0.f, prv[e2]), cur[e2]);
                        const float pre = bb[n][e2] + w0[n][e2] * g2 + w1[n][e2] * g1 + w2[n][e2] * cur[e2];
                        o[n][e2] = pre;
                    } }
                if (ai == 0 && wr == 0 && m == 0 && fr < 2 && !seq_start) {
                    float* ph = preh + ((size_t)u.pm * 2 + fr) * DFF_ + col0; float* uh = uph + ((size_t)u.pm * 2 + fr) * DFF_ + col0;
                    *(f32x4*)ph = o[0]; *(f32x4*)(ph + 4) = o[1]; *(f32x4*)uh = acc[0][1][0][0]; *(f32x4*)(uh + 4) = acc[0][1][0][1];
                } else {
                    f32x4 v0, v1;
#pragma unroll
                    for (int e2 = 0; e2 < 4; ++e2) { v0[e2] = o[0][e2] * fsigmoid(o[0][e2]) * acc[ai][1][m][0][e2]; v1[e2] = o[1][e2] * fsigmoid(o[1][e2]) * acc[ai][1][m][1][e2]; }
                    u32x4 w; w.x = cvt_pk_bf16(v0[0], v0[1]); w.y = cvt_pk_bf16(v0[2], v0[3]); w.z = cvt_pk_bf16(v1[0], v1[1]); w.w = cvt_pk_bf16(v1[2], v1[3]);
                    *(u32x4*)(U + (size_t)row * DFF_ + col0) = w;
                }
            }
        }
    }
};

struct EpiZLn {
    static constexpr bool PERM = true, AFTER_DRAIN = false;
    const bf16_t* hc; bf16_t* xc; int ldc; const float* ss; const float* stats; const float* lnw; const float* skip;
    __device__ __forceinline__ void operator()(const f32x4 (&acc)[2][2][4][2], const Unit& u, int wr, int wc, int fr, int fq) const {
        const int row0 = u.pm * BM + wr * 64 + fr, col0 = u.pn * BM + wc * 32 + 8 * fq, head = u.pn >> 1;
#pragma unroll
        for (int bj = 0; bj < 2; ++bj) {
            const f32x4 lw0 = *(const f32x4*)(lnw + col0 + bj * HALF), lw1 = *(const f32x4*)(lnw + col0 + bj * HALF + 4), sk0 = *(const f32x4*)(skip + col0 + bj * HALF), sk1 = *(const f32x4*)(skip + col0 + bj * HALF + 4);
#pragma unroll
            for (int ai = 0; ai < 2; ++ai)
#pragma unroll
                for (int m = 0; m < 4; ++m) { const int row = row0 + ai * HALF + m * 16; const size_t off = (size_t)row * ldc + col0 + bj * HALF;
                    const float rs = rsqrtf(ss[row] * (1.f / 2048.f) + 1e-6f); const float mean = stats[((size_t)row * 8 + head) * 2], rstd = stats[((size_t)row * 8 + head) * 2 + 1];
                    const u32x4 h = *(const u32x4*)(hc + off), x = *(const u32x4*)(xc + off);
                    f32x4 z0 = acc[ai][bj][m][0] * rs, z1 = acc[ai][bj][m][1] * rs, o0, o1;
#pragma unroll
                    for (int j = 0; j < 2; ++j) {
                        const float h0 = __uint_as_float(h[j] << 16), h1 = __uint_as_float(h[j] & 0xffff0000u), h2 = __uint_as_float(h[j + 2] << 16), h3 = __uint_as_float(h[j + 2] & 0xffff0000u);
                        const float x0 = __uint_as_float(x[j] << 16), x1 = __uint_as_float(x[j] & 0xffff0000u), x2 = __uint_as_float(x[j + 2] << 16), x3 = __uint_as_float(x[j + 2] & 0xffff0000u);
                        o0[2 * j] = ((h0 - mean) * rstd * lw0[2 * j] + sk0[2 * j] * x0); o0[2 * j + 1] = ((h1 - mean) * rstd * lw0[2 * j + 1] + sk0[2 * j + 1] * x1);
                        o1[2 * j] = ((h2 - mean) * rstd * lw1[2 * j] + sk1[2 * j] * x2); o1[2 * j + 1] = ((h3 - mean) * rstd * lw1[2 * j + 1] + sk1[2 * j + 1] * x3); }
#pragma unroll
                    for (int j = 0; j < 4; ++j) { o0[j] *= z0[j] * fsigmoid(z0[j]); o1[j] *= z1[j] * fsigmoid(z1[j]); }
                    u32x4 w; w.x = cvt_pk_bf16(o0[0], o0[1]); w.y = cvt_pk_bf16(o0[2], o0[3]); w.z = cvt_pk_bf16(o1[0], o1[1]); w.w = cvt_pk_bf16(o1[2], o1[3]);
                    *(u32x4*)(xc + off) = w; }
            asm volatile("" ::: "memory"); }
    }
};

template <class Inner> struct EpiTimed {
    static constexpr bool PERM = Inner::PERM, AFTER_DRAIN = false;
    Inner in; unsigned long long* dbg;
    __device__ __forceinline__ void operator()(const f32x4 (&acc)[2][2][4][2], const Unit& u, int wr, int wc, int fr, int fq) const {
        const bool rec = (threadIdx.x == 0);
        unsigned long long t0 = 0; if (rec) { t0 = (unsigned long long)clock64(); dbg[0] += t0 - dbg[2]; }
        in(acc, u, wr, wc, fr, fq);
        asm volatile("s_waitcnt vmcnt(0)" ::: "memory");
        if (rec) { const unsigned long long t1 = (unsigned long long)clock64(); dbg[1] += t1 - t0; dbg[2] = t1; dbg[3] += 1; }
    }
};
template <class Epi, class Sched, bool ALIGN_EPI = false, bool SP2 = false>
__device__ __forceinline__ void gemm_phase(PG8_LAS unsigned char* lds, const Gemm g, const Sched& S, const Epi& E) {
    int tid_ = threadIdx.x; asm volatile("" : "+v"(tid_));
    const int tid = tid_, wid = __builtin_amdgcn_readfirstlane(tid >> 6), lane = tid & 63, wr = wid >> 2, wc = wid & 3, fr = lane & 15, fq = lane >> 4;
    const int K = g.K, nt = K / BK;
    unsigned voffA[2], voffB[2];
#pragma unroll
    for (int i = 0; i < 2; ++i) { int R, C; stage_rc(tid * 16 + i * 8192, R, C); const int Rb = Epi::PERM ? ((R & ~31) + perm32(R & 31)) : R;
        voffA[i] = (unsigned)(R * K + C) * 2u; voffB[i] = (unsigned)(Rb * K + C) * 2u; }
    const size_t kstep = (size_t)(BK * 2);
    const size_t hstep = (size_t)HALF * K * 2;
    const size_t tstep = 2 * hstep;
    const unsigned ldsw = (unsigned)wid * 1024u;
    const int aoff = lds_byte(wr * 64 + fr, fq * 8), boff = lds_byte(wc * 32 + fr, fq * 8);
#define PG8_SA(b, h) (((b) * 2 + (h)) * HTB)
#define PG8_SB(b, h) ((4 + (b) * 2 + (h)) * HTB)
#ifndef PG8_AUX_B
#define PG8_AUX_B 0
#endif
#ifndef PG8_AUX_A
#define PG8_AUX_A 0
#endif
#define PG8_STAGE(bufoff, gbase, voff) do { _Pragma("unroll") for (int _i = 0; _i < 2; ++_i) { \
        if ((bufoff) >= 4 * HTB) __builtin_amdgcn_global_load_lds((const unsigned*)((const char*)(gbase) + (voff)[_i]), (PG8_LAS unsigned*)(lds + (bufoff) + ldsw + _i * 8192), 16, 0, PG8_AUX_B); \
        else __builtin_amdgcn_global_load_lds((const unsigned*)((const char*)(gbase) + (voff)[_i]), (PG8_LAS unsigned*)(lds + (bufoff) + ldsw + _i * 8192), 16, 0, PG8_AUX_A); } } while (0)
#define PG8_LDA(dst, b, h) do { _Pragma("unroll") for (int m = 0; m < 4; ++m) _Pragma("unroll") for (int k = 0; k < 2; ++k) dst[m][k] = *(const PG8_LAS bf16x8*)(lds + PG8_SA(b, h) + aoff + m * 2048 + k * 1024); } while (0)
#define PG8_LDB(dst, b, h) do { _Pragma("unroll") for (int n = 0; n < 2; ++n) _Pragma("unroll") for (int k = 0; k < 2; ++k) dst[n][k] = *(const PG8_LAS bf16x8*)(lds + PG8_SB(b, h) + boff + n * 2048 + k * 1024); } while (0)
#define PG8_MMA(ai, bj, At, Bt) do { __builtin_amdgcn_s_setprio(1); _Pragma("unroll") for (int m = 0; m < 4; ++m) _Pragma("unroll") for (int n = 0; n < 2; ++n) _Pragma("unroll") for (int k = 0; k < 2; ++k) \
        acc[ai][bj][m][n] = __builtin_amdgcn_mfma_f32_16x16x32_bf16(Bt[n][k], At[m][k], acc[ai][bj][m][n], 0, 0, 0); __builtin_amdgcn_s_setprio(0); } while (0)
#define PG8_WAIT_V(n) asm volatile("s_waitcnt vmcnt(" #n ")" ::: "memory")
#define PG8_WAIT_L(n) asm volatile("s_waitcnt lgkmcnt(" #n ")" ::: "memory")
#define PG8_BAR __builtin_amdgcn_s_barrier()
#define PG8_SCHED __builtin_amdgcn_sched_barrier(0)
    Unit cur, nxt; int ui = 0;
    if (!S.next(0, cur)) return;
    f32x4 acc[2][2][4][2];
#pragma unroll
    for (int a = 0; a < 2; ++a)
#pragma unroll
        for (int b = 0; b < 2; ++b)
#pragma unroll
            for (int m = 0; m < 4; ++m)
#pragma unroll
                for (int n = 0; n < 2; ++n) acc[a][b][m][n] = (f32x4){0.f, 0.f, 0.f, 0.f};
    bf16x8 At[4][2], B0[2][2], B1[2][2];
    const char* cA = (const char*)g.A + (size_t)cur.pm * tstep; const char* cB = (const char*)g.Bt + (size_t)cur.pn * tstep;
    S.a_ready(cur);
    if constexpr (SP2) {
        PG8_STAGE(PG8_SB(0, 0), cB, voffB); PG8_STAGE(PG8_SB(0, 1), cB + hstep, voffB); PG8_STAGE(PG8_SA(0, 0), cA, voffA); PG8_STAGE(PG8_SA(0, 1), cA + hstep, voffA);
        if (wr == 1) PG8_BAR;
        PG8_WAIT_V(2); PG8_BAR;
        PG8_STAGE(PG8_SB(1, 0), cB + kstep, voffB); PG8_STAGE(PG8_SA(1, 0), cA + kstep, voffA); PG8_STAGE(PG8_SB(1, 1), cB + hstep + kstep, voffB);
        PG8_WAIT_V(6); PG8_BAR;
    } else {
        PG8_STAGE(PG8_SB(0, 0), cB, voffB); PG8_STAGE(PG8_SA(0, 0), cA, voffA); PG8_STAGE(PG8_SB(0, 1), cB + hstep, voffB); PG8_STAGE(PG8_SA(0, 1), cA + hstep, voffA);
        if (wr == 1) PG8_BAR;
        PG8_WAIT_V(4); PG8_BAR;
        PG8_STAGE(PG8_SB(1, 0), cB + kstep, voffB); PG8_STAGE(PG8_SA(1, 0), cA + kstep, voffA); PG8_STAGE(PG8_SB(1, 1), cB + hstep + kstep, voffB);
        PG8_WAIT_V(6); PG8_BAR;
    }
    for (;;) {
        const bool has_next = S.next(ui + 1, nxt);
        const char* nA = has_next ? (const char*)g.A + (size_t)nxt.pm * tstep : cA; const char* nB = has_next ? (const char*)g.Bt + (size_t)nxt.pn * tstep : cB;
        for (int t = 0; t < nt; t += 2) {
            const bool last = (t == nt - 2);
            const char* a1 = cA + (size_t)(t + 1) * kstep;
            const char* a2 = last ? nA : cA + (size_t)(t + 2) * kstep; const char* b2 = last ? nB : cB + (size_t)(t + 2) * kstep;
            const char* a3 = a2 + kstep; const char* b3 = b2 + kstep;
            if (last && has_next) S.a_ready(nxt);
            if constexpr (SP2) {
            PG8_LDB(B0, 0, 0); PG8_LDB(B1, 0, 1); PG8_SCHED; PG8_LDA(At, 0, 0); PG8_STAGE(PG8_SA(1, 1), a1 + hstep, voffA);
            PG8_WAIT_V(8); PG8_WAIT_L(0); PG8_BAR; PG8_MMA(0, 0, At, B0); PG8_MMA(0, 1, At, B1); PG8_BAR; PG8_SCHED;
            PG8_LDA(At, 0, 1); PG8_STAGE(PG8_SB(0, 0), b2, voffB); PG8_STAGE(PG8_SB(0, 1), b2 + hstep, voffB); PG8_STAGE(PG8_SA(0, 0), a2, voffA);
            PG8_WAIT_V(8); PG8_WAIT_L(0); PG8_BAR; PG8_MMA(1, 0, At, B0); PG8_MMA(1, 1, At, B1); PG8_BAR; PG8_SCHED;
            PG8_LDB(B0, 1, 0); PG8_LDB(B1, 1, 1); PG8_SCHED; PG8_LDA(At, 1, 0); PG8_STAGE(PG8_SA(0, 1), a2 + hstep, voffA);
            PG8_WAIT_V(8); PG8_WAIT_L(0); PG8_BAR; PG8_MMA(0, 0, At, B0); PG8_MMA(0, 1, At, B1); PG8_BAR; PG8_SCHED;
            PG8_LDA(At, 1, 1); PG8_STAGE(PG8_SB(1, 0), b3, voffB); PG8_STAGE(PG8_SB(1, 1), b3 + hstep, voffB); PG8_STAGE(PG8_SA(1, 0), a3, voffA);
            PG8_WAIT_V(8); PG8_WAIT_L(0); PG8_BAR; PG8_MMA(1, 0, At, B0); PG8_MMA(1, 1, At, B1); PG8_BAR; PG8_SCHED;
            } else {
            PG8_LDB(B0, 0, 0); PG8_SCHED; PG8_LDA(At, 0, 0); PG8_STAGE(PG8_SA(1, 1), a1 + hstep, voffA);
            PG8_WAIT_L(8); PG8_BAR; PG8_WAIT_L(0); PG8_MMA(0, 0, At, B0); PG8_BAR; PG8_SCHED;
            PG8_LDB(B1, 0, 1); PG8_STAGE(PG8_SB(0, 0), b2, voffB);
            PG8_BAR; PG8_WAIT_L(0); PG8_MMA(0, 1, At, B1); PG8_BAR;
            PG8_LDA(At, 0, 1); PG8_STAGE(PG8_SA(0, 0), a2, voffA);
            PG8_BAR; PG8_WAIT_L(0); PG8_MMA(1, 0, At, B0); PG8_BAR; PG8_SCHED;
            PG8_STAGE(PG8_SB(0, 1), b2 + hstep, voffB);
            PG8_WAIT_V(6); PG8_BAR; PG8_MMA(1, 1, At, B1); PG8_BAR;
            PG8_LDB(B0, 1, 0); PG8_SCHED; PG8_LDA(At, 1, 0); PG8_STAGE(PG8_SA(0, 1), a2 + hstep, voffA);
            PG8_WAIT_L(8); PG8_BAR; PG8_WAIT_L(0); PG8_MMA(0, 0, At, B0); PG8_BAR; PG8_SCHED;
            PG8_LDB(B1, 1, 1); PG8_STAGE(PG8_SB(1, 0), b3, voffB);
            PG8_BAR; PG8_WAIT_L(0); PG8_MMA(0, 1, At, B1); PG8_BAR;
            PG8_LDA(At, 1, 1); PG8_STAGE(PG8_SA(1, 0), a3, voffA);
            PG8_BAR; PG8_WAIT_L(0); PG8_MMA(1, 0, At, B0); PG8_BAR; PG8_SCHED;
            PG8_STAGE(PG8_SB(1, 1), b3 + hstep, voffB);
            PG8_WAIT_V(6); PG8_BAR; PG8_MMA(1, 1, At, B1); PG8_BAR;
            }
        }
        if constexpr (ALIGN_EPI) { if (wr == 0) PG8_BAR; }
        if constexpr (!Epi::AFTER_DRAIN) { E(acc, cur, wr, wc, fr, fq); S.done(cur); }
        if (!has_next) break;
#pragma unroll
        for (int a = 0; a < 2; ++a)
#pragma unroll
            for (int b = 0; b < 2; ++b)
#pragma unroll
                for (int m = 0; m < 4; ++m)
#pragma unroll
                    for (int n = 0; n < 2; ++n) acc[a][b][m][n] = (f32x4){0.f, 0.f, 0.f, 0.f};
        cur = nxt; cA = nA; cB = nB; ++ui;
        if constexpr (ALIGN_EPI) { if (wr == 1) PG8_BAR; }
    }
    PG8_WAIT_V(0);
    if constexpr (!ALIGN_EPI) { if (wr == 0) PG8_BAR; }
    PG8_BAR;
    if constexpr (Epi::AFTER_DRAIN) { E.fused(acc, cur, wr, wc, fr, fq, lds, wid, lane); S.done(cur); }
#undef PG8_SA
#undef PG8_SB
#undef PG8_STAGE
#undef PG8_LDA
#undef PG8_LDB
#undef PG8_MMA
#undef PG8_WAIT_V
#undef PG8_WAIT_L
#undef PG8_BAR
#undef PG8_SCHED
}
}
constexpr int NWAVES = 8, NTHR = 512;
constexpr int BATCH = 8, SEQ = 4096, DM = 2048, M = BATCH * SEQ;
constexpr int EIN = 5408, EIN_PAD = 5632;
constexpr int LRK = 384, LRN = 3072;
constexpr int CW = 4096, CHD = 512;
constexpr int DFF = 5632, GUN = 2 * DFF;
constexpr int MH = M / 2;
constexpr size_t MiB = 1u << 20;
constexpr size_t WS_CTL = 0, CTL_ZERO_BYTES = 1024 * 1024;
constexpr size_t WS_SS = 256 * 1024;
constexpr size_t WS_SSP = 800 * MiB;
constexpr size_t WS_STATS = 812 * MiB;
constexpr size_t WS_HRAW0 = 249 * MiB + 376 * MiB;
constexpr size_t WS_W_IN_O = 1 * MiB, WS_W_OUT_O = 33 * MiB, WS_W_GU1 = 49 * MiB, WS_W_DN1 = 93 * MiB;
constexpr size_t WS_SMALL = 115 * MiB;
constexpr size_t WS_W_LR = WS_SMALL, WS_W_RG = WS_SMALL + 5 * MiB / 2, WS_GT = WS_SMALL + 3 * MiB, WS_P4 = WS_SMALL + 13 * MiB / 4, WS_GATES = WS_SMALL + 7 * MiB / 2, WS_LRB = WS_SMALL + 11 * MiB / 2;
constexpr size_t WS_H = 121 * MiB;
constexpr size_t WS_BIG = 249 * MiB;
constexpr size_t WS_PROJ = WS_BIG, WS_LRA = WS_BIG + 352 * MiB, WS_LR = WS_BIG + 376 * MiB;
constexpr size_t WS_U = WS_BIG, WS_GTAIL = WS_BIG + 352 * MiB, WS_PREH = WS_BIG + 358 * MiB, WS_UPH = WS_BIG + 364 * MiB;
constexpr size_t WS_XM = WS_BIG, WS_XC = WS_BIG + 256 * MiB, WS_KPP = WS_BIG + 512 * MiB;
constexpr size_t WS_W_IN_E = 928 * MiB, WS_W_OUT_E = 950 * MiB, WS_W_GU0 = 958 * MiB, WS_W_DN0 = 1002 * MiB, WS_END = 1024 * MiB;
static_assert(WS_LR + (size_t)M * LRN * 2 <= WS_W_IN_E && WS_UPH + 6 * MiB <= WS_W_IN_E && WS_KPP + (size_t)M * CW * 2 <= WS_END, "d_ws map");
constexpr int LDS_BYTES = 163840, MISC_OFF = LDS_BYTES - 256, HALO_OFF = 131072;

#define GAS __attribute__((address_space(1)))
#define LAS __attribute__((address_space(3)))
typedef unsigned short bf16;
typedef unsigned v4u __attribute__((ext_vector_type(4)));
typedef float f32x4 __attribute__((ext_vector_type(4)));
typedef short bf16x8 __attribute__((ext_vector_type(8)));
typedef GAS unsigned gu32;
typedef GAS unsigned long long gu64;
#define RLX_AGENT __ATOMIC_RELAXED, __HIP_MEMORY_SCOPE_AGENT
#define LDS_WAIT() asm volatile("s_waitcnt lgkmcnt(0)" ::: "memory")
#define VM_WAIT() asm volatile("s_waitcnt vmcnt(0)" ::: "memory")
__device__ __forceinline__ unsigned long long rt() { return __builtin_amdgcn_s_memrealtime(); }
__device__ __forceinline__ unsigned f2bf(float f) { unsigned u = __builtin_bit_cast(unsigned, f); return (u + 0x7fffu + ((u >> 16) & 1u)) >> 16; }
__device__ __forceinline__ unsigned pk2(float lo, float hi) { return f2bf(lo) | (f2bf(hi) << 16); }
#define XB_TMO      128
#define XB_XCNT(j)  (256  + 64 * (j))
#define XB_XSUB(j)  (1280 + 64 * (j))
#define XB_XGEN(j)  (2304 + 64 * (j))
#define XB_TOP      3328
#define XB_TOPGEN   3392
#define XCD_BAR_WORDS 3456
#define XB_SPIN_CAP (1u << 18)

__device__ __forceinline__ unsigned xb_ld(unsigned* p)              { return __hip_atomic_load(p, __ATOMIC_RELAXED, __HIP_MEMORY_SCOPE_AGENT); }
__device__ __forceinline__ unsigned xb_add(unsigned* p, unsigned v) { return __hip_atomic_fetch_add(p, v, __ATOMIC_RELAXED, __HIP_MEMORY_SCOPE_AGENT); }
__device__ __forceinline__ unsigned xb_xcc_id() { return (unsigned)__builtin_amdgcn_s_getreg((3 << 11) | 20) & 0xFu; }
#define XB_SPIN(cond, bar) do { unsigned _sp = 0; while (cond) { __builtin_amdgcn_s_sleep(1); \
    if ((++_sp & 255u) == 0u) { if (xb_ld(&(bar)[XB_TMO])) break; if (_sp > XB_SPIN_CAP) { atomicAdd(&(bar)[XB_TMO], 1u); break; } } } } while (0)

struct XcdBarrier {
    unsigned* bar; unsigned x;
    volatile LAS unsigned* st;
};

__device__ __forceinline__ XcdBarrier xcd_barrier_post(unsigned* bar, volatile LAS unsigned* st) {
    XcdBarrier b; b.bar = bar; b.x = xb_xcc_id(); b.st = st;
    if (threadIdx.x == 0) (void)xb_add(&bar[XB_XCNT(b.x)], 1u);
    return b;
}
__device__ __forceinline__ void xcd_barrier_complete(unsigned* bar, unsigned x, unsigned& nloc, unsigned& nx) {
    const unsigned G = gridDim.x * gridDim.y * gridDim.z;
    unsigned sum, cnt, mine, sp = 0u;
    for (;;) {
        sum = 0u; cnt = 0u; mine = 0u;
#pragma unroll
        for (unsigned j = 0; j < 16; ++j) { const unsigned c = xb_ld(&bar[XB_XCNT(j)]); sum += c; cnt += (c > 0u) ? 1u : 0u; mine = (j == x) ? c : mine; }
        if (sum == G) break;
        __builtin_amdgcn_s_sleep(1);
        if ((++sp & 255u) == 0u) { if (xb_ld(&bar[XB_TMO])) break; if (sp > XB_SPIN_CAP) { atomicAdd(&bar[XB_TMO], 1u); break; } }
    }
    nloc = mine > 0u ? mine : 1u; nx = cnt > 0u ? cnt : 1u;
}

__device__ __forceinline__ void xcd_barrier(const XcdBarrier& b) {
    asm volatile("s_waitcnt vmcnt(0)" ::: "memory");
    __syncthreads();
    if (threadIdx.x == 0) {
        unsigned* bar = b.bar;
        __builtin_amdgcn_s_waitcnt(0);
        unsigned nloc = b.st[0], nx = b.st[1];
        if (nloc == 0u) { xcd_barrier_complete(bar, b.x, nloc, nx); b.st[0] = nloc; b.st[1] = nx; }
        const unsigned old = xb_add(&bar[XB_XSUB(b.x)], 1u);
        const unsigned gen = old / nloc;
        if (old + 1u == (gen + 1u) * nloc) {
            __builtin_amdgcn_fence(__ATOMIC_RELEASE, "agent");
            asm volatile("s_waitcnt vmcnt(0)" ::: "memory");
            const unsigned og = xb_add(&bar[XB_TOP], 1u);
            const unsigned tg = og / nx;
            if (og + 1u == (tg + 1u) * nx) xb_add(&bar[XB_TOPGEN], 1u);
            else XB_SPIN(xb_ld(&bar[XB_TOPGEN]) == tg, bar);
            __builtin_amdgcn_fence(__ATOMIC_ACQUIRE, "agent");
            xb_add(&bar[XB_XGEN(b.x)], 1u);
            asm volatile("s_waitcnt vmcnt(0)" ::: "memory");
        } else {
            XB_SPIN(xb_ld(&bar[XB_XGEN(b.x)]) == gen, bar);
            __builtin_amdgcn_fence(__ATOMIC_ACQUIRE, "agent");
            asm volatile("s_waitcnt vmcnt(0)" ::: "memory");
        }
    }
    __syncthreads();
}

typedef float f32x2 __attribute__((ext_vector_type(2)));
typedef short s16x4 __attribute__((ext_vector_type(4)));
typedef unsigned v2u __attribute__((ext_vector_type(2)));
#define LBAR() do { asm volatile("s_waitcnt lgkmcnt(0)" ::: "memory"); __builtin_amdgcn_s_barrier(); asm volatile("" ::: "memory"); } while (0)
struct Frame {
    LAS unsigned char* lds;
    int tid, lane, wave, G, gw, NGW;
};
template <int CTRL> __device__ __forceinline__ float dpp_x(float x) { return __int_as_float(__builtin_amdgcn_update_dpp(0, __float_as_int(x), CTRL, 0xf, 0xf, true)); }
__device__ __forceinline__ float wave_sum(float v) {
    v += dpp_x<0xB1>(v);
    v += dpp_x<0x4E>(v);
    v += dpp_x<0x141>(v);
    v += dpp_x<0x140>(v);
    v += __shfl_xor(v, 16); v += __shfl_xor(v, 32);
    return v;
}
__device__ __forceinline__ float bflo(unsigned w) { return __uint_as_float(w << 16); }
__device__ __forceinline__ float bfhi(unsigned w) { return __uint_as_float(w & 0xffff0000u); }
__device__ __forceinline__ float bf1(unsigned short b) { return __uint_as_float(((unsigned)b) << 16); }
__device__ __forceinline__ unsigned cvtpk(float lo, float hi) { return pg8::cvt_pk_bf16(lo, hi); }
__device__ __forceinline__ float fsig(float x) { return __builtin_amdgcn_rcpf(1.0f + __expf(-x)); }
__device__ __forceinline__ float fsilu(float x) { return x * fsig(x); }
__device__ __forceinline__ float ftanh(float x) { const float xc = fminf(fmaxf(x, -15.f), 15.f); const float t = __expf(2.f * xc); return (t - 1.f) * __builtin_amdgcn_rcpf(t + 1.f); }
__device__ __forceinline__ float fgelu_tanh(float x) { return 0.5f * x * (1.f + ftanh(0.7978845608f * (x + 0.044715f * x * x * x))); }

__device__ __forceinline__ void p0_transpose_item(const float* W, int K, int N, bf16* WT, int drow, LAS float* scr, int kb, int n0, int lane, const float* gain) {
    const int k0 = 64 * kb;
    float wv_[32];
#pragma unroll
    for (int i = 0; i < 32; ++i) { const int kk = 2 * i + (lane >> 5); wv_[i] = W[(size_t)(k0 + kk) * N + n0 + (lane & 31)]; }
#pragma unroll
    for (int i = 0; i < 32; ++i) { const int kk = 2 * i + (lane >> 5); scr[kk * 33 + (lane & 31)] = wv_[i] * (gain ? gain[k0 + kk] : 1.f); }
    LDS_WAIT(); asm volatile("" ::: "memory");
    const int c = lane & 7;
#pragma unroll
    for (int j = 0; j < 4; ++j) { const int n = (lane >> 3) + 8 * j; const LAS float* s = scr + (8 * c) * 33 + n;
        v4u o; o.x = pk2(s[0 * 33], s[1 * 33]); o.y = pk2(s[2 * 33], s[3 * 33]); o.z = pk2(s[4 * 33], s[5 * 33]); o.w = pk2(s[6 * 33], s[7 * 33]);
        *(GAS v4u*)(WT + (size_t)(drow + n) * K + k0 + 8 * c) = o; }
    LDS_WAIT(); asm volatile("" ::: "memory");
}
__device__ __forceinline__ void p0_matrix(Frame& F, const float* W, int K, int N, bf16* WT, int mode, LAS float* scr, const float* gain = nullptr) {
    const int nblk = N / 32, items = (K / 64) * nblk;
    for (int it = F.gw; it < items; it += F.NGW) {
        const int kb = it / nblk, n0 = 32 * (it % nblk);
        const int drow = mode == 0 ? n0 : (256 * (n0 >> 7) + (n0 & 127) + (mode == 2 ? 128 : 0));
        p0_transpose_item(W, K, N, WT, drow, scr, kb, n0, F.lane, gain);
    }
}
struct Ptrs {
    const float* in[41]; float* out; unsigned char* ws;
};
#define IN_X 0
#define IN_EVEN_NORM 1
#define IN_EVEN_W_IN 2
#define IN_A_CONV_W 3
#define IN_A_CONV_B 4
#define IN_A_W_R 5
#define IN_A_B_R 6
#define IN_A_W_I 7
#define IN_A_B_I 8
#define IN_A_LAMBDA 9
#define IN_B_MU 10
#define IN_B_W0 11
#define IN_B_W_UP 12
#define IN_B_A0 13
#define IN_B_A_UP 14
#define IN_B_G_UP 15
#define IN_B_K_K 16
#define IN_B_K_A 17
#define IN_B_R_K 18
#define IN_B_LN_W 19
#define IN_B_LN_B 20
#define IN_EVEN_W_OUT 21
#define IN_ODD_NORM 22
#define IN_ODD_W_IN 23
#define IN_C_CONV_W 24
#define IN_C_CONV_B 25
#define IN_C_W_Q 26
#define IN_C_W_K 27
#define IN_C_W_V 28
#define IN_C_W_IF 29
#define IN_C_B_IF 30
#define IN_C_LN_W 31
#define IN_C_SKIP 32
#define IN_ODD_W_OUT 33
#define IN_FFN_NORM 34
#define IN_FFN_W_GATE 35
#define IN_FFN_W_UP 36
#define IN_FFN_CONV_W 37
#define IN_FFN_CONV_B 38
#define IN_FFN_W_DOWN 39
#define IN_FINAL_NORM 40

__device__ __forceinline__ void ph_prologue(Frame& F, const Ptrs& P) {
    LAS float* scr = (LAS float*)(F.lds + F.wave * 16384);
    unsigned char* ws = P.ws;
    p0_matrix(F, P.in[IN_EVEN_W_IN], DM, EIN, (bf16*)(ws + WS_W_IN_E), 0, scr, P.in[IN_EVEN_NORM]);
    p0_matrix(F, P.in[IN_EVEN_W_OUT], DM, DM, (bf16*)(ws + WS_W_OUT_E), 0, scr);
    const size_t gt = (size_t)F.gw * 64 + F.lane, GT = (size_t)F.NGW * 64;
    { v4u* z = (v4u*)(ws + WS_W_IN_E + (size_t)EIN * DM * 2); const size_t n = (size_t)(EIN_PAD - EIN) * DM * 2 / 16; for (size_t i = gt; i < n; i += GT) z[i] = (v4u){0u, 0u, 0u, 0u}; }
    { bf16* B = (bf16*)(ws + WS_W_LR); const float* wup = P.in[IN_B_W_UP]; const float* aup = P.in[IN_B_A_UP]; const float* gup = P.in[IN_B_G_UP];
      for (size_t i = gt; i < (size_t)LRN * LRK; i += GT) { const int n = (int)(i / LRK), k = (int)(i % LRK); float v = 0.f;
          if (n < 1024) { if (k < 64) v = wup[(size_t)k * 1024 + n]; }
          else if (n < 2048) { if (k >= 64 && k < 128) v = aup[(size_t)(k - 64) * 1024 + (n - 1024)]; }
          else { if (k >= 128 && k < 288) v = gup[(size_t)(k - 128) * 1024 + (n - 2048)]; }
          B[i] = (bf16)f2bf(v); } }
    { float* lb = (float*)(ws + WS_LRB); for (size_t i = gt; i < (size_t)LRN; i += GT) lb[i] = i < 1024 ? P.in[IN_B_W0][i] : (i < 2048 ? P.in[IN_B_A0][i - 1024] : 0.f); }
    { bf16* B = (bf16*)(ws + WS_W_RG); const float* wr = P.in[IN_A_W_R]; const float* wi = P.in[IN_A_W_I];
      for (size_t i = gt; i < (size_t)2 * 8 * 128 * 128; i += GT) { const int which = (int)(i >> 17), g = (int)((i >> 14) & 7), n = (int)((i >> 7) & 127), k = (int)(i & 127);
          const float* w = which ? wi : wr; B[i] = (bf16)f2bf(w[((size_t)g * 128 + k) * 128 + n]); } }
    { float* P4 = (float*)(ws + WS_P4); const float* wq = P.in[IN_C_W_Q]; const float* wk = P.in[IN_C_W_K];
      for (size_t i = gt; i < (size_t)1024 * 16; i += GT) { const int j = (int)(i >> 4), b = (int)((i >> 2) & 3), ii = (int)(i & 3); float s = 0.f;
#pragma unroll
          for (int a = 0; a < 4; ++a) s += wk[j * 16 + b * 4 + a] * wq[j * 16 + ii * 4 + a];
          P4[i] = s * 0.04419417382f; } }
    { bf16* Gt = (bf16*)(ws + WS_GT); const float* wq = P.in[IN_C_W_Q]; const float* wk = P.in[IN_C_W_K]; const float* wv = P.in[IN_C_W_V]; const float* wif = P.in[IN_C_W_IF];
      for (size_t i = gt; i < (size_t)16 * 8192; i += GT) { const int g = (int)(i >> 13), kidx = (int)(i & 8191), c = kidx & 4095, j = c >> 2, ii = c & 3; float s = 0.f;
          if (kidx < 4096) {
#pragma unroll
              for (int a = 0; a < 4; ++a) s += wq[j * 16 + ii * 4 + a] * wif[((size_t)0 * CW + 4 * j + a) * 16 + g] + wk[j * 16 + ii * 4 + a] * wif[((size_t)1 * CW + 4 * j + a) * 16 + g];
          } else {
#pragma unroll
              for (int a = 0; a < 4; ++a) s += wv[j * 16 + ii * 4 + a] * wif[((size_t)2 * CW + 4 * j + a) * 16 + g];
          }
          Gt[i] = (bf16)f2bf(s); } }
}
__device__ __forceinline__ void ph_late_weights(Frame& F, const Ptrs& P) {
    LAS float* scr = (LAS float*)(F.lds + F.wave * 16384);
    unsigned char* ws = P.ws;
    p0_matrix(F, P.in[IN_FFN_W_GATE], DM, DFF, (bf16*)(ws + WS_W_GU0), 1, scr, P.in[IN_FFN_NORM]);
    p0_matrix(F, P.in[IN_FFN_W_UP], DM, DFF, (bf16*)(ws + WS_W_GU0), 2, scr, P.in[IN_FFN_NORM]);
    p0_matrix(F, P.in[IN_FFN_W_DOWN], DFF, DM, (bf16*)(ws + WS_W_DN0), 0, scr);
    p0_matrix(F, P.in[IN_FFN_W_GATE] + (size_t)DM * DFF, DM, DFF, (bf16*)(ws + WS_W_GU1), 1, scr, P.in[IN_FFN_NORM] + DM);
    p0_matrix(F, P.in[IN_FFN_W_UP] + (size_t)DM * DFF, DM, DFF, (bf16*)(ws + WS_W_GU1), 2, scr, P.in[IN_FFN_NORM] + DM);
    p0_matrix(F, P.in[IN_FFN_W_DOWN] + (size_t)DFF * DM, DFF, DM, (bf16*)(ws + WS_W_DN1), 0, scr);
    p0_matrix(F, P.in[IN_ODD_W_IN], DM, 2 * CW, (bf16*)(ws + WS_W_IN_O), 0, scr, P.in[IN_ODD_NORM]);
    p0_matrix(F, P.in[IN_ODD_W_OUT], CW, DM, (bf16*)(ws + WS_W_OUT_O), 0, scr);
}
__device__ __forceinline__ void ph_rmsnorm_bf16(Frame& F, const float* src, const float* gain, bf16* dst) {
    for (int m = F.gw; m < M; m += F.NGW) {
        const GAS f32x4* xr = (const GAS f32x4*)(src + (size_t)m * DM) + F.lane;
        f32x4 v[8]; float s = 0.f;
#pragma unroll
        for (int j = 0; j < 8; ++j) { v[j] = xr[64 * j]; s += (v[j].x * v[j].x + v[j].y * v[j].y) + (v[j].z * v[j].z + v[j].w * v[j].w); }
        const float rstd = rsqrtf(wave_sum(s) * (1.f / DM) + 1e-6f);
        GAS v2u* o8 = (GAS v2u*)(dst + (size_t)m * DM) + F.lane;
#pragma unroll
        for (int j = 0; j < 8; ++j) { const f32x4 g = ((const GAS f32x4*)gain)[F.lane + 64 * j];
            v2u o; o.x = cvtpk(v[j].x * rstd * g.x, v[j].y * rstd * g.y); o.y = cvtpk(v[j].z * rstd * g.z, v[j].w * rstd * g.w); o8[64 * j] = o; }
    }
}
__device__ __forceinline__ void ph_cast_ss(Frame& F, const float* src, bf16* dst, float* ss) {
    for (int m = F.gw; m < M; m += F.NGW) {
        const GAS f32x4* xr = (const GAS f32x4*)(src + (size_t)m * DM) + F.lane;
        f32x4 v[8]; float s = 0.f;
#pragma unroll
        for (int j = 0; j < 8; ++j) { v[j] = xr[64 * j]; s += (v[j].x * v[j].x + v[j].y * v[j].y) + (v[j].z * v[j].z + v[j].w * v[j].w); }
        s = wave_sum(s);
        GAS v2u* o8 = (GAS v2u*)(dst + (size_t)m * DM) + F.lane;
#pragma unroll
        for (int j = 0; j < 8; ++j) { v2u o; o.x = cvtpk(v[j].x, v[j].y); o.y = cvtpk(v[j].z, v[j].w); o8[64 * j] = o; }
        if (F.lane == 0) ss[m] = s;
    }
}
__device__ __forceinline__ void ph_rmsnorm_f32_inplace(Frame& F, float* x, const float* gain) {
    for (int m = F.gw; m < M; m += F.NGW) {
        GAS f32x4* xr = (GAS f32x4*)(x + (size_t)m * DM) + F.lane;
        f32x4 v[8]; float s = 0.f;
#pragma unroll
        for (int j = 0; j < 8; ++j) { v[j] = xr[64 * j]; s += (v[j].x * v[j].x + v[j].y * v[j].y) + (v[j].z * v[j].z + v[j].w * v[j].w); }
        const float rstd = rsqrtf(wave_sum(s) * (1.f / DM) + 1e-6f);
#pragma unroll
        for (int j = 0; j < 8; ++j) { const f32x4 g = ((const GAS f32x4*)gain)[F.lane + 64 * j]; xr[64 * j] = v[j] * rstd * g; }
    }
}
__device__ __forceinline__ void ph_rmsnorm_final(Frame& F, const bf16* x, const float* gain, float* out) {
    for (int m = F.gw; m < M; m += F.NGW) {
        const GAS v4u* xr = (const GAS v4u*)(x + (size_t)m * DM) + F.lane;
        v4u v[4]; float s = 0.f;
#pragma unroll
        for (int j = 0; j < 4; ++j) { v[j] = xr[64 * j];
            s += ((bflo(v[j].x) * bflo(v[j].x) + bfhi(v[j].x) * bfhi(v[j].x)) + (bflo(v[j].y) * bflo(v[j].y) + bfhi(v[j].y) * bfhi(v[j].y))) + ((bflo(v[j].z) * bflo(v[j].z) + bfhi(v[j].z) * bfhi(v[j].z)) + (bflo(v[j].w) * bflo(v[j].w) + bfhi(v[j].w) * bfhi(v[j].w))); }
        const float rstd = rsqrtf(wave_sum(s) * (1.f / DM) + 1e-6f);
        GAS f32x4* o = (GAS f32x4*)(out + (size_t)m * DM) + 2 * F.lane;
#pragma unroll
        for (int j = 0; j < 4; ++j) { const f32x4 g0 = ((const GAS f32x4*)gain)[2 * F.lane + 128 * j], g1 = ((const GAS f32x4*)gain)[2 * F.lane + 128 * j + 1];
            o[128 * j] = (f32x4){bflo(v[j].x) * rstd * g0.x, bfhi(v[j].x) * rstd * g0.y, bflo(v[j].y) * rstd * g0.z, bfhi(v[j].y) * rstd * g0.w};
            o[128 * j + 1] = (f32x4){bflo(v[j].z) * rstd * g1.x, bfhi(v[j].z) * rstd * g1.y, bflo(v[j].w) * rstd * g1.z, bfhi(v[j].w) * rstd * g1.w}; }
    }
}
__device__ __forceinline__ void ph_ss_reduce(Frame& F, const float* ssp, float* ss) {
    for (int m = F.gw * 64 + F.lane; m < M; m += F.NGW * 64) { const GAS f32x4* p = (const GAS f32x4*)(ssp + (size_t)m * 32); float s = 0.f;
#pragma unroll
        for (int i = 0; i < 8; ++i) { const f32x4 v = p[i]; s += (v.x + v.y) + (v.z + v.w); }
        ss[m] = s; }
}
__device__ __forceinline__ void ph_lra(Frame& F, const Ptrs& P) {
    const bf16* proj = (const bf16*)(P.ws + WS_PROJ); bf16* lra = (bf16*)(P.ws + WS_LRA); const float* mu = P.in[IN_B_MU];
    const size_t gt = (size_t)F.gw * 64 + F.lane, GT = (size_t)F.NGW * 64;
    for (size_t i = gt; i < (size_t)M * 48; i += GT) {
        const int m = (int)(i / 48), g8 = (int)(i % 48), c0 = 8 * g8; v4u o = (v4u){0u, 0u, 0u, 0u};
        if (c0 < 288) {
            const v4u cur = *(const GAS v4u*)(proj + (size_t)m * EIN_PAD + 5120 + c0);
            v4u prv = (v4u){0u, 0u, 0u, 0u}; if ((m & (SEQ - 1)) != 0) prv = *(const GAS v4u*)(proj + (size_t)(m - 1) * EIN_PAD + 5120 + c0);
            const f32x4 mu0 = *(const GAS f32x4*)(mu + 3072 + c0), mu1 = *(const GAS f32x4*)(mu + 3072 + c0 + 4);
            float v[8];
#pragma unroll
            for (int j = 0; j < 4; ++j) { const float c_lo = bflo(cur[j]), c_hi = bfhi(cur[j]), p_lo = bflo(prv[j]), p_hi = bfhi(prv[j]);
                const float m_lo = (2 * j < 4) ? mu0[2 * j] : mu1[2 * j - 4], m_hi = (2 * j + 1 < 4) ? mu0[2 * j + 1] : mu1[2 * j + 1 - 4];
                v[2 * j] = c_lo + (p_lo - c_lo) * m_lo; v[2 * j + 1] = c_hi + (p_hi - c_hi) * m_hi; }
#pragma unroll
            for (int j = 0; j < 8; ++j) v[j] = c0 < 64 ? ftanh(v[j]) : (c0 < 128 ? v[j] : fsig(v[j]));
            o.x = cvtpk(v[0], v[1]); o.y = cvtpk(v[2], v[3]); o.z = cvtpk(v[4], v[5]); o.w = cvtpk(v[6], v[7]);
        }
        *(GAS v4u*)(lra + (size_t)m * LRK + c0) = o;
    }
}
__device__ __forceinline__ void ph_ffn_fix(Frame& F, bf16* U, const float* cw, const float* gtail, const float* preh, const float* uph) {
    const size_t gt = (size_t)F.gw * 64 + F.lane, GT = (size_t)F.NGW * 64;
    constexpr int C4 = DFF / 4;
    for (size_t i = gt; i < (size_t)(M / 256) * 2 * C4; i += GT) {
        const int pm = (int)(i / (2 * C4)), fr = (int)((i / C4) & 1), c = 4 * (int)(i % C4);
        if ((pm & 15) == 0) continue;
        const f32x4 pre0 = *(const GAS f32x4*)(preh + ((size_t)pm * 2 + fr) * DFF + c), up = *(const GAS f32x4*)(uph + ((size_t)pm * 2 + fr) * DFF + c);
        const f32x4 ga = *(const GAS f32x4*)(gtail + ((size_t)(pm - 1) * 2 + 0) * DFF + c), gb = *(const GAS f32x4*)(gtail + ((size_t)(pm - 1) * 2 + 1) * DFF + c);
        const f32x4 w0 = *(const GAS f32x4*)(cw + c), w1 = *(const GAS f32x4*)(cw + DFF + c);
        const f32x4 pre = fr == 0 ? (pre0 + w0 * ga + w1 * gb) : (pre0 + w0 * gb);
        v2u o; o.x = cvtpk(fsilu(pre.x) * up.x, fsilu(pre.y) * up.y); o.y = cvtpk(fsilu(pre.z) * up.z, fsilu(pre.w) * up.w);
        *(GAS v2u*)(U + (size_t)(pm * 256 + fr) * DFF + c) = o;
    }
}

constexpr int RW_R = 0, RW_W = 16384, RW_K = 32768, RW_A = 49152, RW_B = 65536, RW_V = 81920, RW_Y = 98304, RW_BONUS = 114688;
__device__ __forceinline__ void rwkv_unit(Frame& F, const Ptrs& P, int unit) {
    const int b = unit >> 4, h = unit & 15, col = h * 64 + F.lane;
    const bf16* proj = (const bf16*)(P.ws + WS_PROJ); const bf16* lr = (const bf16*)(P.ws + WS_LR); bf16* ycat = (bf16*)(P.ws + WS_H);
    const float* mu = P.in[IN_B_MU];
    const float mu_r = mu[col], mu_k = mu[1024 + col], mu_v = mu[2048 + col];
    const float k_k = P.in[IN_B_K_K][col], k_a = P.in[IN_B_K_A][col], r_k = P.in[IN_B_R_K][col], ln_w = P.in[IN_B_LN_W][col], ln_b = P.in[IN_B_LN_B][col];
    LAS float* Rb = (LAS float*)(F.lds + RW_R); LAS float* Wb = (LAS float*)(F.lds + RW_W); LAS float* Kb = (LAS float*)(F.lds + RW_K);
    LAS float* Ab = (LAS float*)(F.lds + RW_A); LAS float* Bb = (LAS float*)(F.lds + RW_B); LAS float* Vb = (LAS float*)(F.lds + RW_V);
    LAS float* Yb = (LAS float*)(F.lds + RW_Y); LAS float* Bon = (LAS float*)(F.lds + RW_BONUS);
    float s[64];
#pragma unroll
    for (int k = 0; k < 64; ++k) s[k] = 0.f;
    for (int ch = 0; ch < SEQ / 64; ++ch) {
        const int t0 = ch * 64;
#pragma unroll 2
        for (int i = 0; i < 8; ++i) {
            const int tt = F.wave * 8 + i, t = t0 + tt; const size_t m = (size_t)b * SEQ + t;
            const bf16* pr = proj + m * EIN_PAD + 2048 + col;
            float r = bf1(pr[0]), k = bf1(pr[1024]), v = bf1(pr[2048]);
            float rp = 0.f, kp = 0.f, vp = 0.f;
            if (t > 0) { rp = bf1(pr[-EIN_PAD]); kp = bf1(pr[1024 - EIN_PAD]); vp = bf1(pr[2048 - EIN_PAD]); }
            r += (rp - r) * mu_r; k += (kp - k) * mu_k; v += (vp - v) * mu_v;
            const float lw = -0.60653066f * fsig(bf1(lr[m * LRN + col])), a = fsig(bf1(lr[m * LRN + 1024 + col]));
            float kk = k * k_k; const float ss = wave_sum(kk * kk); kk *= rsqrtf(fmaxf(ss, 1e-12f));
            const float kq = k * (1.f + (a - 1.f) * k_a);
            Rb[tt * 64 + F.lane] = r; Wb[tt * 64 + F.lane] = __expf(lw); Kb[tt * 64 + F.lane] = kq; Ab[tt * 64 + F.lane] = -kk; Bb[tt * 64 + F.lane] = kk * a; Vb[tt * 64 + F.lane] = v;
            const float bo = wave_sum(r * kq * r_k); if (F.lane == 0) Bon[tt] = bo;
        }
        __syncthreads();
        if (F.wave == 0) {
            for (int tt = 0; tt < 64; ++tt) {
                const LAS f32x4* A4 = (const LAS f32x4*)(Ab + tt * 64); const LAS f32x4* W4 = (const LAS f32x4*)(Wb + tt * 64); const LAS f32x4* B4 = (const LAS f32x4*)(Bb + tt * 64);
                const LAS f32x4* K4 = (const LAS f32x4*)(Kb + tt * 64); const LAS f32x4* R4 = (const LAS f32x4*)(Rb + tt * 64);
                float sa0 = 0.f, sa1 = 0.f, sa2 = 0.f, sa3 = 0.f;
#pragma unroll
                for (int q = 0; q < 16; ++q) { const f32x4 a = A4[q]; sa0 += s[4 * q] * a.x; sa1 += s[4 * q + 1] * a.y; sa2 += s[4 * q + 2] * a.z; sa3 += s[4 * q + 3] * a.w; }
                const float sa = (sa0 + sa1) + (sa2 + sa3), vv = Vb[tt * 64 + F.lane];
                float y0 = 0.f, y1 = 0.f, y2 = 0.f, y3 = 0.f;
#pragma unroll
                for (int q = 0; q < 16; ++q) { const f32x4 w = W4[q], bb = B4[q], kk = K4[q], rr = R4[q];
                    s[4 * q] = s[4 * q] * w.x + sa * bb.x + vv * kk.x; s[4 * q + 1] = s[4 * q + 1] * w.y + sa * bb.y + vv * kk.y;
                    s[4 * q + 2] = s[4 * q + 2] * w.z + sa * bb.z + vv * kk.z; s[4 * q + 3] = s[4 * q + 3] * w.w + sa * bb.w + vv * kk.w;
                    y0 += s[4 * q] * rr.x; y1 += s[4 * q + 1] * rr.y; y2 += s[4 * q + 2] * rr.z; y3 += s[4 * q + 3] * rr.w; }
                Yb[tt * 64 + F.lane] = (y0 + y1) + (y2 + y3);
            }
        }
        __syncthreads();
#pragma unroll 2
        for (int i = 0; i < 8; ++i) {
            const int tt = F.wave * 8 + i; const size_t m = (size_t)b * SEQ + t0 + tt;
            const float y = Yb[tt * 64 + F.lane]; const float mean = wave_sum(y) * (1.f / 64.f); const float d = y - mean; const float var = wave_sum(d * d) * (1.f / 64.f);
            float o = d * rsqrtf(var + 64e-5f) * ln_w + ln_b; o += Bon[tt] * Vb[tt * 64 + F.lane];
            o *= bf1(lr[m * LRN + 2048 + col]);
            ycat[m * DM + 1024 + col] = (bf16)f2bf(o);
        }
        __syncthreads();
    }
}
constexpr int RG_XCB = 0, RG_XCF = 20480, RG_A = 53248, RG_U = 86016;
__device__ __forceinline__ void rglru_unit(Frame& F, const Ptrs& P, int unit) {
    const int b = unit >> 3, blk = unit & 7, cb0 = blk * 128;
    const bf16* proj = (const bf16*)(P.ws + WS_PROJ); bf16* ycat = (bf16*)(P.ws + WS_H);
    const float* cw = P.in[IN_A_CONV_W]; const float* cbias = P.in[IN_A_CONV_B];
    LAS bf16* XCB = (LAS bf16*)(F.lds + RG_XCB); LAS float* XCF = (LAS float*)(F.lds + RG_XCF); LAS float* AB = (LAS float*)(F.lds + RG_A); LAS float* UB = (LAS float*)(F.lds + RG_U);
    const bf16* wrg = (const bf16*)(P.ws + WS_W_RG);
    pg8::bf16x8 Br[4], Bi[4];
    float b_r, b_i, sp8;
    { const int r16 = F.lane & 15, g4 = F.lane >> 4;
#pragma unroll
    for (int ks = 0; ks < 4; ++ks) { const size_t o = ((size_t)blk * 128 + 16 * F.wave + r16) * 128 + 32 * ks + 8 * g4;
        Br[ks] = *(const pg8::bf16x8*)(wrg + o); Bi[ks] = *(const pg8::bf16x8*)(wrg + (size_t)8 * 128 * 128 + o); }
    const int cn = cb0 + 16 * F.wave + r16;
    b_r = P.in[IN_A_B_R][cn]; b_i = P.in[IN_A_B_I][cn];
    const float lam = P.in[IN_A_LAMBDA][cn]; sp8 = 8.f * log1pf(expf(-lam)); }
    float hcar = 0.f;
    v4u xr[4][2], gar[2];
    { int t0_ = F.tid; asm volatile("" : "+v"(t0_)); const int ct = (t0_ & 7) * 16, tr = t0_ >> 3; const size_t m = (size_t)b * SEQ + tr;
#pragma unroll
      for (int jj = 0; jj < 4; ++jj) { xr[jj][0] = (v4u){0u, 0u, 0u, 0u}; xr[jj][1] = xr[jj][0];
          if (tr - 3 + jj >= 0) { xr[jj][0] = *(const GAS v4u*)(proj + (m - 3 + jj) * EIN_PAD + cb0 + ct); xr[jj][1] = *(const GAS v4u*)(proj + (m - 3 + jj) * EIN_PAD + cb0 + ct + 8); } }
      gar[0] = *(const GAS v4u*)(proj + m * EIN_PAD + 1024 + cb0 + ct); gar[1] = *(const GAS v4u*)(proj + m * EIN_PAD + 1024 + cb0 + ct + 8); }
    for (int ch = 0; ch < SEQ / 64; ++ch) {
        const int t0 = ch * 64;
        int tid_ = F.tid; asm volatile("" : "+v"(tid_));
        const int ct = (tid_ & 7) * 16, tr = tid_ >> 3;
        const int r16 = tid_ & 15, g4 = (tid_ >> 4) & 3;
        {
            const int t = t0 + tr; const size_t m = (size_t)b * SEQ + t;
            float acc[16];
#pragma unroll
            for (int j = 0; j < 16; ++j) acc[j] = cbias[cb0 + ct + j];
#pragma unroll
            for (int jj = 0; jj < 4; ++jj) { {
                const v4u x0 = xr[jj][0], x1 = xr[jj][1];
                const float* w = cw + jj * 1024 + cb0 + ct;
#pragma unroll
                for (int j = 0; j < 4; ++j) { acc[2 * j] += w[2 * j] * bflo(x0[j]); acc[2 * j + 1] += w[2 * j + 1] * bfhi(x0[j]); acc[8 + 2 * j] += w[8 + 2 * j] * bflo(x1[j]); acc[8 + 2 * j + 1] += w[8 + 2 * j + 1] * bfhi(x1[j]); } } }
#pragma unroll
            for (int j = 0; j < 16; ++j) XCF[tr * 128 + ct + j] = acc[j];
            v4u p0, p1; p0.x = cvtpk(acc[0], acc[1]); p0.y = cvtpk(acc[2], acc[3]); p0.z = cvtpk(acc[4], acc[5]); p0.w = cvtpk(acc[6], acc[7]);
            p1.x = cvtpk(acc[8], acc[9]); p1.y = cvtpk(acc[10], acc[11]); p1.z = cvtpk(acc[12], acc[13]); p1.w = cvtpk(acc[14], acc[15]);
            *(LAS v4u*)(XCB + tr * 136 + ct) = p0; *(LAS v4u*)(XCB + tr * 136 + ct + 8) = p1;
            if (ch + 1 < SEQ / 64) { const size_t mn = m + 64;
#pragma unroll
                for (int jj = 0; jj < 4; ++jj) { xr[jj][0] = *(const GAS v4u*)(proj + (mn - 3 + jj) * EIN_PAD + cb0 + ct); xr[jj][1] = *(const GAS v4u*)(proj + (mn - 3 + jj) * EIN_PAD + cb0 + ct + 8); }
            }
        }
        LBAR();
        {
#pragma unroll
            for (int mt = 0; mt < 4; ++mt) {
                pg8::f32x4 ar = {0.f, 0.f, 0.f, 0.f}, ai = {0.f, 0.f, 0.f, 0.f};
#pragma unroll
                for (int ks = 0; ks < 4; ++ks) { const pg8::bf16x8 a = *(const LAS pg8::bf16x8*)(XCB + (16 * mt + r16) * 136 + 32 * ks + 8 * g4);
                    ar = __builtin_amdgcn_mfma_f32_16x16x32_bf16(a, Br[ks], ar, 0, 0, 0); ai = __builtin_amdgcn_mfma_f32_16x16x32_bf16(a, Bi[ks], ai, 0, 0, 0); }
#pragma unroll
                for (int rg = 0; rg < 4; ++rg) { const int tt = 16 * mt + 4 * g4 + rg, cl = 16 * F.wave + r16;
                    const float rr = fsig(ar[rg] + b_r), ii = fsig(ai[rg] + b_i); const float la = -sp8 * rr; const float a = __expf(la);
                    const float mult = sqrtf(fmaxf(1.f - a * a, 0.f));
                    AB[tt * 128 + cl] = a; UB[tt * 128 + cl] = mult * ii * XCF[tt * 128 + cl]; }
            }
        }
        LBAR();
        if (tid_ < 128) {
#pragma unroll 8
            for (int tt = 0; tt < 64; ++tt) { hcar = AB[tt * 128 + tid_] * hcar + UB[tt * 128 + tid_]; UB[tt * 128 + tid_] = hcar; }
        }
        LBAR();
        {
            const size_t m = (size_t)b * SEQ + t0 + tr;
            const v4u g0 = gar[0], g1 = gar[1];
            float o[16];
#pragma unroll
            for (int j = 0; j < 4; ++j) { o[2 * j] = bflo(g0[j]); o[2 * j + 1] = bfhi(g0[j]); o[8 + 2 * j] = bflo(g1[j]); o[8 + 2 * j + 1] = bfhi(g1[j]); }
#pragma unroll
            for (int j = 0; j < 16; ++j) o[j] = UB[tr * 128 + ct + j] * fgelu_tanh(o[j]);
            v4u p0, p1; p0.x = cvtpk(o[0], o[1]); p0.y = cvtpk(o[2], o[3]); p0.z = cvtpk(o[4], o[5]); p0.w = cvtpk(o[6], o[7]);
            p1.x = cvtpk(o[8], o[9]); p1.y = cvtpk(o[10], o[11]); p1.z = cvtpk(o[12], o[13]); p1.w = cvtpk(o[14], o[15]);
            *(GAS v4u*)(ycat + m * DM + cb0 + ct) = p0; *(GAS v4u*)(ycat + m * DM + cb0 + ct + 8) = p1;
            if (ch + 1 < SEQ / 64) { gar[0] = *(const GAS v4u*)(proj + (m + 64) * EIN_PAD + 1024 + cb0 + ct); gar[1] = *(const GAS v4u*)(proj + (m + 64) * EIN_PAD + 1024 + cb0 + ct + 8); }
        }
    }
}

typedef short bf16x4 __attribute__((ext_vector_type(4)));
#define MFMA16(a, b, c) __builtin_amdgcn_mfma_f32_16x16x16bf16_1k((a), (b), (c), 0, 0, 0)
constexpr int R2_PC = 15360, R2_BT = 0, R2_KT = 2560, R2_VT = 5120, R2_RR = 7680, R2_WR = 9984, R2_TA = 12288, R2_MB = 13056, R2_MK = 13824, R2_GL = 14592;
constexpr int R2_YB = 61440, R2_YE = 6400, R2_YVF = 4096, R2_YBO = 6144;
constexpr int R2_SC = R2_YB + 8 * R2_YE, R2_SCB = 9728;
static_assert(R2_SC + 4 * R2_SCB <= MISC_OFF, "RWKV LDS map");
__device__ __forceinline__ float bperm0(int srclane, float x) { return __int_as_float(__builtin_amdgcn_ds_bpermute(srclane << 2, __float_as_int(x))); }
__device__ __forceinline__ bf16x4 pack4(const pg8::f32x4 v) { v2u p; p.x = cvtpk(v[0], v[1]); p.y = cvtpk(v[2], v[3]); return __builtin_bit_cast(bf16x4, p); }
template <int CTRL> __device__ __forceinline__ float dppf(float x) { return __int_as_float(__builtin_amdgcn_update_dpp(0, __float_as_int(x), CTRL, 0xf, 0xf, true)); }
__device__ __forceinline__ float scan16(float x) { x += dppf<0x111>(x); x += dppf<0x112>(x); x += dppf<0x114>(x); x += dppf<0x118>(x); return x; }
__device__ __forceinline__ float xrow_sum(float x, int lid) { x += bperm0(lid ^ 16, x); x += bperm0(lid ^ 32, x); return x; }
__device__ __forceinline__ void rwkv_post(int lane, const Ptrs& P, int b, int h, int tstart, LAS unsigned char* ye) {
    const bf16* lr = (const bf16*)(P.ws + WS_LR); bf16* ycat = (bf16*)(P.ws + WS_H);
    const LAS float* Y = (const LAS float*)ye; const LAS bf16* VF = (const LAS bf16*)(ye + R2_YVF); const LAS float* BO = (const LAS float*)(ye + R2_YBO);
    const int t = lane & 15, g = lane >> 4; const size_t m = (size_t)b * SEQ + tstart + t; const int ch0 = h * 64 + 4 * g;
    v2u gv[4];
#pragma unroll
    for (int ks = 0; ks < 4; ++ks) gv[ks] = *(const GAS v2u*)(lr + m * LRN + 2048 + ch0 + 16 * ks);
    f32x4 y[4]; float s = 0.f;
#pragma unroll
    for (int ks = 0; ks < 4; ++ks) { y[ks] = *(const LAS f32x4*)(Y + t * 64 + 16 * ks + 4 * g); s += (y[ks].x + y[ks].y) + (y[ks].z + y[ks].w); }
    const float mean = xrow_sum(s, lane) * (1.f / 64.f); float q = 0.f;
#pragma unroll
    for (int ks = 0; ks < 4; ++ks) { y[ks] = y[ks] - mean; q += (y[ks].x * y[ks].x + y[ks].y * y[ks].y) + (y[ks].z * y[ks].z + y[ks].w * y[ks].w); }
    const float rstd = rsqrtf(xrow_sum(q, lane) * (1.f / 64.f) + 64e-5f), bo = BO[t];
#pragma unroll
    for (int ks = 0; ks < 4; ++ks) { const int c = ch0 + 16 * ks;
        const f32x4 lw4 = *(const GAS f32x4*)(P.in[IN_B_LN_W] + c), lb4 = *(const GAS f32x4*)(P.in[IN_B_LN_B] + c);
        const v2u vv = *(const LAS v2u*)(VF + t * 64 + 16 * ks + 4 * g);
        f32x4 o = y[ks] * rstd * lw4 + lb4; o.x += bo * bflo(vv.x); o.y += bo * bfhi(vv.x); o.z += bo * bflo(vv.y); o.w += bo * bfhi(vv.y);
        o.x *= bflo(gv[ks].x); o.y *= bfhi(gv[ks].x); o.z *= bflo(gv[ks].y); o.w *= bfhi(gv[ks].y);
        *(GAS v2u*)(ycat + m * DM + 1024 + c) = (v2u){cvtpk(o.x, o.y), cvtpk(o.z, o.w)}; }
}
#define RW_LOAD(SET, BT, LANE) do { const int tok_ = (BT) * 64 + 16 * w + ((LANE) & 15); const size_t m_ = (size_t)b * SEQ + tok_; const int ch0_ = h * 64 + 4 * ((LANE) >> 4); \
        const bf16* prow_ = proj + m_ * EIN_PAD + 2048 + ch0_; const bf16* lrow_ = lr + m_ * LRN + ch0_; \
        _Pragma("unroll") for (int ks = 0; ks < 4; ++ks) { IN[SET][0][ks] = *(const GAS v2u*)(prow_ + 16 * ks); IN[SET][1][ks] = *(const GAS v2u*)(prow_ + 1024 + 16 * ks); IN[SET][2][ks] = *(const GAS v2u*)(prow_ + 2048 + 16 * ks); \
            IN[SET][3][ks] = *(const GAS v2u*)(lrow_ + 16 * ks); IN[SET][4][ks] = *(const GAS v2u*)(lrow_ + 1024 + 16 * ks); } \
        { const int tp_ = (BT) * 64 + 16 * w - 1; PV[SET][0] = 0u; PV[SET][1] = 0u; PV[SET][2] = 0u; \
          if (tp_ >= 0) { const bf16* pp_ = proj + ((size_t)b * SEQ + tp_) * EIN_PAD + 2048 + h * 64 + (LANE); PV[SET][0] = pp_[0]; PV[SET][1] = pp_[1024]; PV[SET][2] = pp_[2048]; } } } while (0)
template <int CS> __device__ __forceinline__ void rwkv_batch(Frame& F, const Ptrs& P, const int b, const int h, const int w, const int bt, const int skip, pg8::f32x4 (&Z)[4], v2u (&IN)[2][5][4], unsigned (&PV)[2][3]) {
    const bf16* proj = (const bf16*)(P.ws + WS_PROJ); const bf16* lr = (const bf16*)(P.ws + WS_LR);
    const float* mu = P.in[IN_B_MU];
        const int t0 = bt * 64, par = bt & 1;
        int lane_ = F.lane; asm volatile("" : "+v"(lane_));
        const int r16 = lane_ & 15, g = lane_ >> 4;
        if (w < 4) {
            const int c = w, tb = t0 + 16 * c, tok = tb + r16; const size_t m = (size_t)b * SEQ + tok; const int ch0 = h * 64 + 4 * g;
            LAS unsigned char* pc = F.lds + c * R2_PC; LAS unsigned char* sc = F.lds + R2_SC + c * R2_SCB; LAS unsigned char* ye = F.lds + R2_YB + (par * 4 + c) * R2_YE;
            LAS bf16* AT = (LAS bf16*)(sc + 2304); LAS bf16* BT = (LAS bf16*)(pc + R2_BT); LAS bf16* KT = (LAS bf16*)(pc + R2_KT); LAS bf16* VT = (LAS bf16*)(pc + R2_VT);
            LAS bf16* RR = (LAS bf16*)(pc + R2_RR); LAS bf16* VF = (LAS bf16*)(ye + R2_YVF); LAS float* BO = (LAS float*)(ye + R2_YBO); LAS float* GL = (LAS float*)(pc + R2_GL);
            if (CS == 0 && bt == 0) RW_LOAD(0, 0, lane_);
            if (bt + 1 < SEQ / 64) RW_LOAD(CS ^ 1, bt + 1, lane_);
            LAS bf16* PVS = (LAS bf16*)(sc + 7168);
            PVS[lane_] = (bf16)PV[CS][0]; PVS[64 + lane_] = (bf16)PV[CS][1]; PVS[128 + lane_] = (bf16)PV[CS][2];
            LDS_WAIT();
            if (!(skip & 2)) {
            float ssp = 0.f, bop = 0.f;
            pg8::f32x4 Nab = {0.f, 0.f, 0.f, 0.f}, Aak = Nab, Mrb = Nab, Mrk = Nab;
#pragma unroll
            for (int ks = 0; ks < 4; ++ks) { const int cc = ch0 + 16 * ks;
                const f32x4 muk = *(const GAS f32x4*)(mu + 1024 + cc), kkv = *(const GAS f32x4*)(P.in[IN_B_K_K] + cc);
                const v2u lk_ = *(const LAS v2u*)(PVS + 64 + 16 * ks + 4 * g); v2u Kp_;
                Kp_.x = (unsigned)__builtin_amdgcn_update_dpp((int)lk_.x, (int)IN[CS][1][ks].x, 0x111, 0xf, 0xf, false); Kp_.y = (unsigned)__builtin_amdgcn_update_dpp((int)lk_.y, (int)IN[CS][1][ks].y, 0x111, 0xf, 0xf, false);
#pragma unroll
                for (int j = 0; j < 4; ++j) { const unsigned wk_ = (j < 2) ? IN[CS][1][ks].x : IN[CS][1][ks].y, pk_ = (j < 2) ? Kp_.x : Kp_.y;
                    const float kr = (j & 1) ? bfhi(wk_) : bflo(wk_), kp = (j & 1) ? bfhi(pk_) : bflo(pk_); const float kk = (kr + (kp - kr) * muk[j]) * kkv[j]; ssp += kk * kk; } }
            ssp = xrow_sum(ssp, lane_);
            const float inv = rsqrtf(fmaxf(ssp, 1e-12f));
#pragma unroll
            for (int ks = 0; ks < 4; ++ks) { const int cc = ch0 + 16 * ks;
                const f32x4 mur = *(const GAS f32x4*)(mu + cc), muk = *(const GAS f32x4*)(mu + 1024 + cc), muv = *(const GAS f32x4*)(mu + 2048 + cc);
                const f32x4 kkv = *(const GAS f32x4*)(P.in[IN_B_K_K] + cc), kav = *(const GAS f32x4*)(P.in[IN_B_K_A] + cc), rkv = *(const GAS f32x4*)(P.in[IN_B_R_K] + cc);
                float kt_[4], rt_[4], vv_[4], gl_[4], at_[4], bt_[4];
                v2u Rp_, Kp_, Vp_;
                { const v2u lr_ = *(const LAS v2u*)(PVS + 16 * ks + 4 * g), lk_ = *(const LAS v2u*)(PVS + 64 + 16 * ks + 4 * g), lv_ = *(const LAS v2u*)(PVS + 128 + 16 * ks + 4 * g);
                  Rp_.x = (unsigned)__builtin_amdgcn_update_dpp((int)lr_.x, (int)IN[CS][0][ks].x, 0x111, 0xf, 0xf, false); Rp_.y = (unsigned)__builtin_amdgcn_update_dpp((int)lr_.y, (int)IN[CS][0][ks].y, 0x111, 0xf, 0xf, false);
                  Kp_.x = (unsigned)__builtin_amdgcn_update_dpp((int)lk_.x, (int)IN[CS][1][ks].x, 0x111, 0xf, 0xf, false); Kp_.y = (unsigned)__builtin_amdgcn_update_dpp((int)lk_.y, (int)IN[CS][1][ks].y, 0x111, 0xf, 0xf, false);
                  Vp_.x = (unsigned)__builtin_amdgcn_update_dpp((int)lv_.x, (int)IN[CS][2][ks].x, 0x111, 0xf, 0xf, false); Vp_.y = (unsigned)__builtin_amdgcn_update_dpp((int)lv_.y, (int)IN[CS][2][ks].y, 0x111, 0xf, 0xf, false); }
#pragma unroll
                for (int j = 0; j < 4; ++j) {
                    const unsigned wr_ = (j < 2) ? IN[CS][0][ks].x : IN[CS][0][ks].y, wk_ = (j < 2) ? IN[CS][1][ks].x : IN[CS][1][ks].y, wv_ = (j < 2) ? IN[CS][2][ks].x : IN[CS][2][ks].y;
                    const unsigned pr_ = (j < 2) ? Rp_.x : Rp_.y, pk_ = (j < 2) ? Kp_.x : Kp_.y, pv_ = (j < 2) ? Vp_.x : Vp_.y;
                    const unsigned zw_ = (j < 2) ? IN[CS][3][ks].x : IN[CS][3][ks].y, za_ = (j < 2) ? IN[CS][4][ks].x : IN[CS][4][ks].y;
                    const float rr = (j & 1) ? bfhi(wr_) : bflo(wr_), kr = (j & 1) ? bfhi(wk_) : bflo(wk_), vr = (j & 1) ? bfhi(wv_) : bflo(wv_);
                    const float rp = (j & 1) ? bfhi(pr_) : bflo(pr_), kp = (j & 1) ? bfhi(pk_) : bflo(pk_), vp = (j & 1) ? bfhi(pv_) : bflo(pv_);
                    const float zw = (j & 1) ? bfhi(zw_) : bflo(zw_), za = (j & 1) ? bfhi(za_) : bflo(za_);
                    const float r = rr + (rp - rr) * mur[j], k = kr + (kp - kr) * muk[j], v = vr + (vp - vr) * muv[j];
                    const float lw = -0.60653066f * fsig(zw), al = fsig(za);
                    const float cl = scan16(lw), gcur = __expf(cl), gi = __expf(-cl), gprev = __expf(cl - lw);
                    const float kk = k * kkv[j] * inv;
                    const float kq = k * (1.f + (al - 1.f) * kav[j]); bop += r * kq * rkv[j];
                    at_[j] = -kk * gprev; bt_[j] = kk * al * gi; kt_[j] = kq * gi; rt_[j] = r * gcur; vv_[j] = v; gl_[j] = gcur;
                }
                const bf16x4 bK = pack4((pg8::f32x4){kt_[0], kt_[1], kt_[2], kt_[3]}), aR = pack4((pg8::f32x4){rt_[0], rt_[1], rt_[2], rt_[3]});
                const bf16x4 aA = pack4((pg8::f32x4){at_[0], at_[1], at_[2], at_[3]}), bB = pack4((pg8::f32x4){bt_[0], bt_[1], bt_[2], bt_[3]});
                const v2u vpk = (v2u){cvtpk(vv_[0], vv_[1]), cvtpk(vv_[2], vv_[3])};
                if (r16 == 15) *(LAS f32x4*)(GL + 16 * ks + 4 * g) = (f32x4){gl_[0], gl_[1], gl_[2], gl_[3]};
                *(LAS bf16x4*)(RR + r16 * 72 + 16 * ks + 4 * g) = aR; *(LAS v2u*)(VF + r16 * 64 + 16 * ks + 4 * g) = vpk;
                if (!(skip & 16))
#pragma unroll
                for (int j = 0; j < 4; ++j) { const int kch = 16 * ks + 4 * g + j;
                    AT[kch * 20 + r16] = (bf16)aA[j]; BT[kch * 20 + r16] = (bf16)bB[j]; KT[kch * 20 + r16] = (bf16)bK[j];
                    VT[kch * 20 + r16] = (bf16)((j & 1) ? (((j < 2) ? vpk.x : vpk.y) >> 16) : (((j < 2) ? vpk.x : vpk.y) & 0xffffu)); }
                Nab = MFMA16(aA, bB, Nab); Aak = MFMA16(aA, bK, Aak); Mrb = MFMA16(aR, bB, Mrb); Mrk = MFMA16(aR, bK, Mrk);
                __builtin_amdgcn_sched_barrier(0);
            }
            bop = xrow_sum(bop, lane_);
            if (g == 0) BO[r16] = bop;
            LAS float* NF = (LAS float*)sc; LAS bf16* TB = (LAS bf16*)(sc + 4864);
            LAS bf16* MB = (LAS bf16*)(pc + R2_MB); LAS bf16* MK = (LAS bf16*)(pc + R2_MK); LAS bf16* TAo = (LAS bf16*)(pc + R2_TA); LAS bf16* WR = (LAS bf16*)(pc + R2_WR);
#pragma unroll
            for (int rg = 0; rg < 4; ++rg) { const int t = 4 * g + rg;
                if (!(r16 < t)) { Nab[rg] = 0.f; Aak[rg] = 0.f; } if (!(r16 <= t)) { Mrb[rg] = 0.f; Mrk[rg] = 0.f; }
                NF[t * 16 + r16] = Nab[rg]; MB[t * 24 + r16] = (bf16)f2bf(Mrb[rg]); MK[t * 24 + r16] = (bf16)f2bf(Mrk[rg]); }
            const bf16x4 bAak = pack4(Aak);
            LDS_WAIT();
            float Tc[16];
#pragma unroll
            for (int t = 0; t < 16; ++t) {
                const LAS f32x4* rowp = (const LAS f32x4*)(NF + t * 16);
                float acc = (t == lane_) ? 1.f : 0.f, acc1 = 0.f, acc2 = 0.f, acc3 = 0.f;
                if (!(skip & 1))
#pragma unroll
                for (int q = 0; q < 4; ++q) { if (4 * q < t) { const f32x4 rv = rowp[q];
                    if (4 * q + 0 < t) acc += rv.x * Tc[4 * q + 0]; if (4 * q + 1 < t) acc1 += rv.y * Tc[4 * q + 1]; if (4 * q + 2 < t) acc2 += rv.z * Tc[4 * q + 2]; if (4 * q + 3 < t) acc3 += rv.w * Tc[4 * q + 3]; } }
                Tc[t] = (acc + acc1) + (acc2 + acc3);
            }
            if (lane_ < 16) {
#pragma unroll
                for (int t = 0; t < 16; ++t) TB[t * 24 + lane_] = (bf16)f2bf(Tc[t]);
            }
            LDS_WAIT();
            const bf16x4 aT = *(const LAS bf16x4*)(TB + r16 * 24 + 4 * g);
#pragma unroll
            for (int nt = 0; nt < 4; ++nt) { const bf16x4 bA = *(const LAS bf16x4*)(AT + (16 * nt + r16) * 20 + 4 * g);
                const pg8::f32x4 Wn = MFMA16(aT, bA, ((pg8::f32x4){0.f, 0.f, 0.f, 0.f}));
#pragma unroll
                for (int rg = 0; rg < 4; ++rg) WR[(4 * g + rg) * 72 + 16 * nt + r16] = (bf16)f2bf(Wn[rg]); }
            { const pg8::f32x4 TAm = MFMA16(aT, bAak, ((pg8::f32x4){0.f, 0.f, 0.f, 0.f}));
#pragma unroll
              for (int rg = 0; rg < 4; ++rg) TAo[(4 * g + rg) * 24 + r16] = (bf16)f2bf(TAm[rg]); }
            }
        } else if (bt > 0 && !(skip & 8)) {
            rwkv_post(lane_, P, b, h, t0 - 64 + 16 * (w - 4), F.lds + R2_YB + ((1 - par) * 4 + (w - 4)) * R2_YE);
        }
        LBAR();
        if (w < 4 && !(skip & 4)) {
            const int nb = w;
#pragma unroll 1
            for (int c = 0; c < 4; ++c) {
                LAS unsigned char* pc = F.lds + c * R2_PC; LAS float* Y = (LAS float*)(F.lds + R2_YB + (par * 4 + c) * R2_YE);
                const LAS bf16* WR = (const LAS bf16*)(pc + R2_WR); const LAS bf16* RR = (const LAS bf16*)(pc + R2_RR);
                bf16x4 zb[4];
#pragma unroll
                for (int kb = 0; kb < 4; ++kb) zb[kb] = pack4(Z[kb]);
                const bf16x4 vB = *(const LAS bf16x4*)((const LAS bf16*)(pc + R2_VT) + (16 * nb + r16) * 20 + 4 * g);
                pg8::f32x4 U = {0.f, 0.f, 0.f, 0.f}, Yt = U;
#pragma unroll
                for (int kb = 0; kb < 4; ++kb) { const bf16x4 aW = *(const LAS bf16x4*)(WR + r16 * 72 + 16 * kb + 4 * g), aR = *(const LAS bf16x4*)(RR + r16 * 72 + 16 * kb + 4 * g);
                    U = MFMA16(aW, zb[kb], U); Yt = MFMA16(aR, zb[kb], Yt); }
                U = MFMA16(*(const LAS bf16x4*)((const LAS bf16*)(pc + R2_TA) + r16 * 24 + 4 * g), vB, U);
                const bf16x4 ub = pack4(U);
                Yt = MFMA16(*(const LAS bf16x4*)((const LAS bf16*)(pc + R2_MB) + r16 * 24 + 4 * g), ub, Yt);
                Yt = MFMA16(*(const LAS bf16x4*)((const LAS bf16*)(pc + R2_MK) + r16 * 24 + 4 * g), vB, Yt);
#pragma unroll
                for (int rg = 0; rg < 4; ++rg) Y[(4 * g + rg) * 64 + 16 * nb + r16] = Yt[rg];
#pragma unroll
                for (int kb = 0; kb < 4; ++kb) {
                    Z[kb] = MFMA16(*(const LAS bf16x4*)((const LAS bf16*)(pc + R2_BT) + (16 * kb + r16) * 20 + 4 * g), ub, Z[kb]);
                    Z[kb] = MFMA16(*(const LAS bf16x4*)((const LAS bf16*)(pc + R2_KT) + (16 * kb + r16) * 20 + 4 * g), vB, Z[kb]);
                    Z[kb] = Z[kb] * *(const LAS f32x4*)((const LAS float*)(pc + R2_GL) + 16 * kb + 4 * g);
                }
            }
        }
        LBAR();
    }
__device__ __forceinline__ void rwkv_unit2(Frame& F, const Ptrs& P, int unit, int skip = 0) {
    const int b = unit >> 4, h = unit & 15, w = F.wave;
    const bf16* proj = (const bf16*)(P.ws + WS_PROJ); const bf16* lr = (const bf16*)(P.ws + WS_LR);
    const float* mu = P.in[IN_B_MU];
    pg8::f32x4 Z[4];
#pragma unroll
    for (int i = 0; i < 4; ++i) Z[i] = (pg8::f32x4){0.f, 0.f, 0.f, 0.f};
    v2u IN[2][5][4]; unsigned PV[2][3];
    for (int bt = 0; bt < SEQ / 64; bt += 2) {
        rwkv_batch<0>(F, P, b, h, w, bt, skip, Z, IN, PV);
        rwkv_batch<1>(F, P, b, h, w, bt + 1, skip, Z, IN, PV);
    }
#undef RW_LOAD
    int lane2_ = F.lane, tl_ = SEQ - 64; asm volatile("" : "+v"(lane2_), "+s"(tl_));
    if (w >= 4) rwkv_post(lane2_, P, b, h, tl_ + 16 * (w - 4), F.lds + R2_YB + (1 * 4 + (w - 4)) * R2_YE);
}

constexpr int PT_CW = 0, PT_CB = 8192, PT_P4 = 10240, PT_GT = 18432, PT_SZ = 51200;
__device__ __forceinline__ void pre_step(const v4u (&x)[4], const LAS unsigned char* T, const int cl, const int t, const int r, bf16* xcp_out, bf16* kp_out, pg8::f32x4& acc) {
    float a[8];
    { const f32x4 b0 = *(const LAS f32x4*)(T + PT_CB + cl * 4), b1 = *(const LAS f32x4*)(T + PT_CB + cl * 4 + 16);
      a[0] = b0.x; a[1] = b0.y; a[2] = b0.z; a[3] = b0.w; a[4] = b1.x; a[5] = b1.y; a[6] = b1.z; a[7] = b1.w; }
#pragma unroll
    for (int jj = 0; jj < 4; ++jj) { const float mk = (t - 3 + jj >= 0) ? 1.f : 0.f; const f32x4 w0 = *(const LAS f32x4*)(T + PT_CW + jj * 2048 + cl * 4) * mk, w1 = *(const LAS f32x4*)(T + PT_CW + jj * 2048 + cl * 4 + 16) * mk;
        a[0] += w0.x * bflo(x[jj][0]); a[1] += w0.y * bfhi(x[jj][0]); a[2] += w0.z * bflo(x[jj][1]); a[3] += w0.w * bfhi(x[jj][1]);
        a[4] += w1.x * bflo(x[jj][2]); a[5] += w1.y * bfhi(x[jj][2]); a[6] += w1.z * bflo(x[jj][3]); a[7] += w1.w * bfhi(x[jj][3]); }
#pragma unroll
    for (int j = 0; j < 8; ++j) a[j] = fsilu(a[j]);
    v4u xcp; xcp.x = cvtpk(a[0], a[1]); xcp.y = cvtpk(a[2], a[3]); xcp.z = cvtpk(a[4], a[5]); xcp.w = cvtpk(a[6], a[7]);
    float ar[8];
#pragma unroll
    for (int j = 0; j < 4; ++j) { ar[2 * j] = bflo(xcp[j]); ar[2 * j + 1] = bfhi(xcp[j]); }
    float kq[8];
#pragma unroll
    for (int bq = 0; bq < 2; ++bq) { const LAS unsigned char* p4 = T + PT_P4 + (cl / 4 + bq) * 64;
        const f32x4 q0 = *(const LAS f32x4*)(p4), q1 = *(const LAS f32x4*)(p4 + 16), q2 = *(const LAS f32x4*)(p4 + 32), q3 = *(const LAS f32x4*)(p4 + 48);
        const f32x4 o = q0 * ar[4 * bq] + q1 * ar[4 * bq + 1] + q2 * ar[4 * bq + 2] + q3 * ar[4 * bq + 3];
        kq[4 * bq] = o.x; kq[4 * bq + 1] = o.y; kq[4 * bq + 2] = o.z; kq[4 * bq + 3] = o.w; }
    v4u kp; kp.x = cvtpk(kq[0], kq[1]); kp.y = cvtpk(kq[2], kq[3]); kp.z = cvtpk(kq[4], kq[5]); kp.w = cvtpk(kq[6], kq[7]);
    *(GAS v4u*)xcp_out = xcp; *(GAS v4u*)kp_out = kp;
    const v4u g1 = *(const LAS v4u*)(T + PT_GT + (r * 1024 + cl) * 2), g2 = *(const LAS v4u*)(T + PT_GT + (r * 1024 + 512 + cl) * 2);
    acc = __builtin_amdgcn_mfma_f32_16x16x32_bf16(__builtin_bit_cast(pg8::bf16x8, xcp), __builtin_bit_cast(pg8::bf16x8, g1), acc, 0, 0, 0);
    acc = __builtin_amdgcn_mfma_f32_16x16x32_bf16(__builtin_bit_cast(pg8::bf16x8, x[3]), __builtin_bit_cast(pg8::bf16x8, g2), acc, 0, 0, 0);
}
__device__ __forceinline__ void ph_mlstm_pre(Frame& F, const Ptrs& P) {
    const bf16* xm = (const bf16*)(P.ws + WS_XM); bf16* xc = (bf16*)(P.ws + WS_XC); bf16* kpp = (bf16*)(P.ws + WS_KPP);
    const bf16* Gt = (const bf16*)(P.ws + WS_GT); const float* P4 = (const float*)(P.ws + WS_P4); float* gates = (float*)(P.ws + WS_GATES);
    const float* cw = P.in[IN_C_CONV_W]; const float* cbias = P.in[IN_C_CONV_B];
    const int r = F.lane & 15, g = F.lane >> 4;
    for (int rb = blockIdx.x; rb < M / 128; rb += F.G) {
        const int tile = rb * 8 + F.wave, m = tile * 16 + r, t = m & (SEQ - 1);
        pg8::f32x4 acc = {0.f, 0.f, 0.f, 0.f};
        const bf16* xrow = xm + (size_t)m * CW; bf16* xcrow = xc + (size_t)m * CW; bf16* kprow = kpp + (size_t)m * CW;
        v4u XA[4][4], XB[4][4];
#define PRE_LOAD(X, G) do { _Pragma("unroll") for (int u_ = 0; u_ < 4; ++u_) { const int c0_ = 128 * (G) + 32 * u_ + 8 * g; \
            _Pragma("unroll") for (int jj = 0; jj < 4; ++jj) X[u_][jj] = *(const GAS v4u*)(xrow + (ptrdiff_t)((t - 3 + jj >= 0) ? jj - 3 : 0) * CW + c0_); } } while (0)
        PRE_LOAD(XA, 0);
        for (int G = 0; G < 32; G += 2) {
            const int seg = G >> 2;
            LAS unsigned char* T = F.lds + (seg & 1) * PT_SZ;
            if ((G & 3) == 0) { const int c512 = seg * 512;
              for (int i = F.tid; i < 512; i += NTHR) { const int jj = i >> 7, q = i & 127; *(LAS f32x4*)(T + PT_CW + jj * 2048 + q * 16) = *(const GAS f32x4*)(cw + jj * CW + c512 + 4 * q); }
              if (F.tid < 128) *(LAS f32x4*)(T + PT_CB + F.tid * 16) = *(const GAS f32x4*)(cbias + c512 + 4 * F.tid);
              *(LAS f32x4*)(T + PT_P4 + F.tid * 16) = *(const GAS f32x4*)(P4 + (size_t)(c512 / 4) * 16 + 4 * F.tid);
              for (int i = F.tid; i < 2048; i += NTHR) { const int gi = i >> 7, part = (i >> 6) & 1, q = i & 63; *(LAS v4u*)(T + PT_GT + (gi * 1024 + part * 512 + q * 8) * 2) = *(const GAS v4u*)(Gt + (size_t)gi * 8192 + part * 4096 + c512 + 8 * q); }
              LBAR(); }
            PRE_LOAD(XB, G + 1);
#pragma unroll
            for (int u = 0; u < 4; ++u) { const int cl = 128 * (G & 3) + 32 * u + 8 * g, c0 = 512 * seg + cl; pre_step(XA[u], T, cl, t, r, xcrow + c0, kprow + c0, acc); }
            if (G + 2 < 32) PRE_LOAD(XA, G + 2);
#pragma unroll
            for (int u = 0; u < 4; ++u) { const int cl = 128 * ((G + 1) & 3) + 32 * u + 8 * g, c0 = 512 * seg + cl; pre_step(XB[u], T, cl, t, r, xcrow + c0, kprow + c0, acc); }
        }
#undef PRE_LOAD
        const float bi = P.in[IN_C_B_IF][r];
#pragma unroll
        for (int rg = 0; rg < 4; ++rg) gates[(size_t)(tile * 16 + 4 * g + rg) * 16 + r] = acc[rg] + bi;
        LBAR();
    }
}
__device__ __forceinline__ void ph_mlstm_post(Frame& F, const Ptrs& P) {
    const bf16* hc = (const bf16*)(P.ws + WS_XM); bf16* xc = (bf16*)(P.ws + WS_XC);
    const float* lnw = P.in[IN_C_LN_W]; const float* skip = P.in[IN_C_SKIP];
    for (int m = F.gw; m < M; m += F.NGW) {
#pragma unroll 2
        for (int hh = 0; hh < 8; ++hh) {
            const int c0 = hh * CHD + 8 * F.lane;
            const v4u hv = *(const GAS v4u*)(hc + (size_t)m * CW + c0), xv = *(const GAS v4u*)(xc + (size_t)m * CW + c0);
            float x[8]; float s = 0.f;
#pragma unroll
            for (int j = 0; j < 4; ++j) { x[2 * j] = bflo(hv[j]); x[2 * j + 1] = bfhi(hv[j]); s += x[2 * j] + x[2 * j + 1]; }
            const float mean = wave_sum(s) * (1.f / CHD); float q = 0.f;
#pragma unroll
            for (int j = 0; j < 8; ++j) { x[j] -= mean; q += x[j] * x[j]; }
            const float rstd = rsqrtf(wave_sum(q) * (1.f / CHD) + 1e-6f);
            const f32x4 w0 = *(const GAS f32x4*)(lnw + c0), w1 = *(const GAS f32x4*)(lnw + c0 + 4), s0 = *(const GAS f32x4*)(skip + c0), s1 = *(const GAS f32x4*)(skip + c0 + 4);
            float o[8];
            o[0] = x[0] * rstd * w0.x + s0.x * bflo(xv[0]); o[1] = x[1] * rstd * w0.y + s0.y * bfhi(xv[0]); o[2] = x[2] * rstd * w0.z + s0.z * bflo(xv[1]); o[3] = x[3] * rstd * w0.w + s0.w * bfhi(xv[1]);
            o[4] = x[4] * rstd * w1.x + s1.x * bflo(xv[2]); o[5] = x[5] * rstd * w1.y + s1.y * bfhi(xv[2]); o[6] = x[6] * rstd * w1.z + s1.z * bflo(xv[3]); o[7] = x[7] * rstd * w1.w + s1.w * bfhi(xv[3]);
            v4u w; w.x = cvtpk(o[0], o[1]); w.y = cvtpk(o[2], o[3]); w.z = cvtpk(o[4], o[5]); w.w = cvtpk(o[6], o[7]);
            *(GAS v4u*)(xc + (size_t)m * CW + c0) = w;
        }
    }
}
__device__ __forceinline__ void ph_mlstm_stats(Frame& F, const Ptrs& P) {
    const bf16* hc = (const bf16*)(P.ws + WS_XM); float* stats = (float*)(P.ws + WS_STATS);
    for (int m = F.gw; m < M; m += F.NGW) {
        v4u hv[8];
#pragma unroll
        for (int hh = 0; hh < 8; ++hh) hv[hh] = *(const GAS v4u*)(hc + (size_t)m * CW + hh * CHD + 8 * F.lane);
#pragma unroll
        for (int hh = 0; hh < 8; ++hh) { float x[8]; float s = 0.f;
#pragma unroll
            for (int j = 0; j < 4; ++j) { x[2 * j] = bflo(hv[hh][j]); x[2 * j + 1] = bfhi(hv[hh][j]); s += x[2 * j] + x[2 * j + 1]; }
            const float mean = wave_sum(s) * (1.f / CHD); float q = 0.f;
#pragma unroll
            for (int j = 0; j < 8; ++j) { const float d = x[j] - mean; q += d * d; }
            const float rstd = rsqrtf(wave_sum(q) * (1.f / CHD) + 1e-6f);
            if (F.lane == 0) { f32x2 o = {mean, rstd}; *(GAS f32x2*)(stats + ((size_t)m * 8 + hh) * 2) = o; } }
    }
}
constexpr int ML_QP = 0, ML_KP = 66560, ML_VTE = 133120, ML_MISC = 151552, ML_SD = 155200, ML_QSTR = 520, ML_VSTR = 72;
constexpr int MS_E = 0, MS_ROWF = 64, MS_SC = 128, MS_FLOOR = 192, MS_RS = 256, MS_QN = 320, MS_SCAL = 384, MS_N = 400;
__device__ __forceinline__ float bperm(int srclane, float x) { return __int_as_float(__builtin_amdgcn_ds_bpermute(srclane << 2, __float_as_int(x))); }
#ifndef NEW_N
#define NEW_N 4
#endif
#ifndef ML_QPF
#define ML_QPF 0
#endif
#ifndef ML_GLDS
#define ML_GLDS 1
#endif
#ifndef ML_GPRE
#define ML_GPRE 1
#endif
#ifndef ML_SDOWN
#define ML_SDOWN 1
#endif
#ifndef ML_PIPE3
#define ML_PIPE3 1
#endif
#ifndef ML_PIPE6
#define ML_PIPE6 1
#endif
#ifndef ML_XPF
#define ML_XPF 1
#endif
#ifndef ML_WVREG
#define ML_WVREG 1
#endif
#ifndef ML_PIPE2
#define ML_PIPE2 0
#endif
#ifndef ML_NSPLIT
#define ML_NSPLIT (ML_SDOWN && ML_GLDS)
#endif
#define SDX(t, s_) (ML_SDOWN ? ((t) * 64 + ((((s_) >> 3) ^ ((t) & 7)) << 3) + ((s_) & 7)) : ((t) * ML_VSTR + (s_)))
#ifndef DRY_SKIP
#define DRY_SKIP 0
#endif
#define DSK(bit) (dry && ((DRY_SKIP >> (bit)) & 1))
__device__ __forceinline__ void mlstm_unit(Frame& F, const Ptrs& P, int unit, bool dry = false) {
    const int j = unit & 3, hh = (unit >> 2) & 7, b = unit >> 5;
    const bf16* xcg = (const bf16*)(P.ws + WS_XC); const bf16* kpg = (const bf16*)(P.ws + WS_KPP); bf16* xm = (bf16*)(P.ws + WS_XM);
    const float* gates = (const float*)(P.ws + WS_GATES); const float* wv = P.in[IN_C_W_V];
    LAS bf16* QP = (LAS bf16*)(F.lds + ML_QP); LAS bf16* KP = (LAS bf16*)(F.lds + ML_KP); LAS bf16* VTE = (LAS bf16*)(F.lds + ML_VTE); LAS bf16* SD = ML_SDOWN ? (LAS bf16*)(F.lds + ML_SD) : QP;
    LAS float* MS = (LAS float*)(F.lds + ML_MISC);
    const int w = F.wave;
    const int hc0 = hh * CHD, vc0 = hc0 + 128 * j;
    v2u Cb[32];
#pragma unroll
    for (int i = 0; i < 32; ++i) Cb[i] = (v2u){0u, 0u};
    MS[MS_N + F.tid] = 0.f; if (F.tid == 0) { MS[MS_SCAL + 2] = 0.f; MS[MS_SCAL + 3] = 0.f; }
#if ML_GPRE
    float* gsc = P.out + (size_t)unit * 8192;
    { const int l0 = F.tid & 63;
      for (int c8 = 0; c8 < 8; ++c8) { const int chq = w * 8 + c8; const size_t mm = (size_t)b * SEQ + chq * 64 + l0;
        const float ipre = gates[mm * 16 + hh], fpre = gates[mm * 16 + 8 + hh];
        const float lf = fminf(fpre, 0.f) - log1pf(__expf(-fabsf(fpre)));
        float bcum = lf;
#pragma unroll
        for (int o = 1; o < 64; o <<= 1) { const float tv = bperm(l0 - o, bcum); if (l0 >= o) bcum += tv; }
        float pm = ipre - bcum;
#pragma unroll
        for (int o = 1; o < 64; o <<= 1) { const float tv = bperm(l0 - o, pm); if (l0 >= o) pm = fmaxf(pm, tv); }
        { f32x2 o2 = {bcum, pm}; *(GAS f32x2*)(gsc + (chq * 64 + l0) * 2) = o2; } }
      asm volatile("s_waitcnt vmcnt(0)" ::: "memory"); }
#endif
    LBAR();
#if ML_QPF
    v4u qpf[ML_QPF];
    { int t0_ = F.tid; asm volatile("" : "+v"(t0_));
#pragma unroll
      for (int it = 0; it < ML_QPF; ++it) { const int id = it * NTHR + t0_, row = id >> 6, cchunk = id & 63; qpf[it] = *(const GAS v4u*)(xcg + ((size_t)b * SEQ + row) * CW + hc0 + 8 * cchunk); } }
#endif
#if ML_WVREG
    f32x4 wq0, wq1, wq2, wq3;
    { const float* wb = wv + (size_t)(vc0 / 4 + (F.tid & 31)) * 16; wq0 = *(const GAS f32x4*)(wb); wq1 = *(const GAS f32x4*)(wb + 4); wq2 = *(const GAS f32x4*)(wb + 8); wq3 = *(const GAS f32x4*)(wb + 12); }
#endif
#if ML_XPF
    v2u xvn[4]; float ipn = 0.f, fpn = 0.f, gpn = 0.f;
    { int t0_ = F.tid; asm volatile("" : "+v"(t0_)); const int vb_ = t0_ & 31, sg_ = t0_ >> 5, l0_ = t0_ & 63; const size_t mq = (size_t)b * SEQ;
#pragma unroll
      for (int i = 0; i < 4; ++i) xvn[i] = *(const GAS v2u*)(xm + (mq + 4 * sg_ + i) * CW + vc0 + 4 * vb_);
      if (w == 0) { ipn = gates[(mq + l0_) * 16 + hh]; const f32x2 bp = *(const GAS f32x2*)(gsc + l0_ * 2); fpn = bp.x; gpn = bp.y; } }
#endif
    for (int ch = 0; ch < SEQ / 64; ++ch) {
        const size_t m0 = (size_t)b * SEQ + ch * 64;
        int tid = F.tid; asm volatile("" : "+v"(tid));
        const int lid = tid & 63, r = lid & 15, g = lid >> 4;
#if ML_GLDS
        float ipre = 0.f, fpre = 0.f, gpm = 0.f;
#if ML_NSPLIT
        if (tid < 256) { const f32x2 nv = *(const LAS f32x2*)(MS + MS_N + 2 * tid); const int k_ = 2 * tid, pos = (k_ & ~31) + 8 * ((k_ >> 2) & 3) + 4 * ((k_ >> 4) & 1) + (k_ & 3);
            const unsigned hi2 = cvtpk(nv.x, nv.y), lo2 = cvtpk(nv.x - bflo(hi2), nv.y - bfhi(hi2));
            *(LAS unsigned*)(SD + pos) = hi2; *(LAS unsigned*)(SD + 512 + pos) = lo2; }
#endif
#if ML_XPF
        ipre = ipn; fpre = fpn; gpm = gpn;
#elif ML_GPRE
        if (w == 0) { ipre = gates[(m0 + lid) * 16 + hh]; const f32x2 bp = *(const GAS f32x2*)(gsc + (ch * 64 + lid) * 2); fpre = bp.x; gpm = bp.y; }
#else
        if (w == 0) { ipre = gates[(m0 + lid) * 16 + hh]; fpre = gates[(m0 + lid) * 16 + 8 + hh]; }
#endif
        const int vblk = tid & 31, sg = tid >> 5;
        f32x4 po[4];
        {
#if ML_WVREG
          const f32x4 q0 = wq0, q1 = wq1, q2 = wq2, q3 = wq3;
#else
          const float* wb = wv + (size_t)(vc0 / 4 + vblk) * 16;
          const f32x4 q0 = *(const GAS f32x4*)(wb), q1 = *(const GAS f32x4*)(wb + 4), q2 = *(const GAS f32x4*)(wb + 8), q3 = *(const GAS f32x4*)(wb + 12);
#endif
          v2u xv[4];
#if ML_XPF
#pragma unroll
          for (int i = 0; i < 4; ++i) xv[i] = xvn[i];
#else
#pragma unroll
          for (int i = 0; i < 4; ++i) xv[i] = *(const GAS v2u*)(xm + (m0 + 4 * sg + i) * CW + vc0 + 4 * vblk);
#endif
          if (!ML_SDOWN || ch == 0) {
#pragma unroll
          for (int i = 0; i < 8; ++i) { const int row = w + 8 * i;
              __builtin_amdgcn_global_load_lds((const unsigned*)(xcg + (m0 + row) * CW + hc0 + 8 * lid), (LAS unsigned*)(QP + row * ML_QSTR), 16, 0, 0); } }
          if (w == 0 && !DSK(6)) {
            const int s = lid; const float mprev = MS[MS_SCAL + 2 + (ch & 1)];
#if ML_GPRE
            const float bcum = fpre, pm = gpm;
#else
            const float lf = fminf(fpre, 0.f) - log1pf(__expf(-fabsf(fpre)));
            float bcum = lf;
#pragma unroll
            for (int o = 1; o < 64; o <<= 1) { const float tv = bperm(s - o, bcum); if (s >= o) bcum += tv; }
            float pm = ipre - bcum;
#pragma unroll
            for (int o = 1; o < 64; o <<= 1) { const float tv = bperm(s - o, pm); if (s >= o) pm = fmaxf(pm, tv); }
#endif
            const float blast = __int_as_float(__builtin_amdgcn_readlane(__float_as_int(bcum), 63)), pmlast = __int_as_float(__builtin_amdgcn_readlane(__float_as_int(pm), 63));
            const float mt = fmaxf(bcum + mprev, bcum + pm);
            const float mnew = fmaxf(blast + mprev, blast + pmlast);
            MS[MS_E + s] = __expf(blast - bcum + ipre - mnew);
            MS[MS_ROWF + s] = __expf(bcum - blast + mnew - mt);
            MS[MS_SC + s] = __expf(bcum + mprev - mt);
            MS[MS_FLOOR + s] = __expf(-mt);
            MS[MS_QN + s] = 0.f;
            if (s == 0) { MS[MS_SCAL + 0] = __expf(blast + mprev - mnew); MS[MS_SCAL + 2 + ((ch + 1) & 1)] = mnew; }
          }
#pragma unroll
          for (int i = 0; i < 4; ++i) po[i] = q0 * bflo(xv[i].x) + q1 * bfhi(xv[i].x) + q2 * bflo(xv[i].y) + q3 * bfhi(xv[i].y); }
        asm volatile("s_waitcnt vmcnt(0)" ::: "memory");
#pragma unroll
        for (int i = 0; i < 8; ++i) { const int row = w + 8 * i;
            __builtin_amdgcn_global_load_lds((const unsigned*)(kpg + (m0 + row) * CW + hc0 + 8 * lid), (LAS unsigned*)(KP + row * ML_QSTR), 16, 0, 0); }
        LBAR();
        if (!DSK(1)) { const f32x4 e4 = *(const LAS f32x4*)(MS + MS_E + 4 * sg);
#pragma unroll
          for (int j = 0; j < 4; ++j) *(LAS v2u*)(VTE + (4 * vblk + j) * ML_VSTR + 4 * sg) = (v2u){cvtpk(po[0][j] * e4[0], po[1][j] * e4[1]), cvtpk(po[2][j] * e4[2], po[3][j] * e4[3])}; }
        __builtin_amdgcn_sched_barrier(0);
        pg8::f32x4 N2[4];
#pragma unroll
        for (int i = 0; i < 4; ++i) N2[i] = (pg8::f32x4){0.f, 0.f, 0.f, 0.f};
#if ML_PIPE3
        if (!DSK(3)) {
#define ML_R64(dst, off) asm volatile("ds_read_b64 %0, %1 offset:%2" : "=v"(dst) : "v"(qb_), "n"(off))
#define ML_RSET(buf, ks) do { ML_R64(fa[buf][0], 0 * 32 * ML_QSTR + 64 * (ks)); ML_R64(fb[buf][0], 0 * 32 * ML_QSTR + 64 * (ks) + 32); ML_R64(fa[buf][1], 1 * 32 * ML_QSTR + 64 * (ks)); ML_R64(fb[buf][1], 1 * 32 * ML_QSTR + 64 * (ks) + 32); \
                               ML_R64(fa[buf][2], 2 * 32 * ML_QSTR + 64 * (ks)); ML_R64(fb[buf][2], 2 * 32 * ML_QSTR + 64 * (ks) + 32); ML_R64(fa[buf][3], 3 * 32 * ML_QSTR + 64 * (ks)); ML_R64(fb[buf][3], 3 * 32 * ML_QSTR + 64 * (ks) + 32); } while (0)
            const unsigned qb_ = (unsigned)(__SIZE_TYPE__)((const LAS char*)QP) + (unsigned)((r * ML_QSTR + 4 * g) * 2);
            v2u fa[2][4], fb[2][4];
            ML_RSET(0, 0);
#pragma unroll
            for (int ks = 0; ks < 16; ++ks) {
                v4u bp; bp.x = Cb[2 * ks].x; bp.y = Cb[2 * ks].y; bp.z = Cb[2 * ks + 1].x; bp.w = Cb[2 * ks + 1].y;
                const pg8::bf16x8 bfrag = __builtin_bit_cast(pg8::bf16x8, bp);
                if (ks < 15) { if (ks & 1) ML_RSET(0, ks + 1); else ML_RSET(1, ks + 1); }
                if (ks < 15) asm volatile("s_waitcnt lgkmcnt(8)" : "+v"(fa[ks & 1][0]), "+v"(fb[ks & 1][0]), "+v"(fa[ks & 1][1]), "+v"(fb[ks & 1][1]), "+v"(fa[ks & 1][2]), "+v"(fb[ks & 1][2]), "+v"(fa[ks & 1][3]), "+v"(fb[ks & 1][3]));
                else asm volatile("s_waitcnt lgkmcnt(0)" : "+v"(fa[ks & 1][0]), "+v"(fb[ks & 1][0]), "+v"(fa[ks & 1][1]), "+v"(fb[ks & 1][1]), "+v"(fa[ks & 1][2]), "+v"(fb[ks & 1][2]), "+v"(fa[ks & 1][3]), "+v"(fb[ks & 1][3]));
#pragma unroll
                for (int tq = 0; tq < 4; ++tq) { const v4u ap = (v4u){fa[ks & 1][tq].x, fa[ks & 1][tq].y, fb[ks & 1][tq].x, fb[ks & 1][tq].y};
                    N2[tq] = __builtin_amdgcn_mfma_f32_16x16x32_bf16(__builtin_bit_cast(pg8::bf16x8, ap), bfrag, N2[tq], 0, 0, 0); }
            }
#undef ML_RSET
#undef ML_R64
        }
        __builtin_amdgcn_sched_barrier(0);
#else
        if (!DSK(3))
#pragma unroll
        for (int ks = 0; ks < 16; ++ks) {
            v4u bp; bp.x = Cb[2 * ks].x; bp.y = Cb[2 * ks].y; bp.z = Cb[2 * ks + 1].x; bp.w = Cb[2 * ks + 1].y;
            const pg8::bf16x8 bfrag = __builtin_bit_cast(pg8::bf16x8, bp);
#pragma unroll
            for (int tq = 0; tq < 4; ++tq) { const LAS bf16* qrow = QP + (16 * tq + r) * ML_QSTR + 32 * ks + 4 * g;
                const v2u a0 = *(const LAS v2u*)(qrow), a1 = *(const LAS v2u*)(qrow + 16); v4u ap; ap.x = a0.x; ap.y = a0.y; ap.z = a1.x; ap.w = a1.y;
                N2[tq] = __builtin_amdgcn_mfma_f32_16x16x32_bf16(__builtin_bit_cast(pg8::bf16x8, ap), bfrag, N2[tq], 0, 0, 0); }
            if ((ks & 3) == 3) __builtin_amdgcn_sched_barrier(0);
        }
#endif
        if (!DSK(7)) { const int tqq = w & 3, kh = w >> 2; pg8::f32x4 qa = {0.f, 0.f, 0.f, 0.f};
          int qn1 = ((16 * tqq + r) * ML_QSTR + 256 * kh + 4 * g) * 2, qn2 = qn1 + 32; asm volatile("" : "+v"(qn2));
#pragma unroll
          for (int k8 = 0; k8 < 8; ++k8) { const int ks = 8 * kh + k8;
              const v2u a0 = *(const LAS v2u*)((const LAS char*)QP + qn1 + 64 * k8), a1 = *(const LAS v2u*)((const LAS char*)QP + qn2 + 64 * k8); v4u ap; ap.x = a0.x; ap.y = a0.y; ap.z = a1.x; ap.w = a1.y;
#if ML_NSPLIT
              const v4u np = *(const LAS v4u*)(SD + 32 * ks + 8 * g), nl = *(const LAS v4u*)(SD + 512 + 32 * ks + 8 * g);
#else
              const f32x4 n0 = *(const LAS f32x4*)(MS + MS_N + 32 * ks + 4 * g), n1 = *(const LAS f32x4*)(MS + MS_N + 32 * ks + 16 + 4 * g);
              v4u np; np.x = cvtpk(n0.x, n0.y); np.y = cvtpk(n0.z, n0.w); np.z = cvtpk(n1.x, n1.y); np.w = cvtpk(n1.z, n1.w);
              v4u nl;
              nl.x = cvtpk(n0.x - bflo(np.x), n0.y - bfhi(np.x)); nl.y = cvtpk(n0.z - bflo(np.y), n0.w - bfhi(np.y)); nl.z = cvtpk(n1.x - bflo(np.z), n1.y - bfhi(np.z)); nl.w = cvtpk(n1.z - bflo(np.w), n1.w - bfhi(np.w));
#endif
              qa = __builtin_amdgcn_mfma_f32_16x16x32_bf16(__builtin_bit_cast(pg8::bf16x8, ap), __builtin_bit_cast(pg8::bf16x8, np), qa, 0, 0, 0);
              qa = __builtin_amdgcn_mfma_f32_16x16x32_bf16(__builtin_bit_cast(pg8::bf16x8, ap), __builtin_bit_cast(pg8::bf16x8, nl), qa, 0, 0, 0); }
          if (r == 0) {
#pragma unroll
              for (int rg = 0; rg < 4; ++rg) __hip_atomic_fetch_add(&MS[MS_QN + 16 * tqq + 4 * g + rg], qa[rg], __ATOMIC_RELAXED, __HIP_MEMORY_SCOPE_WORKGROUP); } }
        asm volatile("s_waitcnt vmcnt(0)" ::: "memory");
        LBAR();
        const int tm = w >> 1, tn0 = 2 * (w & 1);
        pg8::f32x4 S0 = {0.f, 0.f, 0.f, 0.f}, S1 = {0.f, 0.f, 0.f, 0.f};
        if (tn0 <= tm && !DSK(2)) {
#if ML_PIPE2
            const LAS bf16* pa = QP + (16 * tm + r) * ML_QSTR + 8 * g; const LAS bf16* pb = KP + (16 * tn0 + r) * ML_QSTR + 8 * g;
            pg8::bf16x8 an = *(const LAS pg8::bf16x8*)(pa), b0n = *(const LAS pg8::bf16x8*)(pb), b1n = *(const LAS pg8::bf16x8*)(pb + 16 * ML_QSTR);
#pragma unroll
            for (int ks = 0; ks < 16; ++ks) { const pg8::bf16x8 a = an, b0 = b0n, b1 = b1n;
                if (ks < 15) { an = *(const LAS pg8::bf16x8*)(pa + 32 * (ks + 1)); b0n = *(const LAS pg8::bf16x8*)(pb + 32 * (ks + 1)); b1n = *(const LAS pg8::bf16x8*)(pb + 16 * ML_QSTR + 32 * (ks + 1)); }
                S0 = __builtin_amdgcn_mfma_f32_16x16x32_bf16(a, b0, S0, 0, 0, 0); S1 = __builtin_amdgcn_mfma_f32_16x16x32_bf16(a, b1, S1, 0, 0, 0); }
            __builtin_amdgcn_sched_group_barrier(0x100, 6, 0);
#pragma unroll
            for (int i = 0; i < 14; ++i) { __builtin_amdgcn_sched_group_barrier(0x008, 2, 0); __builtin_amdgcn_sched_group_barrier(0x100, 3, 0); }
            __builtin_amdgcn_sched_group_barrier(0x008, 4, 0);
#else
#pragma unroll 4
            for (int ks = 0; ks < 16; ++ks) { const pg8::bf16x8 a = *(const LAS pg8::bf16x8*)(QP + (16 * tm + r) * ML_QSTR + 32 * ks + 8 * g);
                const pg8::bf16x8 b0 = *(const LAS pg8::bf16x8*)(KP + (16 * tn0 + r) * ML_QSTR + 32 * ks + 8 * g), b1 = *(const LAS pg8::bf16x8*)(KP + (16 * tn0 + 16 + r) * ML_QSTR + 32 * ks + 8 * g);
                S0 = __builtin_amdgcn_mfma_f32_16x16x32_bf16(a, b0, S0, 0, 0, 0); S1 = __builtin_amdgcn_mfma_f32_16x16x32_bf16(a, b1, S1, 0, 0, 0); }
#endif
#pragma unroll
            for (int rg = 0; rg < 4; ++rg) { const int t = 16 * tm + 4 * g + rg;
                if (16 * tn0 + r > t) S0[rg] = 0.f; if (16 * tn0 + 16 + r > t) S1[rg] = 0.f; }
        }
        __builtin_amdgcn_sched_barrier(0);
#else
        if (!DSK(0)) {
#if ML_QPF
#pragma unroll
            for (int it = 0; it < ML_QPF; ++it) { const int id = it * NTHR + tid, row = id >> 6, cchunk = id & 63; *(LAS v4u*)(QP + row * ML_QSTR + 8 * cchunk) = qpf[it]; }
#pragma unroll
            for (int it = ML_QPF; it < 8; ++it) { const int id = it * NTHR + tid, row = id >> 6, cchunk = id & 63;
                *(LAS v4u*)(QP + row * ML_QSTR + 8 * cchunk) = *(const GAS v4u*)(xcg + (m0 + row) * CW + hc0 + 8 * cchunk); }
#pragma unroll 4
            for (int it = 0; it < 8; ++it) { const int id = it * NTHR + tid, row = id >> 6, cchunk = id & 63;
                *(LAS v4u*)(KP + row * ML_QSTR + 8 * cchunk) = *(const GAS v4u*)(kpg + (m0 + row) * CW + hc0 + 8 * cchunk); }
#else
#pragma unroll 2
        for (int it = 0; it < 8; ++it) { const int id = it * NTHR + tid, row = id >> 6, cchunk = id & 63;
            const v4u q = *(const GAS v4u*)(xcg + (m0 + row) * CW + hc0 + 8 * cchunk), k = *(const GAS v4u*)(kpg + (m0 + row) * CW + hc0 + 8 * cchunk);
            *(LAS v4u*)(QP + row * ML_QSTR + 8 * cchunk) = q; *(LAS v4u*)(KP + row * ML_QSTR + 8 * cchunk) = k; }
#endif
        }
        if (w == 0 && !DSK(6)) {
            const int s = lid; const float mprev = MS[MS_SCAL + 2 + (ch & 1)];
            const float ipre = gates[(m0 + s) * 16 + hh], fpre = gates[(m0 + s) * 16 + 8 + hh];
            const float lf = fminf(fpre, 0.f) - log1pf(__expf(-fabsf(fpre)));
            float bcum = lf;
#pragma unroll
            for (int o = 1; o < 64; o <<= 1) { const float tv = bperm(s - o, bcum); if (s >= o) bcum += tv; }
            float pm = ipre - bcum;
#pragma unroll
            for (int o = 1; o < 64; o <<= 1) { const float tv = bperm(s - o, pm); if (s >= o) pm = fmaxf(pm, tv); }
            const float blast = __int_as_float(__builtin_amdgcn_readlane(__float_as_int(bcum), 63)), pmlast = __int_as_float(__builtin_amdgcn_readlane(__float_as_int(pm), 63));
            const float mt = fmaxf(bcum + mprev, bcum + pm);
            const float mnew = fmaxf(blast + mprev, blast + pmlast);
            MS[MS_E + s] = __expf(blast - bcum + ipre - mnew);
            MS[MS_ROWF + s] = __expf(bcum - blast + mnew - mt);
            MS[MS_SC + s] = __expf(bcum + mprev - mt);
            MS[MS_FLOOR + s] = __expf(-mt);
            MS[MS_QN + s] = 0.f;
            if (s == 0) { MS[MS_SCAL + 0] = __expf(blast + mprev - mnew); MS[MS_SCAL + 2 + ((ch + 1) & 1)] = mnew; }
        }
        LBAR();
        if (!DSK(1)) { const int vblk = tid & 31, sg = tid >> 5;
          const float* wb = wv + (size_t)(vc0 / 4 + vblk) * 16;
          const f32x4 q0 = *(const GAS f32x4*)(wb), q1 = *(const GAS f32x4*)(wb + 4), q2 = *(const GAS f32x4*)(wb + 8), q3 = *(const GAS f32x4*)(wb + 12);
          const f32x4 e4 = *(const LAS f32x4*)(MS + MS_E + 4 * sg);
          f32x4 o[4];
#pragma unroll
          for (int i = 0; i < 4; ++i) { const v2u xv = *(const GAS v2u*)(xm + (m0 + 4 * sg + i) * CW + vc0 + 4 * vblk);
              o[i] = (q0 * bflo(xv.x) + q1 * bfhi(xv.x) + q2 * bflo(xv.y) + q3 * bfhi(xv.y)) * e4[i]; }
#pragma unroll
          for (int j = 0; j < 4; ++j) *(LAS v2u*)(VTE + (4 * vblk + j) * ML_VSTR + 4 * sg) = (v2u){cvtpk(o[0][j], o[1][j]), cvtpk(o[2][j], o[3][j])}; }
        __builtin_amdgcn_sched_barrier(0);
        const int tm = w >> 1, tn0 = 2 * (w & 1);
        pg8::f32x4 S0 = {0.f, 0.f, 0.f, 0.f}, S1 = {0.f, 0.f, 0.f, 0.f};
        if (tn0 <= tm && !DSK(2)) {
#pragma unroll 4
            for (int ks = 0; ks < 16; ++ks) { const pg8::bf16x8 a = *(const LAS pg8::bf16x8*)(QP + (16 * tm + r) * ML_QSTR + 32 * ks + 8 * g);
                const pg8::bf16x8 b0 = *(const LAS pg8::bf16x8*)(KP + (16 * tn0 + r) * ML_QSTR + 32 * ks + 8 * g), b1 = *(const LAS pg8::bf16x8*)(KP + (16 * tn0 + 16 + r) * ML_QSTR + 32 * ks + 8 * g);
                S0 = __builtin_amdgcn_mfma_f32_16x16x32_bf16(a, b0, S0, 0, 0, 0); S1 = __builtin_amdgcn_mfma_f32_16x16x32_bf16(a, b1, S1, 0, 0, 0); }
#pragma unroll
            for (int rg = 0; rg < 4; ++rg) { const int t = 16 * tm + 4 * g + rg;
                if (16 * tn0 + r > t) S0[rg] = 0.f; if (16 * tn0 + 16 + r > t) S1[rg] = 0.f; }
        }
        __builtin_amdgcn_sched_barrier(0);
        pg8::f32x4 N2[4];
#pragma unroll
        for (int i = 0; i < 4; ++i) N2[i] = (pg8::f32x4){0.f, 0.f, 0.f, 0.f};
        if (!DSK(3))
#pragma unroll
        for (int ks = 0; ks < 16; ++ks) {
            v4u bp; bp.x = Cb[2 * ks].x; bp.y = Cb[2 * ks].y; bp.z = Cb[2 * ks + 1].x; bp.w = Cb[2 * ks + 1].y;
            const pg8::bf16x8 bfrag = __builtin_bit_cast(pg8::bf16x8, bp);
#pragma unroll
            for (int tq = 0; tq < 4; ++tq) { const LAS bf16* qrow = QP + (16 * tq + r) * ML_QSTR + 32 * ks + 4 * g;
                const v2u a0 = *(const LAS v2u*)(qrow), a1 = *(const LAS v2u*)(qrow + 16); v4u ap; ap.x = a0.x; ap.y = a0.y; ap.z = a1.x; ap.w = a1.y;
                N2[tq] = __builtin_amdgcn_mfma_f32_16x16x32_bf16(__builtin_bit_cast(pg8::bf16x8, ap), bfrag, N2[tq], 0, 0, 0); }
            if ((ks & 3) == 3) __builtin_amdgcn_sched_barrier(0);
        }
        if (!DSK(7)) { const int tqq = w & 3, kh = w >> 2; pg8::f32x4 qa = {0.f, 0.f, 0.f, 0.f};
#pragma unroll
          for (int k8 = 0; k8 < 8; ++k8) { const int ks = 8 * kh + k8;
              const LAS bf16* qrow = QP + (16 * tqq + r) * ML_QSTR + 32 * ks + 4 * g;
              const v2u a0 = *(const LAS v2u*)(qrow), a1 = *(const LAS v2u*)(qrow + 16); v4u ap; ap.x = a0.x; ap.y = a0.y; ap.z = a1.x; ap.w = a1.y;
              const f32x4 n0 = *(const LAS f32x4*)(MS + MS_N + 32 * ks + 4 * g), n1 = *(const LAS f32x4*)(MS + MS_N + 32 * ks + 16 + 4 * g);
              v4u np; np.x = cvtpk(n0.x, n0.y); np.y = cvtpk(n0.z, n0.w); np.z = cvtpk(n1.x, n1.y); np.w = cvtpk(n1.z, n1.w);
              v4u nl;
              nl.x = cvtpk(n0.x - bflo(np.x), n0.y - bfhi(np.x)); nl.y = cvtpk(n0.z - bflo(np.y), n0.w - bfhi(np.y)); nl.z = cvtpk(n1.x - bflo(np.z), n1.y - bfhi(np.z)); nl.w = cvtpk(n1.z - bflo(np.w), n1.w - bfhi(np.w));
              qa = __builtin_amdgcn_mfma_f32_16x16x32_bf16(__builtin_bit_cast(pg8::bf16x8, ap), __builtin_bit_cast(pg8::bf16x8, np), qa, 0, 0, 0);
              qa = __builtin_amdgcn_mfma_f32_16x16x32_bf16(__builtin_bit_cast(pg8::bf16x8, ap), __builtin_bit_cast(pg8::bf16x8, nl), qa, 0, 0, 0); }
          if (r == 0) {
#pragma unroll
              for (int rg = 0; rg < 4; ++rg) __hip_atomic_fetch_add(&MS[MS_QN + 16 * tqq + 4 * g + rg], qa[rg], __ATOMIC_RELAXED, __HIP_MEMORY_SCOPE_WORKGROUP); } }
#endif
#if !(ML_SDOWN && ML_GLDS)
        LBAR();
#endif
        if (tn0 <= tm) {
#pragma unroll
            for (int rg = 0; rg < 4; ++rg) { const int t = 16 * tm + 4 * g + rg; SD[SDX(t, 16 * tn0 + r)] = (bf16)f2bf(S0[rg]); SD[SDX(t, 16 * tn0 + 16 + r)] = (bf16)f2bf(S1[rg]); }
        } else {
#pragma unroll
            for (int rg = 0; rg < 4; ++rg) { const int t = 16 * tm + 4 * g + rg; SD[SDX(t, 16 * tn0 + r)] = 0; SD[SDX(t, 16 * tn0 + 16 + r)] = 0; }
        }
        LBAR();
#if ML_SDOWN && ML_GLDS
        if (ch + 1 < SEQ / 64) {
#if ML_XPF
            { int t2_ = F.tid; asm volatile("" : "+v"(t2_)); const int vb_ = t2_ & 31, sg_ = t2_ >> 5, l2_ = t2_ & 63;
#pragma unroll
              for (int i = 0; i < 4; ++i) xvn[i] = *(const GAS v2u*)(xm + (m0 + 64 + 4 * sg_ + i) * CW + vc0 + 4 * vb_);
              if (w == 0) { ipn = gates[(m0 + 64 + l2_) * 16 + hh]; const f32x2 bp = *(const GAS f32x2*)(gsc + ((ch + 1) * 64 + l2_) * 2); fpn = bp.x; gpn = bp.y; } }
#endif
#pragma unroll
            for (int i = 0; i < 8; ++i) { const int row = w + 8 * i;
                __builtin_amdgcn_global_load_lds((const unsigned*)(xcg + (m0 + 64 + row) * CW + hc0 + 8 * lid), (LAS unsigned*)(QP + row * ML_QSTR), 16, 0, 0); } }
#endif
#if ML_QPF
        if (ch + 1 < SEQ / 64) { int t2_ = F.tid; asm volatile("" : "+v"(t2_));
#pragma unroll
            for (int it = 0; it < ML_QPF; ++it) { const int id = it * NTHR + t2_, row = id >> 6, cchunk = id & 63; qpf[it] = *(const GAS v4u*)(xcg + (m0 + 64 + row) * CW + hc0 + 8 * cchunk); } }
#endif
        const float decay = MS[MS_SCAL + 0];
        pg8::bf16x8 eb0, eb1, el0, el1; pg8::f32x4 nacc[4];
#pragma unroll
        for (int i = 0; i < 4; ++i) nacc[i] = (pg8::f32x4){0.f, 0.f, 0.f, 0.f};
          { const f32x4 ea = *(const LAS f32x4*)(MS + MS_E + 8 * g), ebv = *(const LAS f32x4*)(MS + MS_E + 8 * g + 4), ec = *(const LAS f32x4*)(MS + MS_E + 32 + 8 * g), ed = *(const LAS f32x4*)(MS + MS_E + 32 + 8 * g + 4);
            v4u p0, p1; p0.x = cvtpk(ea.x, ea.y); p0.y = cvtpk(ea.z, ea.w); p0.z = cvtpk(ebv.x, ebv.y); p0.w = cvtpk(ebv.z, ebv.w); p1.x = cvtpk(ec.x, ec.y); p1.y = cvtpk(ec.z, ec.w); p1.z = cvtpk(ed.x, ed.y); p1.w = cvtpk(ed.z, ed.w);
            eb0 = __builtin_bit_cast(pg8::bf16x8, p0); eb1 = __builtin_bit_cast(pg8::bf16x8, p1);
#if NEW_N == 4
            v4u q0, q1;
            q0.x = cvtpk(ea.x - bflo(p0.x), ea.y - bfhi(p0.x)); q0.y = cvtpk(ea.z - bflo(p0.y), ea.w - bfhi(p0.y)); q0.z = cvtpk(ebv.x - bflo(p0.z), ebv.y - bfhi(p0.z)); q0.w = cvtpk(ebv.z - bflo(p0.w), ebv.w - bfhi(p0.w));
            q1.x = cvtpk(ec.x - bflo(p1.x), ec.y - bfhi(p1.x)); q1.y = cvtpk(ec.z - bflo(p1.y), ec.w - bfhi(p1.y)); q1.z = cvtpk(ed.x - bflo(p1.z), ed.y - bfhi(p1.z)); q1.w = cvtpk(ed.z - bflo(p1.w), ed.w - bfhi(p1.w));
            el0 = __builtin_bit_cast(pg8::bf16x8, q0); el1 = __builtin_bit_cast(pg8::bf16x8, q1);
#endif
          }
        pg8::f32x4 RSa[4];
#pragma unroll
        for (int i = 0; i < 4; ++i) RSa[i] = (pg8::f32x4){0.f, 0.f, 0.f, 0.f};
#pragma unroll
        for (int i = 0; i < 4; ++i) N2[i] = N2[i] * decay;
#pragma unroll
        for (int ks = 0; ks < 2; ++ks) { const pg8::bf16x8 vb = *(const LAS pg8::bf16x8*)(VTE + (16 * w + r) * ML_VSTR + 32 * ks + 8 * g);
#pragma unroll
            for (int tq = 0; tq < 4; ++tq) { const pg8::bf16x8 a = *(const LAS pg8::bf16x8*)(SD + SDX(16 * tq + r, 32 * ks + 8 * g));
                N2[tq] = __builtin_amdgcn_mfma_f32_16x16x32_bf16(a, vb, N2[tq], 0, 0, 0);
                RSa[tq] = __builtin_amdgcn_mfma_f32_16x16x32_bf16(a, ks ? eb1 : eb0, RSa[tq], 0, 0, 0); RSa[tq] = __builtin_amdgcn_mfma_f32_16x16x32_bf16(a, ks ? el1 : el0, RSa[tq], 0, 0, 0); } }
#pragma unroll
        for (int tq = 0; tq < 4; ++tq)
#pragma unroll
            for (int rg = 0; rg < 4; ++rg) { const int t = 16 * tq + 4 * g + rg; const float rowf = MS[MS_ROWF + t], sc = MS[MS_SC + t];
                const float num = rowf * N2[tq][rg], den = rowf * RSa[tq][rg] + sc * MS[MS_QN + t];
                const float hval = num / fmaxf(fabsf(den), MS[MS_FLOOR + t]);
                if (!dry) xm[(m0 + t) * CW + vc0 + 16 * w + r] = (bf16)f2bf(hval); }
        __builtin_amdgcn_sched_barrier(0);
        { const pg8::bf16x8 vb0 = *(const LAS pg8::bf16x8*)(VTE + (16 * w + r) * ML_VSTR + 8 * g), vb1 = *(const LAS pg8::bf16x8*)(VTE + (16 * w + r) * ML_VSTR + 32 + 8 * g);
          const int q4 = r >> 2, p4 = r & 3;
#if ML_PIPE6 && NEW_N == 4
#define ML_TRA(dst0, dst1, KB) do { const LAS bf16* base_ = KP + (8 * g + q4) * ML_QSTR + 16 * (KB) + 4 * p4; \
              const s16x4 t00 = __builtin_amdgcn_ds_read_tr16_b64_v4i16((LAS s16x4*)(base_)), t01 = __builtin_amdgcn_ds_read_tr16_b64_v4i16((LAS s16x4*)(base_ + 4 * ML_QSTR)); \
              const s16x4 t10 = __builtin_amdgcn_ds_read_tr16_b64_v4i16((LAS s16x4*)(base_ + 32 * ML_QSTR)), t11 = __builtin_amdgcn_ds_read_tr16_b64_v4i16((LAS s16x4*)(base_ + 36 * ML_QSTR)); \
              dst0[0] = t00[0]; dst0[1] = t00[1]; dst0[2] = t00[2]; dst0[3] = t00[3]; dst0[4] = t01[0]; dst0[5] = t01[1]; dst0[6] = t01[2]; dst0[7] = t01[3]; \
              dst1[0] = t10[0]; dst1[1] = t10[1]; dst1[2] = t10[2]; dst1[3] = t10[3]; dst1[4] = t11[0]; dst1[5] = t11[1]; dst1[6] = t11[2]; dst1[7] = t11[3]; } while (0)
          if (!DSK(4)) {
              { pg8::f32x4 na[4];
#pragma unroll
                for (int i = 0; i < 4; ++i) { pg8::bf16x8 a0, a1; ML_TRA(a0, a1, 4 * w + i);
                    na[i] = __builtin_amdgcn_mfma_f32_16x16x32_bf16(a0, eb0, ((pg8::f32x4){0.f, 0.f, 0.f, 0.f}), 0, 0, 0); na[i] = __builtin_amdgcn_mfma_f32_16x16x32_bf16(a1, eb1, na[i], 0, 0, 0);
                    na[i] = __builtin_amdgcn_mfma_f32_16x16x32_bf16(a0, el0, na[i], 0, 0, 0); na[i] = __builtin_amdgcn_mfma_f32_16x16x32_bf16(a1, el1, na[i], 0, 0, 0); }
                if (r == 0) {
#pragma unroll
                    for (int i = 0; i < 4; ++i) { LAS f32x4* np_ = (LAS f32x4*)(MS + MS_N + 16 * (4 * w + i) + 4 * g); *np_ = *np_ * decay + na[i]; } } }
              __builtin_amdgcn_sched_barrier(0);
              pg8::bf16x8 an[2][2];
              ML_TRA(an[0][0], an[0][1], 0); ML_TRA(an[1][0], an[1][1], 1);
#pragma unroll
              for (int kp = 0; kp < 16; ++kp) {
                  pg8::bf16x8 ac[2][2];
#pragma unroll
                  for (int u = 0; u < 2; ++u) { ac[u][0] = an[u][0]; ac[u][1] = an[u][1]; }
                  if (kp < 15) { ML_TRA(an[0][0], an[0][1], 2 * kp + 2); ML_TRA(an[1][0], an[1][1], 2 * kp + 3); }
                  pg8::f32x4 c0 = (pg8::f32x4){bflo(Cb[2 * kp].x), bfhi(Cb[2 * kp].x), bflo(Cb[2 * kp].y), bfhi(Cb[2 * kp].y)} * decay;
                  pg8::f32x4 c1 = (pg8::f32x4){bflo(Cb[2 * kp + 1].x), bfhi(Cb[2 * kp + 1].x), bflo(Cb[2 * kp + 1].y), bfhi(Cb[2 * kp + 1].y)} * decay;
                  c0 = __builtin_amdgcn_mfma_f32_16x16x32_bf16(ac[0][0], vb0, c0, 0, 0, 0); c1 = __builtin_amdgcn_mfma_f32_16x16x32_bf16(ac[1][0], vb0, c1, 0, 0, 0);
                  c0 = __builtin_amdgcn_mfma_f32_16x16x32_bf16(ac[0][1], vb1, c0, 0, 0, 0); c1 = __builtin_amdgcn_mfma_f32_16x16x32_bf16(ac[1][1], vb1, c1, 0, 0, 0);
                  Cb[2 * kp].x = cvtpk(c0[0], c0[1]); Cb[2 * kp].y = cvtpk(c0[2], c0[3]); Cb[2 * kp + 1].x = cvtpk(c1[0], c1[1]); Cb[2 * kp + 1].y = cvtpk(c1[2], c1[3]);
              }
              __builtin_amdgcn_sched_group_barrier(0x100, 8, 0);
#pragma unroll
              for (int i = 0; i < 15; ++i) { __builtin_amdgcn_sched_group_barrier(0x100, 8, 0); __builtin_amdgcn_sched_group_barrier(0x008, 4, 0); }
              __builtin_amdgcn_sched_group_barrier(0x008, 4, 0);
          }
#undef ML_TRA
#else
          if (!DSK(4))
#pragma unroll
          for (int kb = 0; kb < 32; ++kb) {
              const LAS bf16* base = KP + (8 * g + q4) * ML_QSTR + 16 * kb + 4 * p4;
              const s16x4 t00 = __builtin_amdgcn_ds_read_tr16_b64_v4i16((LAS s16x4*)(base)), t01 = __builtin_amdgcn_ds_read_tr16_b64_v4i16((LAS s16x4*)(base + 4 * ML_QSTR));
              const s16x4 t10 = __builtin_amdgcn_ds_read_tr16_b64_v4i16((LAS s16x4*)(base + 32 * ML_QSTR)), t11 = __builtin_amdgcn_ds_read_tr16_b64_v4i16((LAS s16x4*)(base + 36 * ML_QSTR));
              pg8::bf16x8 a0, a1;
              a0[0] = t00[0]; a0[1] = t00[1]; a0[2] = t00[2]; a0[3] = t00[3]; a0[4] = t01[0]; a0[5] = t01[1]; a0[6] = t01[2]; a0[7] = t01[3];
              a1[0] = t10[0]; a1[1] = t10[1]; a1[2] = t10[2]; a1[3] = t10[3]; a1[4] = t11[0]; a1[5] = t11[1]; a1[6] = t11[2]; a1[7] = t11[3];
              pg8::f32x4 c = (pg8::f32x4){bflo(Cb[kb].x), bfhi(Cb[kb].x), bflo(Cb[kb].y), bfhi(Cb[kb].y)} * decay;
              c = __builtin_amdgcn_mfma_f32_16x16x32_bf16(a0, vb0, c, 0, 0, 0);
              c = __builtin_amdgcn_mfma_f32_16x16x32_bf16(a1, vb1, c, 0, 0, 0);
              Cb[kb].x = cvtpk(c[0], c[1]); Cb[kb].y = cvtpk(c[2], c[3]);
              if (NEW_N && (kb >> 2) == w) { pg8::f32x4 na = __builtin_amdgcn_mfma_f32_16x16x32_bf16(a0, eb0, ((pg8::f32x4){0.f, 0.f, 0.f, 0.f}), 0, 0, 0); na = __builtin_amdgcn_mfma_f32_16x16x32_bf16(a1, eb1, na, 0, 0, 0);
#if NEW_N == 4
                  na = __builtin_amdgcn_mfma_f32_16x16x32_bf16(a0, el0, na, 0, 0, 0); na = __builtin_amdgcn_mfma_f32_16x16x32_bf16(a1, el1, na, 0, 0, 0);
#endif
#if NEW_N == 2
                  if (r == 0) { LAS f32x4* np_ = (LAS f32x4*)(MS + MS_QN + 600 + 16 * kb + 4 * g); *np_ = na; } }
#elif NEW_N == 3
                  nacc[kb & 3] = na; }
#else
                  if (r == 0) { LAS f32x4* np_ = (LAS f32x4*)(MS + MS_N + 16 * kb + 4 * g); *np_ = *np_ * decay + na; } }
#endif
              if ((kb & 7) == 7) __builtin_amdgcn_sched_barrier(0);
          }
#endif
#if NEW_N == 3
          if (r == 0) {
#pragma unroll
              for (int i = 0; i < 4; ++i) { LAS f32x4* np_ = (LAS f32x4*)(MS + MS_N + 16 * (4 * w + i) + 4 * g); *np_ = *np_ * decay + nacc[i]; } }
#endif
          if (NEW_N != 1 && NEW_N != 3 && NEW_N != 4) { float nk = MS[MS_N + tid] * decay;
#pragma unroll 8
          for (int s2 = 0; s2 < 64; ++s2) nk += MS[MS_E + s2] * bf1(KP[s2 * ML_QSTR + tid]);
          MS[MS_N + tid] = nk; }
        }
        LBAR();
    }
}

#ifndef SITE_MASK
#define SITE_MASK 0xFFFFFFFFu
#endif
#define SITE_ON(n) (((SITE_MASK) >> (n)) & 1u)
#ifndef GEMM_ALIGN
#define GEMM_ALIGN true
#endif
#ifndef GEMM_SP2
#define GEMM_SP2 true
#endif
#ifndef RW_SKIP
#define RW_SKIP 0
#endif
#ifndef RW_REP
#define RW_REP 1
#endif
#ifndef RG_REP
#define RG_REP 1
#endif
#ifndef REP_MASK
#define REP_MASK 0u
#endif
#define SITE_REP(n) (1 + (int)(((REP_MASK) >> (n)) & 1u))
constexpr int N_PHASES = 22;
struct Args { Ptrs p; int ph_lo, ph_hi, li, pad; };
__device__ __forceinline__ Frame mk_frame(LAS unsigned char* lds) {
    Frame F; F.lds = lds; int t = threadIdx.x; asm volatile("" : "+v"(t));
    F.tid = t; F.lane = t & 63; F.wave = __builtin_amdgcn_readfirstlane(t >> 6);
    F.G = gridDim.x; F.gw = blockIdx.x * NWAVES + F.wave; F.NGW = F.G * NWAVES; return F;
}
template <class Epi, bool ALIGN = GEMM_ALIGN> __device__ __forceinline__ void run_gemm(Frame& F, const bf16* A, const bf16* Bt, int Mr, int N, int K, const Epi& E) {
    pg8::Gemm g{A, Bt, Mr, N, K}; pg8::StaticOrder S; S.init(Mr, N, F.G, (int)blockIdx.x);
    pg8::gemm_phase<Epi, pg8::StaticOrder, ALIGN, GEMM_SP2>(F.lds, g, S, E);
}
__global__ void __launch_bounds__(NTHR, 2) fwd_kernel(Args args) {
    extern __shared__ __attribute__((aligned(16))) unsigned char lds_raw[];
    const Ptrs& P = args.p; unsigned char* ws = P.ws;
    volatile LAS unsigned* MISC = (volatile LAS unsigned*)((LAS unsigned char*)lds_raw + MISC_OFF);
    if (threadIdx.x < 64) MISC[threadIdx.x] = 0u;
    __syncthreads();
    XcdBarrier bar = xcd_barrier_post((unsigned*)(ws + WS_CTL) + 1024 + args.li * 4096, MISC + 8);
    const int lo = args.ph_lo, hi = args.ph_hi;
    int ph = 0;
#define PHASE_BEGIN if (ph >= lo && ph < hi) { Frame F = mk_frame((LAS unsigned char*)lds_raw);
#define PHASE_END   if (ph + 1 < hi) xcd_barrier(bar); } ++ph;

    PHASE_BEGIN
#if SITE_ON(0)
 for (int rep_ = 0; rep_ < SITE_REP(0); ++rep_) { if (rep_) xcd_barrier(bar);
 ph_prologue(F, P); ph_cast_ss(F, P.in[IN_X], (bf16*)P.out, (float*)(ws + WS_SS) + 3 * M);  }
#endif
    PHASE_END
    PHASE_BEGIN
#if SITE_ON(1)
 for (int rep_ = 0; rep_ < SITE_REP(1); ++rep_) { if (rep_) xcd_barrier(bar);
#if defined(DIAG_GEMM) && DIAG_GEMM < 10
 { unsigned long long* dbg = (unsigned long long*)(ws + 768 * 1024) + blockIdx.x * 8; if (threadIdx.x == 0) { dbg[0] = 0; dbg[1] = 0; dbg[3] = 0; dbg[2] = (unsigned long long)clock64(); }
   pg8::EpiTimed<pg8::EpiBf16<0>> E{{(bf16*)(ws + WS_PROJ), EIN_PAD, nullptr, 0, 0, 1.f}, dbg}; run_gemm(F, (const bf16*)(ws + WS_H), (const bf16*)(ws + WS_W_IN_E), M, EIN_PAD, DM, E); }
#else
 { pg8::EpiBf16<0> E{(bf16*)(ws + WS_PROJ), EIN_PAD, nullptr, 0, 0, 1.f, (const float*)(ws + WS_SS) + 3 * M}; run_gemm(F, (const bf16*)P.out, (const bf16*)(ws + WS_W_IN_E), M, EIN_PAD, DM, E); }
#endif
 }
#endif
    PHASE_END
    PHASE_BEGIN
#if SITE_ON(2)
 for (int rep_ = 0; rep_ < SITE_REP(2); ++rep_) { if (rep_) xcd_barrier(bar);
 ph_lra(F, P);  }
#endif
    PHASE_END
    PHASE_BEGIN
#if SITE_ON(3)
 for (int rep_ = 0; rep_ < SITE_REP(3); ++rep_) { if (rep_) xcd_barrier(bar);
 { pg8::EpiBf16<0> E{(bf16*)(ws + WS_LR), LRN, (const float*)(ws + WS_LRB), 0, 0, 1.f}; run_gemm(F, (const bf16*)(ws + WS_LRA), (const bf16*)(ws + WS_W_LR), M, LRN, LRK, E); }  }
#endif
    PHASE_END
    PHASE_BEGIN
#if SITE_ON(4)
 for (int rep_ = 0; rep_ < SITE_REP(4); ++rep_) { if (rep_) xcd_barrier(bar);
 if (F.G >= 256 && blockIdx.x >= 192) { Frame Fl = F; Fl.gw = (blockIdx.x - 192) * NWAVES + F.wave; Fl.NGW = (F.G - 192) * NWAVES; ph_late_weights(Fl, P); } else if (F.G < 256 && blockIdx.x == 0) { }
 if (F.G < 256) { ph_late_weights(F, P); __syncthreads(); }
 for (int u = blockIdx.x; u < 192; u += F.G) { if (u < 128) { for (int q_ = 0; q_ < RW_REP; ++q_) { rwkv_unit2(F, P, u, (q_ + 1 < RW_REP) ? RW_SKIP : 0); __syncthreads(); } } else { for (int q_ = 0; q_ < RG_REP; ++q_) { rglru_unit(F, P, u - 128); __syncthreads(); } } }  }
#endif
    PHASE_END
    PHASE_BEGIN
#if SITE_ON(5)
 for (int rep_ = 0; rep_ < SITE_REP(5); ++rep_) { if (rep_) xcd_barrier(bar);
 { pg8::EpiRes E{nullptr, (const bf16*)P.out, nullptr, DM, (bf16*)(ws + WS_HRAW0), (float*)(ws + WS_SSP)}; run_gemm(F, (const bf16*)(ws + WS_H), (const bf16*)(ws + WS_W_OUT_E), M, DM, DM, E); }  }
#endif
    PHASE_END
        PHASE_BEGIN
 ph_ss_reduce(F, (const float*)(ws + WS_SSP), (float*)(ws + WS_SS) + 0);
    PHASE_END

    for (int layer = 0; layer < 2; ++layer) {
        if (layer == 1) {
            PHASE_BEGIN
#if SITE_ON(7)
 for (int rep_ = 0; rep_ < SITE_REP(7); ++rep_) { if (rep_) xcd_barrier(bar);
 { pg8::EpiBf16<0> E{(bf16*)(ws + WS_XM), CW, nullptr, 0, 0, 1.f, (const float*)(ws + WS_SS) + M}; run_gemm(F, (const bf16*)(ws + WS_H), (const bf16*)(ws + WS_W_IN_O), M, CW, DM, E); }  }
#endif
    PHASE_END
            PHASE_BEGIN
#if SITE_ON(8)
 for (int rep_ = 0; rep_ < SITE_REP(8); ++rep_) { if (rep_) xcd_barrier(bar);
 ph_mlstm_pre(F, P);  }
#endif
    PHASE_END
            PHASE_BEGIN
#if SITE_ON(9)
 for (int rep_ = 0; rep_ < SITE_REP(9); ++rep_) { if (rep_) xcd_barrier(bar);
 for (int u = blockIdx.x; u < 256; u += F.G) { const int x = u & 7, y = u >> 3, hd = 8 * (y >> 2) + x; mlstm_unit(F, P, (hd << 2) | (y & 3), rep_ + 1 < SITE_REP(9)); }  }
#endif
    PHASE_END
            PHASE_BEGIN
#if SITE_ON(10)
 for (int rep_ = 0; rep_ < SITE_REP(10); ++rep_) { if (rep_) xcd_barrier(bar);
 ph_mlstm_stats(F, P);  }
#endif
    PHASE_END
            PHASE_BEGIN
#if SITE_ON(11)
 for (int rep_ = 0; rep_ < SITE_REP(11); ++rep_) { if (rep_) xcd_barrier(bar);
 { pg8::EpiZLn E{(const bf16*)(ws + WS_XM), (bf16*)(ws + WS_XC), CW, (const float*)(ws + WS_SS) + M, (const float*)(ws + WS_STATS), P.in[IN_C_LN_W], P.in[IN_C_SKIP]}; run_gemm(F, (const bf16*)(ws + WS_H), (const bf16*)(ws + WS_W_IN_O) + (size_t)CW * DM, M, CW, DM, E); }  }
#endif
    PHASE_END
            PHASE_BEGIN
#if SITE_ON(12)
 for (int rep_ = 0; rep_ < SITE_REP(12); ++rep_) { if (rep_) xcd_barrier(bar);
 { pg8::EpiRes E{nullptr, (const bf16*)(ws + WS_H), nullptr, DM, (bf16*)(ws + WS_H), (float*)(ws + WS_SSP)}; run_gemm(F, (const bf16*)(ws + WS_XC), (const bf16*)(ws + WS_W_OUT_O), M, DM, CW, E); }  }
#endif
    PHASE_END
        PHASE_BEGIN
 ph_ss_reduce(F, (const float*)(ws + WS_SSP), (float*)(ws + WS_SS) + 2 * M);
    PHASE_END

        }
        const bf16* wgu = (const bf16*)(ws + (layer ? WS_W_GU1 : WS_W_GU0)); const bf16* wdn = (const bf16*)(ws + (layer ? WS_W_DN1 : WS_W_DN0));
        const float* fcw = P.in[IN_FFN_CONV_W] + (size_t)layer * 3 * DFF; const float* fcb = P.in[IN_FFN_CONV_B] + (size_t)layer * DFF;
        PHASE_BEGIN
#if SITE_ON(14)
 for (int rep_ = 0; rep_ < SITE_REP(14); ++rep_) { if (rep_) xcd_barrier(bar);
#if defined(DIAG_GEMM) && DIAG_GEMM >= 10
 { unsigned long long* dbg = (unsigned long long*)(ws + 768 * 1024) + blockIdx.x * 8; if (threadIdx.x == 0 && layer == 0) { dbg[0] = 0; dbg[1] = 0; dbg[3] = 0; } if (threadIdx.x == 0) dbg[2] = (unsigned long long)clock64();
   pg8::EpiTimed<pg8::EpiGU> E{{(bf16*)(ws + WS_U), fcw, fcb, (float*)(ws + WS_GTAIL), (float*)(ws + WS_PREH), (float*)(ws + WS_UPH), (LAS float*)(F.lds + HALO_OFF), (const float*)(ws + WS_SS) + (layer ? 2 * M : 0)}, dbg}; run_gemm<pg8::EpiGU, true>(F, (const bf16*)(ws + (layer ? WS_H : WS_HRAW0)), wgu, M, GUN, DM, E); } }
#else
 { pg8::EpiGU E{(bf16*)(ws + WS_U), fcw, fcb, (float*)(ws + WS_GTAIL), (float*)(ws + WS_PREH), (float*)(ws + WS_UPH), (LAS float*)(F.lds + HALO_OFF), (const float*)(ws + WS_SS) + (layer ? 2 * M : 0)}; run_gemm<pg8::EpiGU, true>(F, (const bf16*)(ws + (layer ? WS_H : WS_HRAW0)), wgu, M, GUN, DM, E); } }
#endif

#endif
    PHASE_END
        PHASE_BEGIN
#if SITE_ON(15)
 for (int rep_ = 0; rep_ < SITE_REP(15); ++rep_) { if (rep_) xcd_barrier(bar);
 ph_ffn_fix(F, (bf16*)(ws + WS_U), fcw, (const float*)(ws + WS_GTAIL), (const float*)(ws + WS_PREH), (const float*)(ws + WS_UPH)); }
#endif
    PHASE_END
        PHASE_BEGIN
#if SITE_ON(16)
 for (int rep_ = 0; rep_ < SITE_REP(16); ++rep_) { if (rep_) xcd_barrier(bar);
 { pg8::EpiRes E{nullptr, (const bf16*)(ws + (layer ? WS_H : WS_HRAW0)), nullptr, DM, (bf16*)(ws + WS_H), layer ? (float*)nullptr : (float*)(ws + WS_SSP)}; run_gemm(F, (const bf16*)(ws + WS_U), wdn, M, DM, DFF, E); } }
#endif
    PHASE_END
        if (layer == 0) {
        PHASE_BEGIN
 ph_ss_reduce(F, (const float*)(ws + WS_SSP), (float*)(ws + WS_SS) + M);
    PHASE_END
        }

    }
    PHASE_BEGIN
#if SITE_ON(17)
 for (int rep_ = 0; rep_ < SITE_REP(17); ++rep_) { if (rep_) xcd_barrier(bar);
#ifdef DIAG_GEMM
 { const unsigned long long* dbg = (const unsigned long long*)(ws + 768 * 1024); double k = 0, e2 = 0, n = 0; for (int i = 0; i < 256; ++i) { k += (double)dbg[i * 8]; e2 += (double)dbg[i * 8 + 1]; n += (double)dbg[i * 8 + 3]; }
   const float v = (DIAG_GEMM % 10) == 1 ? sqrtf(100.f * floorf((float)(e2 / k) * 25.f + 0.5f) / 25.f) : ((DIAG_GEMM % 10) == 2 ? sqrtf(floorf((float)(k / n) / 4000.f + 0.5f) * 4.f) : sqrtf(floorf((float)(e2 / n) / 2000.f + 0.5f) * 2.f));
   for (size_t i = (size_t)blockIdx.x * NTHR + threadIdx.x; i < (size_t)M * DM; i += (size_t)gridDim.x * NTHR) P.out[i] = v; }
#else
 ph_rmsnorm_final(F, (const bf16*)(ws + WS_H), P.in[IN_FINAL_NORM], P.out);
#endif
 }
#endif
    PHASE_END
#undef PHASE_BEGIN
#undef PHASE_END
}


#ifdef DIAG_PHASES
__global__ void cks_kernel(const unsigned* p0, size_t n0, const unsigned* p1, size_t n1, const unsigned* p2, size_t n2, unsigned long long* slot) {
    unsigned long long s = 0; const size_t gt = (size_t)blockIdx.x * blockDim.x + threadIdx.x, GT = (size_t)gridDim.x * blockDim.x;
    for (size_t i = gt; i < n0; i += GT) s += (unsigned long long)p0[i] * (unsigned long long)((i & 1023) + 1);
    for (size_t i = gt; i < n1; i += GT) s += (unsigned long long)p1[i] * (unsigned long long)((i & 1023) + 1);
    for (size_t i = gt; i < n2; i += GT) s += (unsigned long long)p2[i] * (unsigned long long)((i & 1023) + 1);
    for (int o = 32; o >= 1; o >>= 1) s += __shfl_xor(s, o);
    if ((threadIdx.x & 63) == 0) atomicAdd(slot, s);
}
__global__ void diag_out_kernel(const unsigned long long* slots, float* out, size_t n) {
    int p = 0; for (int i = N_PHASES - 1; i >= 0; --i) if (slots[i] != slots[64 + i]) p = i + 1;
    const float v = 1.0f + (float)p;
    for (size_t i = (size_t)blockIdx.x * blockDim.x + threadIdx.x; i < n; i += (size_t)gridDim.x * blockDim.x) out[i] = v;
}
#endif
extern "C" void kernel_launch(void* const* d_in, const int* in_sizes, int n_in, void* d_out, int out_size, void* d_ws, size_t ws_size, hipStream_t stream) {
    static int grid = 0;
    if (grid == 0) {
        if (n_in != 41 || out_size != M * DM || ws_size < WS_END) { fprintf(stderr, "kernel_launch: unexpected problem (n_in %d, out %d, ws %zu)\n", n_in, out_size, ws_size); grid = -1; return; }
        int dev = 0, cus = 0, per_cu = 0;
        if (hipGetDevice(&dev) != hipSuccess || hipDeviceGetAttribute(&cus, hipDeviceAttributeMultiprocessorCount, dev) != hipSuccess) { grid = -1; return; }
        if (hipFuncSetAttribute((const void*)fwd_kernel, hipFuncAttributeMaxDynamicSharedMemorySize, LDS_BYTES) != hipSuccess) { fprintf(stderr, "kernel_launch: hipFuncSetAttribute failed\n"); grid = -1; return; }
        if (hipOccupancyMaxActiveBlocksPerMultiprocessor(&per_cu, (const void*)fwd_kernel, NTHR, LDS_BYTES) != hipSuccess || per_cu < 1) { fprintf(stderr, "kernel_launch: occupancy query says %d\n", per_cu); (void)hipGetLastError(); }
        grid = cus;
    }
    if (grid < 0) return;
    (void)hipMemsetAsync((char*)d_ws + WS_CTL, 0, CTL_ZERO_BYTES, stream);
    Args a{};
    for (int i = 0; i < 41; ++i) a.p.in[i] = (const float*)d_in[i];
    a.p.out = (float*)d_out; a.p.ws = (unsigned char*)d_ws;
    constexpr int NL = MK_N_LAUNCHES;
#ifdef DIAG_PHASES
    static_assert(NL == N_PHASES, "diag build runs one launch per phase");
    unsigned long long* slots = (unsigned long long*)((char*)d_ws + 65536);
    unsigned char* w8 = (unsigned char*)d_ws;
    for (int run = 0; run < 2; ++run)
    for (int li = 0; li < NL; ++li) {
        a.ph_lo = li; a.ph_hi = li + 1; a.li = 0;
        hipLaunchKernelGGL(fwd_kernel, dim3(grid), dim3(NTHR), LDS_BYTES, stream, a);
        const unsigned *p0 = nullptr, *p1 = nullptr, *p2 = nullptr; size_t n0 = 0, n1 = 0, n2 = 0;
        auto R = [&](size_t off, size_t bytes, const unsigned*& p, size_t& n) { p = (const unsigned*)(w8 + off); n = bytes / 4; };
        const size_t HB = (size_t)M * DM * 2, OB = (size_t)M * DM * 4;
        switch (li) {
            case 0: R(WS_H, HB, p0, n0); R(WS_W_IN_O, 120 * MiB, p1, n1); R(WS_W_IN_E, 96 * MiB, p2, n2); break;
            case 1: R(WS_PROJ, (size_t)M * EIN_PAD * 2, p0, n0); break;
            case 2: R(WS_LRA, (size_t)M * LRK * 2, p0, n0); break;
            case 3: R(WS_LR, (size_t)M * LRN * 2, p0, n0); break;
            case 4: R(WS_H, HB, p0, n0); break;
            case 6: case 13: case 20: R(WS_H, HB, p0, n0); break;
            case 7: case 10: case 21: case 24: R(WS_GU, (size_t)MH * GUN * 2, p0, n0); break;
            case 8: case 11: case 22: case 25: R(WS_U, (size_t)MH * DFF * 2, p0, n0); break;
            case 14: case 16: R(WS_XM, (size_t)M * CW * 2, p0, n0); break;
            case 15: R(WS_XC, (size_t)M * CW * 2, p0, n0); R(WS_KPP, (size_t)M * CW * 2, p1, n1); R(WS_GATES, (size_t)M * 16 * 4, p2, n2); break;
            case 17: case 18: R(WS_XC, (size_t)M * CW * 2, p0, n0); break;
            default: p0 = (const unsigned*)d_out; n0 = OB / 4; break;
        }
        hipLaunchKernelGGL(cks_kernel, dim3(1024), dim3(256), 0, stream, p0, n0, p1, n1, p2, n2, slots + run * 64 + li);
    }
    hipLaunchKernelGGL(diag_out_kernel, dim3(1024), dim3(256), 0, stream, (const unsigned long long*)slots, (float*)d_out, (size_t)M * DM);
#else
    for (int li = 0; li < NL; ++li) {
        a.ph_lo = (int)((long)N_PHASES * li / NL); a.ph_hi = (int)((long)N_PHASES * (li + 1) / NL); a.li = (NL == N_PHASES) ? 0 : (li & 3);
        hipLaunchKernelGGL(fwd_kernel, dim3(grid), dim3(NTHR), LDS_BYTES, stream, a);
    }
#endif
}
```

```cpp
#include <hip/hip_runtime.h>
#include <cstdio>
#include <cstdint>
#ifndef MK_N_LAUNCHES
#define MK_N_LAUNCHES 1
#endif
#ifndef PG8_WGM
#define PG8_WGM 8
#endif
namespace pg8 {
#define PG8_LAS __attribute__((address_space(3)))
typedef unsigned short bf16_t;
typedef short bf16x8 __attribute__((ext_vector_type(8)));
typedef float f32x4 __attribute__((ext_vector_type(4)));
typedef unsigned u32x4 __attribute__((ext_vector_type(4)));
constexpr int BM = 256, BK = 64, HALF = 128, HTB = HALF * BK * 2  , STAGE_BYTES = 8 * HTB, NXCD = 8, WGM = PG8_WGM;

__host__ __device__ __forceinline__ int lds_byte(int r, int c) { const int st = (r >> 4) * 2 + (c >> 5), rr = r & 15, cc = c & 31, ob = rr * 64 + cc * 2; return st * 1024 + (ob ^ (((ob >> 9) & 1) << 5)); }
__host__ __device__ __forceinline__ void stage_rc(int b, int& R, int& C) { const int st = b / 1024, sb = b % 1024, swz = sb ^ (((sb >> 9) & 1) << 5); R = (st >> 1) * 16 + swz / 64; C = (st & 1) * 32 + (swz % 64) / 2; }
__host__ __device__ __forceinline__ int perm32(int rho) { const int n = rho >> 4, i = rho & 15; return 8 * (i >> 2) + 4 * n + (i & 3); }

struct Unit { int pm, pn; };
struct Gemm { const bf16_t* A; const bf16_t* Bt; int M, N, K; };

struct StaticOrder {
    int nM, nN, nwg, G, c;
    __host__ __device__ void init(int M, int N, int G_, int c_) { nM = M / BM; nN = N / BM; nwg = nM * nN; G = G_; c = c_; }
    __host__ __device__ bool next(int i, Unit& u) const {
        const long L = (long)i * G + c; if (L >= nwg) return false;
        int wgid = (int)L; { const int q = nwg / NXCD, r = nwg % NXCD, xcd = wgid % NXCD, off = wgid / NXCD; wgid = (xcd < r ? xcd * (q + 1) : r * (q + 1) + (xcd - r) * q) + off; }
        const int nig = WGM * nN, gid = wgid / nig, fm = gid * WGM, gsz = (nM - fm) < WGM ? (nM - fm) : WGM;
        u.pm = fm + ((wgid % nig) % gsz); u.pn = (wgid % nig) / gsz; return true;
    }
    __device__ __forceinline__ void a_ready(const Unit&) const {}
    __device__ __forceinline__ void done(const Unit&) const {}
};

typedef float f32x2c __attribute__((ext_vector_type(2))); typedef __bf16 bf16x2c __attribute__((ext_vector_type(2)));
__device__ __forceinline__ unsigned cvt_pk_bf16(float lo, float hi) { const f32x2c v = {lo, hi}; return __builtin_bit_cast(unsigned, __builtin_convertvector(v, bf16x2c)); }
typedef float f32x2 __attribute__((ext_vector_type(2)));
__device__ __forceinline__ f32x2 gelu_pk(f32x2 v) {
    const f32x2 av = __builtin_elementwise_abs(v), d = av * 0.2316418882f + 1.0f;
    f32x2 t; t.x = __builtin_amdgcn_rcpf(d.x); t.y = __builtin_amdgcn_rcpf(d.y);
    f32x2 q = t * 0.5307027145f + (-0.7265760135f); q = q * t + 0.7107068705f; q = q * t + (-0.142248368f); q = q * t + 0.127414796f; q = q * t;
    const f32x2 s = (v * v) * (-0.72134752044f);
    f32x2 e; e.x = __builtin_amdgcn_exp2f(s.x); e.y = __builtin_amdgcn_exp2f(s.y);
    const f32x2 m = v * (q * e), r = v - m;
    f32x2 o; o.x = v.x < 0.f ? m.x : r.x; o.y = v.y < 0.f ? m.y : r.y; return o;
}
template <int ACT  > struct EpiBf16 {
    static constexpr bool PERM = true, AFTER_DRAIN = false; static_assert(ACT == 0 || ACT == 1, "EpiBf16: ACT is 0 (none) or 1 (gelu_pk)");
    bf16_t* O; int ldc; const float* bias; int split_cols; size_t split_stride; float scale0; const float* ss = nullptr;
    __device__ __forceinline__ void operator()(const f32x4 (&acc)[2][2][4][2], const Unit& u, int wr, int wc, int fr, int fq) const {
        const int row0 = u.pm * BM + wr * 64 + fr; int colt = u.pn * BM; bf16_t* base = O;
        float sc = 1.f; if (split_cols) { const int t = colt / split_cols; base += (size_t)t * split_stride; colt -= t * split_cols; if (t == 0) sc = scale0; }
        const int col0 = colt + wc * 32 + 8 * fq, bcol0 = u.pn * BM + wc * 32 + 8 * fq;
        f32x4 bv[2][2];
#pragma unroll
        for (int bj = 0; bj < 2; ++bj)
#pragma unroll
            for (int n = 0; n < 2; ++n) bv[bj][n] = bias ? *(const f32x4*)(bias + bcol0 + bj * HALF + 4 * n) : (f32x4){0.f, 0.f, 0.f, 0.f};
#pragma unroll
        for (int ai = 0; ai < 2; ++ai)
#pragma unroll
            for (int m = 0; m < 4; ++m) { bf16_t* rowp = base + (size_t)(row0 + ai * HALF + m * 16) * ldc + col0; const float rs = ss ? rsqrtf(ss[row0 + ai * HALF + m * 16] * (1.f / 2048.f) + 1e-6f) : 1.f;
#pragma unroll
                for (int bj = 0; bj < 2; ++bj) { f32x4 v0 = acc[ai][bj][m][0] * rs + bv[bj][0], v1 = acc[ai][bj][m][1] * rs + bv[bj][1];
                    if (ACT == 1) { f32x2 a = gelu_pk((f32x2){v0[0], v0[1]}), b = gelu_pk((f32x2){v0[2], v0[3]}), c = gelu_pk((f32x2){v1[0], v1[1]}), d = gelu_pk((f32x2){v1[2], v1[3]});
                        v0 = (f32x4){a.x, a.y, b.x, b.y}; v1 = (f32x4){c.x, c.y, d.x, d.y}; }
                    v0 = v0 * sc; v1 = v1 * sc; u32x4 w; w.x = cvt_pk_bf16(v0[0], v0[1]); w.y = cvt_pk_bf16(v0[2], v0[3]); w.z = cvt_pk_bf16(v1[0], v1[1]); w.w = cvt_pk_bf16(v1[2], v1[3]);
                    *(u32x4*)(rowp + bj * HALF) = w; } }
    }
};
__device__ __forceinline__ float fsigmoid(float x) { return __builtin_amdgcn_rcpf(1.0f + __expf(-x)); }
struct EpiRes {
    static constexpr bool PERM = true, AFTER_DRAIN = false;
    const float* res; const bf16_t* resb; float* out; int ldc; bf16_t* hraw; float* ss;
    __device__ __forceinline__ void operator()(const f32x4 (&acc)[2][2][4][2], const Unit& u, int wr, int wc, int fr, int fq) const {
        const int row0 = u.pm * BM + wr * 64 + fr, col0 = u.pn * BM + wc * 32 + 8 * fq;
#pragma unroll
        for (int ai = 0; ai < 2; ++ai)
#pragma unroll
            for (int m = 0; m < 4; ++m) { const size_t off = (size_t)(row0 + ai * HALF + m * 16) * ldc + col0; float sq = 0.f;
#pragma unroll
                for (int bj = 0; bj < 2; ++bj) {
                    f32x4 r0, r1;
                    if (res) { r0 = *(const f32x4*)(res + off + bj * HALF); r1 = *(const f32x4*)(res + off + bj * HALF + 4); }
                    else { const u32x4 rb = *(const u32x4*)(resb + off + bj * HALF);
                        r0 = (f32x4){__uint_as_float(rb.x << 16), __uint_as_float(rb.x & 0xffff0000u), __uint_as_float(rb.y << 16), __uint_as_float(rb.y & 0xffff0000u)};
                        r1 = (f32x4){__uint_as_float(rb.z << 16), __uint_as_float(rb.z & 0xffff0000u), __uint_as_float(rb.w << 16), __uint_as_float(rb.w & 0xffff0000u)}; }
                    const f32x4 o0 = r0 + acc[ai][bj][m][0], o1 = r1 + acc[ai][bj][m][1];
                    if (out) { *(f32x4*)(out + off + bj * HALF) = o0; *(f32x4*)(out + off + bj * HALF + 4) = o1; }
                    if (hraw) { u32x4 w; w.x = cvt_pk_bf16(o0[0], o0[1]); w.y = cvt_pk_bf16(o0[2], o0[3]); w.z = cvt_pk_bf16(o1[0], o1[1]); w.w = cvt_pk_bf16(o1[2], o1[3]); *(u32x4*)(hraw + off + bj * HALF) = w;
                        sq += ((o0[0] * o0[0] + o0[1] * o0[1]) + (o0[2] * o0[2] + o0[3] * o0[3])) + ((o1[0] * o1[0] + o1[1] * o1[1]) + (o1[2] * o1[2] + o1[3] * o1[3])); } }
                if (hraw && ss) { sq += __shfl_xor(sq, 16); sq += __shfl_xor(sq, 32); if (fq == 0) ss[(size_t)(row0 + ai * HALF + m * 16) * 32 + u.pn * 4 + wc] = sq; }
                if (m & 1) asm volatile("" ::: "memory"); }
    }
};
struct EpiLR {
    static constexpr bool PERM = true, AFTER_DRAIN = false;
    bf16_t* O; const float* w0; const float* a0;
    __device__ __forceinline__ void operator()(const f32x4 (&acc)[2][2][4][2], const Unit& u, int wr, int wc, int fr, int fq) const {
        const int row0 = u.pm * BM + wr * 64 + fr, col0 = u.pn * BM + wc * 32 + 8 * fq;
        const int kind = u.pn >> 2;
        const float* bsrc = kind == 0 ? w0 + col0 : a0 + (col0 - 1024);
#pragma unroll
        for (int bj = 0; bj < 2; ++bj) {
            f32x4 bv0 = (f32x4){0.f, 0.f, 0.f, 0.f}, bv1 = bv0;
            if (kind < 2) { bv0 = *(const f32x4*)(bsrc + bj * HALF); bv1 = *(const f32x4*)(bsrc + bj * HALF + 4); }
#pragma unroll
        for (int ai = 0; ai < 2; ++ai)
#pragma unroll
            for (int m = 0; m < 4; ++m) { bf16_t* rowp = O + (size_t)(row0 + ai * HALF + m * 16) * 3072 + col0;
                { f32x4 v0 = acc[ai][bj][m][0] + bv0, v1 = acc[ai][bj][m][1] + bv1;
                    if (kind < 2) {
#pragma unroll
                        for (int j = 0; j < 4; ++j) { v0[j] = fsigmoid(v0[j]); v1[j] = fsigmoid(v1[j]); }
                        if (kind == 0) { v0 = v0 * (-0.60653066f); v1 = v1 * (-0.60653066f); } }
                    u32x4 w; w.x = cvt_pk_bf16(v0[0], v0[1]); w.y = cvt_pk_bf16(v0[2], v0[3]); w.z = cvt_pk_bf16(v1[0], v1[1]); w.w = cvt_pk_bf16(v1[2], v1[3]);
                    *(u32x4*)(rowp + bj * HALF) = w; } }
            asm volatile("" ::: "memory"); }
    }
};
struct EpiZMul {
    static constexpr bool PERM = true, AFTER_DRAIN = false;
    bf16_t* HS; int ldc; const float* ss;
    __device__ __forceinline__ void operator()(const f32x4 (&acc)[2][2][4][2], const Unit& u, int wr, int wc, int fr, int fq) const {
        const int row0 = u.pm * BM + wr * 64 + fr, col0 = u.pn * BM + wc * 32 + 8 * fq;
#pragma unroll
        for (int ai = 0; ai < 2; ++ai)
#pragma unroll
            for (int m = 0; m < 4; ++m) { bf16_t* rowp = HS + (size_t)(row0 + ai * HALF + m * 16) * ldc + col0; const float rs = rsqrtf(ss[row0 + ai * HALF + m * 16] * (1.f / 2048.f) + 1e-6f);
#pragma unroll
                for (int bj = 0; bj < 2; ++bj) { const u32x4 h = *(const u32x4*)(rowp + bj * HALF); f32x4 v0 = acc[ai][bj][m][0] * rs, v1 = acc[ai][bj][m][1] * rs;
                    float hv[8];
#pragma unroll
                    for (int j = 0; j < 4; ++j) { hv[2 * j] = __uint_as_float(h[j] << 16); hv[2 * j + 1] = __uint_as_float(h[j] & 0xffff0000u); }
#pragma unroll
                    for (int j = 0; j < 4; ++j) { v0[j] = hv[j] * v0[j] * fsigmoid(v0[j]); v1[j] = hv[4 + j] * v1[j] * fsigmoid(v1[j]); }
                    u32x4 w; w.x = cvt_pk_bf16(v0[0], v0[1]); w.y = cvt_pk_bf16(v0[2], v0[3]); w.z = cvt_pk_bf16(v1[0], v1[1]); w.w = cvt_pk_bf16(v1[2], v1[3]);
                    *(u32x4*)(rowp + bj * HALF) = w; } }
    }
};

template <int CTRL> __device__ __forceinline__ float dpp_mv(float old, float x) { return __int_as_float(__builtin_amdgcn_update_dpp(__float_as_int(old), __float_as_int(x), CTRL, 0xf, 0xf, false)); }
struct EpiGU {
    static constexpr bool PERM = true, AFTER_DRAIN = false;
    bf16_t* U; const float* cw; const float* cb; float* gtail; float* preh; float* uph; PG8_LAS float* halo; const float* ss;
    __device__ __forceinline__ void operator()(const f32x4 (&acc_)[2][2][4][2], const Unit& u, int wr, int wc, int fr, int fq) const {
        constexpr int DFF_ = 5632;
        f32x4 acc[2][2][4][2];
#pragma unroll
        for (int ai = 0; ai < 2; ++ai)
#pragma unroll
            for (int m = 0; m < 4; ++m) { const float rs = rsqrtf(ss[u.pm * BM + ai * HALF + wr * 64 + m * 16 + fr] * (1.f / 2048.f) + 1e-6f);
#pragma unroll
                for (int bj = 0; bj < 2; ++bj)
#pragma unroll
                    for (int n = 0; n < 2; ++n) acc[ai][bj][m][n] = acc_[ai][bj][m][n] * rs; }
        const int cc = wc * 32 + 8 * fq, col0 = u.pn * 128 + cc;
        const bool seq_start = ((u.pm * BM) & 4095) == 0;
        if (fr >= 14) {
#pragma unroll
            for (int ai = 0; ai < 2; ++ai) { PG8_LAS float* h = halo + ((2 * ai + wr) * 2 + (fr - 14)) * 128 + cc;
                *(PG8_LAS f32x4*)h = acc[ai][0][3][0]; *(PG8_LAS f32x4*)(h + 4) = acc[ai][0][3][1]; }
            if (wr == 1) { float* gt = gtail + ((size_t)u.pm * 2 + (fr - 14)) * DFF_ + col0; *(f32x4*)gt = acc[1][0][3][0]; *(f32x4*)(gt + 4) = acc[1][0][3][1]; }
        }
        asm volatile("s_waitcnt lgkmcnt(0)" ::: "memory"); __builtin_amdgcn_s_barrier(); asm volatile("" ::: "memory");
        f32x4 w0[2], w1[2], w2[2], bb[2];
#pragma unroll
        for (int n = 0; n < 2; ++n) { w0[n] = *(const f32x4*)(cw + col0 + 4 * n); w1[n] = *(const f32x4*)(cw + DFF_ + col0 + 4 * n); w2[n] = *(const f32x4*)(cw + 2 * DFF_ + col0 + 4 * n); bb[n] = *(const f32x4*)(cb + col0 + 4 * n); }
#pragma unroll
        for (int ai = 0; ai < 2; ++ai) {
            const int s = 2 * ai + wr;
            f32x4 P[2] = {(f32x4){0.f, 0.f, 0.f, 0.f}, (f32x4){0.f, 0.f, 0.f, 0.f}};
            if (s > 0 && fr >= 14) { const PG8_LAS float* h = halo + ((s - 1) * 2 + (fr - 14)) * 128 + cc; P[0] = *(const PG8_LAS f32x4*)h; P[1] = *(const PG8_LAS f32x4*)(h + 4); }
#pragma unroll
            for (int m = 0; m < 4; ++m) {
                const int row = u.pm * BM + ai * HALF + wr * 64 + m * 16 + fr;
                f32x4 o[2];
#pragma unroll
                for (int n = 0; n < 2; ++n) { const f32x4 cur = acc[ai][0][m][n], prv = (m == 0) ? P[n] : acc[ai][0][m - 1][n], upv = acc[ai][1][m][n];
#pragma unroll
                    for (int e2 = 0; e2 < 4; ++e2) {
                        const float g1 = dpp_mv<0x111>(dpp_mv<0x121>(0.f, prv[e2]), cur[e2]);
                        const float g2 = dpp_mv<0x112>(dpp_mv<0x122>(0.f, prv[e2]), cur[e2]);
                        const float pre = bb[n][e2] + w0[n][e2] * g2 + w1[n][e2] * g1 + w2[n][e2] * cur[e2];
                        o[n][e2] = pre;
                    } }
                if (ai == 0 && wr == 0 && m == 0 && fr < 2 && !seq_start) {
                    float* ph = preh + ((size_t)u.pm * 2 + fr) * DFF_ + col0; float* uh = uph + ((size_t)u.pm * 2 + fr) * DFF_ + col0;
                    *(f32x4*)ph = o[0]; *(f32x4*)(ph + 4) = o[1]; *(f32x4*)uh = acc[0][1][0][0]; *(f32x4*)(uh + 4) = acc[0][1][0][1];
                } else {
                    f32x4 v0, v1;
#pragma unroll
                    for (int e2 = 0; e2 < 4; ++e2) { v0[e2] = o[0][e2] * fsigmoid(o[0][e2]) * acc[ai][1][m][0][e2]; v1[e2] = o[1][e2] * fsigmoid(o[1][e2]) * acc[ai][1][m][1][e2]; }
                    u32x4 w; w.x = cvt_pk_bf16(v0[0], v0[1]); w.y = cvt_pk_bf16(v0[2], v0[3]); w.z = cvt_pk_bf16(v1[0], v1[1]); w.w = cvt_pk_bf16(v1[2], v1[3]);
                    *(u32x4*)(U + (size_t)row * DFF_ + col0) = w;
                }
            }
        }
    }
};

#ifndef ZLN_MB
#define ZLN_MB 2
#endif
#ifndef ZLN_DRYNOLOAD
#define ZLN_DRYNOLOAD 0
#endif
#ifndef ZLN_PKMATH
#define ZLN_PKMATH 1
#endif
#ifndef ZLN_PK
#define ZLN_PK 0
#endif
struct EpiZLn {
    static constexpr bool PERM = true, AFTER_DRAIN = false;
    const bf16_t* hc; bf16_t* xc; int ldc; const float* ss; const float* stats; const float* lnw; const float* skip; bf16_t* xo = nullptr; PG8_LAS unsigned* dummy = nullptr; int nM = 0, nN = 0; mutable int ui = 0;
    __device__ __forceinline__ void operator()(const f32x4 (&acc)[2][2][4][2], const Unit& u, int wr, int wc, int fr, int fq) const {
        const int row0 = u.pm * BM + wr * 64 + fr, col0 = u.pn * BM + wc * 32 + 8 * fq, head = u.pn >> 1;
        if (dummy) { ++ui; const int nwg_ = nM * nN; int wgid_ = ui * (int)gridDim.x + (int)blockIdx.x;
            if (wgid_ < nwg_) { { const int q_ = nwg_ / NXCD, r_ = nwg_ % NXCD, xcd_ = wgid_ % NXCD, off_ = wgid_ / NXCD; wgid_ = (xcd_ < r_ ? xcd_ * (q_ + 1) : r_ * (q_ + 1) + (xcd_ - r_) * q_) + off_; }
                const int nig_ = WGM * nN, fm_ = (wgid_ / nig_) * WGM, gsz_ = (nM - fm_) < WGM ? (nM - fm_) : WGM, pm_ = fm_ + ((wgid_ % nig_) % gsz_), pn_ = (wgid_ % nig_) / gsz_;
                const int tid_ = (wr * 4 + wc) * 64 + fq * 16 + fr; const size_t o_ = (size_t)(pm_ * BM + (tid_ >> 1)) * ldc + pn_ * BM + (tid_ & 1) * 128;
                PG8_LAS unsigned* d_ = dummy + (wr * 4 + wc) * 64;
                __builtin_amdgcn_global_load_lds((const unsigned*)(hc + o_), d_, 4, 0, 0); __builtin_amdgcn_global_load_lds((const unsigned*)(hc + o_ + 64), d_, 4, 0, 0);
                __builtin_amdgcn_global_load_lds((const unsigned*)(xc + o_), d_, 4, 0, 0); __builtin_amdgcn_global_load_lds((const unsigned*)(xc + o_ + 64), d_, 4, 0, 0); } }
#pragma unroll
        for (int bj = 0; bj < 2; ++bj) {
#if ZLN_PK
            u32x4 lwp, skp;
            { const f32x4 a = *(const f32x4*)(lnw + col0 + bj * HALF), b = *(const f32x4*)(lnw + col0 + bj * HALF + 4), c = *(const f32x4*)(skip + col0 + bj * HALF), d = *(const f32x4*)(skip + col0 + bj * HALF + 4);
              lwp = (u32x4){cvt_pk_bf16(a[0], a[1]), cvt_pk_bf16(a[2], a[3]), cvt_pk_bf16(b[0], b[1]), cvt_pk_bf16(b[2], b[3])}; skp = (u32x4){cvt_pk_bf16(c[0], c[1]), cvt_pk_bf16(c[2], c[3]), cvt_pk_bf16(d[0], d[1]), cvt_pk_bf16(d[2], d[3])}; }
#define ZLN_LW0(i) (((i) & 1) ? __uint_as_float(lwp[(i) >> 1] & 0xffff0000u) : __uint_as_float(lwp[(i) >> 1] << 16))
#define ZLN_LW1(i) (((i) & 1) ? __uint_as_float(lwp[2 + ((i) >> 1)] & 0xffff0000u) : __uint_as_float(lwp[2 + ((i) >> 1)] << 16))
#define ZLN_SK0(i) (((i) & 1) ? __uint_as_float(skp[(i) >> 1] & 0xffff0000u) : __uint_as_float(skp[(i) >> 1] << 16))
#define ZLN_SK1(i) (((i) & 1) ? __uint_as_float(skp[2 + ((i) >> 1)] & 0xffff0000u) : __uint_as_float(skp[2 + ((i) >> 1)] << 16))
#else
            const f32x4 lw0 = *(const f32x4*)(lnw + col0 + bj * HALF), lw1 = *(const f32x4*)(lnw + col0 + bj * HALF + 4), sk0 = *(const f32x4*)(skip + col0 + bj * HALF), sk1 = *(const f32x4*)(skip + col0 + bj * HALF + 4);
#define ZLN_LW0(i) lw0[i]
#define ZLN_LW1(i) lw1[i]
#define ZLN_SK0(i) sk0[i]
#define ZLN_SK1(i) sk1[i]
#endif
#pragma unroll
            for (int a0 = 0; a0 < 8; a0 += ZLN_MB) {
                u32x4 hh[ZLN_MB], xx[ZLN_MB]; float rs_[ZLN_MB], mean_[ZLN_MB], rstd_[ZLN_MB];
#pragma unroll
                for (int q = 0; q < ZLN_MB; ++q) { const int row = row0 + ((a0 + q) >> 2) * HALF + ((a0 + q) & 3) * 16; const size_t off = (size_t)row * ldc + col0 + bj * HALF;
                        if (ZLN_DRYNOLOAD && xo) { hh[q] = (u32x4){0u, 0u, 0u, 0u}; xx[q] = hh[q]; } else { hh[q] = *(const u32x4*)(hc + off); xx[q] = *(const u32x4*)(xc + off); }
                        rs_[q] = ss[row]; mean_[q] = stats[((size_t)row * 8 + head) * 2]; rstd_[q] = stats[((size_t)row * 8 + head) * 2 + 1]; }
                asm volatile("" ::: "memory");
#pragma unroll
                for (int q = 0; q < ZLN_MB; ++q) { const int ai = (a0 + q) >> 2, m = (a0 + q) & 3; const int row = row0 + ai * HALF + m * 16; const size_t off = (size_t)row * ldc + col0 + bj * HALF;
                        const float rs = rsqrtf(rs_[q] * (1.f / 2048.f) + 1e-6f); const float mean = mean_[q], rstd = rstd_[q];
                        const u32x4 h = hh[q], x = xx[q];
#if ZLN_PKMATH
                        const f32x2 ra = {rstd, rstd}, rb = {-mean * rstd, -mean * rstd}, rs2 = {rs, rs}, nl2 = {-1.442695041f * rs, -1.442695041f * rs}, one2 = {1.f, 1.f};
                        u32x4 w;
#pragma unroll
                        for (int p = 0; p < 4; ++p) {
                            const f32x2 hv = {__uint_as_float(h[p] << 16), __uint_as_float(h[p] & 0xffff0000u)}, xv = {__uint_as_float(x[p] << 16), __uint_as_float(x[p] & 0xffff0000u)};
                            const f32x2 lw2 = (p < 2) ? (f32x2){ZLN_LW0(2 * p), ZLN_LW0(2 * p + 1)} : (f32x2){ZLN_LW1(2 * p - 4), ZLN_LW1(2 * p - 3)};
                            const f32x2 sk2 = (p < 2) ? (f32x2){ZLN_SK0(2 * p), ZLN_SK0(2 * p + 1)} : (f32x2){ZLN_SK1(2 * p - 4), ZLN_SK1(2 * p - 3)};
                            const f32x2 av = (p < 2) ? (f32x2){acc[ai][bj][m][0][2 * p], acc[ai][bj][m][0][2 * p + 1]} : (f32x2){acc[ai][bj][m][1][2 * p - 4], acc[ai][bj][m][1][2 * p - 3]};
                            const f32x2 hs = (hv * ra + rb) * lw2 + sk2 * xv;
                            const f32x2 ea = av * nl2;
                            const f32x2 den = (f32x2){__builtin_amdgcn_exp2f(ea.x), __builtin_amdgcn_exp2f(ea.y)} + one2;
                            const f32x2 sg = {__builtin_amdgcn_rcpf(den.x), __builtin_amdgcn_rcpf(den.y)};
                            const f32x2 o = hs * (av * rs2) * sg;
                            w[p] = cvt_pk_bf16(o.x, o.y); }
#else
                        f32x4 z0 = acc[ai][bj][m][0] * rs, z1 = acc[ai][bj][m][1] * rs, o0, o1;
#pragma unroll
                        for (int j = 0; j < 2; ++j) {
                            const float h0 = __uint_as_float(h[j] << 16), h1 = __uint_as_float(h[j] & 0xffff0000u), h2 = __uint_as_float(h[j + 2] << 16), h3 = __uint_as_float(h[j + 2] & 0xffff0000u);
                            const float x0 = __uint_as_float(x[j] << 16), x1 = __uint_as_float(x[j] & 0xffff0000u), x2 = __uint_as_float(x[j + 2] << 16), x3 = __uint_as_float(x[j + 2] & 0xffff0000u);
                            o0[2 * j] = ((h0 - mean) * rstd * ZLN_LW0(2 * j) + ZLN_SK0(2 * j) * x0); o0[2 * j + 1] = ((h1 - mean) * rstd * ZLN_LW0(2 * j + 1) + ZLN_SK0(2 * j + 1) * x1);
                            o1[2 * j] = ((h2 - mean) * rstd * ZLN_LW1(2 * j) + ZLN_SK1(2 * j) * x2); o1[2 * j + 1] = ((h3 - mean) * rstd * ZLN_LW1(2 * j + 1) + ZLN_SK1(2 * j + 1) * x3); }
#pragma unroll
                        for (int j = 0; j < 4; ++j) { o0[j] *= z0[j] * fsigmoid(z0[j]); o1[j] *= z1[j] * fsigmoid(z1[j]); }
                        u32x4 w; w.x = cvt_pk_bf16(o0[0], o0[1]); w.y = cvt_pk_bf16(o0[2], o0[3]); w.z = cvt_pk_bf16(o1[0], o1[1]); w.w = cvt_pk_bf16(o1[2], o1[3]);
#endif
                        if (!(xo && row >= 6528 && row < 6784)) *(u32x4*)((xo ? xo : xc) + off) = w; }
                asm volatile("" ::: "memory"); }
            asm volatile("" ::: "memory"); }
    }
};

template <class Inner> struct EpiTimed {
    static constexpr bool PERM = Inner::PERM, AFTER_DRAIN = false;
    Inner in; unsigned long long* dbg;
    __device__ __forceinline__ void operator()(const f32x4 (&acc)[2][2][4][2], const Unit& u, int wr, int wc, int fr, int fq) const {
        const bool rec = (threadIdx.x == 0);
        unsigned long long t0 = 0; if (rec) { t0 = (unsigned long long)clock64(); dbg[0] += t0 - dbg[2]; }
        in(acc, u, wr, wc, fr, fq);
        asm volatile("s_waitcnt vmcnt(0)" ::: "memory");
        if (rec) { const unsigned long long t1 = (unsigned long long)clock64(); dbg[1] += t1 - t0; dbg[2] = t1; dbg[3] += 1; }
    }
};
template <class Epi, class Sched, bool ALIGN_EPI = false, bool SP2 = false>
__device__ __forceinline__ void gemm_phase(PG8_LAS unsigned char* lds, const Gemm g, const Sched& S, const Epi& E) {
    int tid_ = threadIdx.x; asm volatile("" : "+v"(tid_));
    int tid = tid_, lane = tid & 63, fr = lane & 15, fq = lane >> 4; const int wid = __builtin_amdgcn_readfirstlane(tid >> 6), wr = wid >> 2, wc = wid & 3;
    const int K = g.K, nt = K / BK;
    unsigned voffA[2], voffB[2]; int aoff, boff;
#define PG8_LANE_SETUP() do { _Pragma("unroll") for (int i = 0; i < 2; ++i) { int R, C; stage_rc(tid * 16 + i * 8192, R, C); const int Rb = Epi::PERM ? ((R & ~31) + perm32(R & 31)) : R; \
        voffA[i] = (unsigned)(R * K + C) * 2u; voffB[i] = (unsigned)(Rb * K + C) * 2u; } \
        aoff = lds_byte(wr * 64 + fr, fq * 8); boff = lds_byte(wc * 32 + fr, fq * 8); } while (0)
    PG8_LANE_SETUP();
    const size_t kstep = (size_t)(BK * 2);
    const size_t hstep = (size_t)HALF * K * 2;
    const size_t tstep = 2 * hstep;
    const unsigned ldsw = (unsigned)wid * 1024u;
#define PG8_SA(b, h) (((b) * 2 + (h)) * HTB)
#define PG8_SB(b, h) ((4 + (b) * 2 + (h)) * HTB)
#ifndef PG8_AUX_B
#define PG8_AUX_B 0
#endif
#ifndef PG8_AUX_A
#define PG8_AUX_A 0
#endif
#define PG8_STAGE(bufoff, gbase, voff) do { _Pragma("unroll") for (int _i = 0; _i < 2; ++_i) { \
        if ((bufoff) >= 4 * HTB) __builtin_amdgcn_global_load_lds((const unsigned*)((const char*)(gbase) + (voff)[_i]), (PG8_LAS unsigned*)(lds + (bufoff) + ldsw + _i * 8192), 16, 0, PG8_AUX_B); \
        else __builtin_amdgcn_global_load_lds((const unsigned*)((const char*)(gbase) + (voff)[_i]), (PG8_LAS unsigned*)(lds + (bufoff) + ldsw + _i * 8192), 16, 0, PG8_AUX_A); } } while (0)
#define PG8_LDA(dst, b, h) do { _Pragma("unroll") for (int m = 0; m < 4; ++m) _Pragma("unroll") for (int k = 0; k < 2; ++k) dst[m][k] = *(const PG8_LAS bf16x8*)(lds + PG8_SA(b, h) + aoff + m * 2048 + k * 1024); } while (0)
#define PG8_LDB(dst, b, h) do { _Pragma("unroll") for (int n = 0; n < 2; ++n) _Pragma("unroll") for (int k = 0; k < 2; ++k) dst[n][k] = *(const PG8_LAS bf16x8*)(lds + PG8_SB(b, h) + boff + n * 2048 + k * 1024); } while (0)
#define PG8_MMA(ai, bj, At, Bt) do { __builtin_amdgcn_s_setprio(1); _Pragma("unroll") for (int m = 0; m < 4; ++m) _Pragma("unroll") for (int n = 0; n < 2; ++n) _Pragma("unroll") for (int k = 0; k < 2; ++k) \
        acc[ai][bj][m][n] = __builtin_amdgcn_mfma_f32_16x16x32_bf16(Bt[n][k], At[m][k], acc[ai][bj][m][n], 0, 0, 0); __builtin_amdgcn_s_setprio(0); } while (0)
#define PG8_WAIT_V(n) asm volatile("s_waitcnt vmcnt(" #n ")" ::: "memory")
#define PG8_WAIT_L(n) asm volatile("s_waitcnt lgkmcnt(" #n ")" ::: "memory")
#define PG8_BAR __builtin_amdgcn_s_barrier()
#define PG8_SCHED __builtin_amdgcn_sched_barrier(0)
    Unit cur, nxt; int ui = 0;
    if (!S.next(0, cur)) return;
    f32x4 acc[2][2][4][2];
#pragma unroll
    for (int a = 0; a < 2; ++a)
#pragma unroll
        for (int b = 0; b < 2; ++b)
#pragma unroll
            for (int m = 0; m < 4; ++m)
#pragma unroll
                for (int n = 0; n < 2; ++n) acc[a][b][m][n] = (f32x4){0.f, 0.f, 0.f, 0.f};
    bf16x8 At[4][2], B0[2][2], B1[2][2];
    const char* cA = (const char*)g.A + (size_t)cur.pm * tstep; const char* cB = (const char*)g.Bt + (size_t)cur.pn * tstep;
    S.a_ready(cur);
    if constexpr (SP2) {
        PG8_STAGE(PG8_SB(0, 0), cB, voffB); PG8_STAGE(PG8_SB(0, 1), cB + hstep, voffB); PG8_STAGE(PG8_SA(0, 0), cA, voffA); PG8_STAGE(PG8_SA(0, 1), cA + hstep, voffA);
        if (wr == 1) PG8_BAR;
        PG8_WAIT_V(2); PG8_BAR;
        PG8_STAGE(PG8_SB(1, 0), cB + kstep, voffB); PG8_STAGE(PG8_SA(1, 0), cA + kstep, voffA); PG8_STAGE(PG8_SB(1, 1), cB + hstep + kstep, voffB);
        PG8_WAIT_V(6); PG8_BAR;
    } else {
        PG8_STAGE(PG8_SB(0, 0), cB, voffB); PG8_STAGE(PG8_SA(0, 0), cA, voffA); PG8_STAGE(PG8_SB(0, 1), cB + hstep, voffB); PG8_STAGE(PG8_SA(0, 1), cA + hstep, voffA);
        if (wr == 1) PG8_BAR;
        PG8_WAIT_V(4); PG8_BAR;
        PG8_STAGE(PG8_SB(1, 0), cB + kstep, voffB); PG8_STAGE(PG8_SA(1, 0), cA + kstep, voffA); PG8_STAGE(PG8_SB(1, 1), cB + hstep + kstep, voffB);
        PG8_WAIT_V(6); PG8_BAR;
    }
    for (;;) {
        const bool has_next = S.next(ui + 1, nxt);
        const char* nA = has_next ? (const char*)g.A + (size_t)nxt.pm * tstep : cA; const char* nB = has_next ? (const char*)g.Bt + (size_t)nxt.pn * tstep : cB;
        for (int t = 0; t < nt; t += 2) {
            const bool last = (t == nt - 2);
            const char* a1 = cA + (size_t)(t + 1) * kstep;
            const char* a2 = last ? nA : cA + (size_t)(t + 2) * kstep; const char* b2 = last ? nB : cB + (size_t)(t + 2) * kstep;
            const char* a3 = a2 + kstep; const char* b3 = b2 + kstep;
            if (last && has_next) S.a_ready(nxt);
            if constexpr (SP2) {
            PG8_LDB(B0, 0, 0); PG8_LDB(B1, 0, 1); PG8_SCHED; PG8_LDA(At, 0, 0); PG8_STAGE(PG8_SA(1, 1), a1 + hstep, voffA);
            PG8_WAIT_V(8); PG8_WAIT_L(0); PG8_BAR; PG8_MMA(0, 0, At, B0); PG8_MMA(0, 1, At, B1); PG8_BAR; PG8_SCHED;
            PG8_LDA(At, 0, 1); PG8_STAGE(PG8_SB(0, 0), b2, voffB); PG8_STAGE(PG8_SB(0, 1), b2 + hstep, voffB); PG8_STAGE(PG8_SA(0, 0), a2, voffA);
            PG8_WAIT_V(8); PG8_WAIT_L(0); PG8_BAR; PG8_MMA(1, 0, At, B0); PG8_MMA(1, 1, At, B1); PG8_BAR; PG8_SCHED;
            PG8_LDB(B0, 1, 0); PG8_LDB(B1, 1, 1); PG8_SCHED; PG8_LDA(At, 1, 0); PG8_STAGE(PG8_SA(0, 1), a2 + hstep, voffA);
            PG8_WAIT_V(8); PG8_WAIT_L(0); PG8_BAR; PG8_MMA(0, 0, At, B0); PG8_MMA(0, 1, At, B1); PG8_BAR; PG8_SCHED;
            PG8_LDA(At, 1, 1); PG8_STAGE(PG8_SB(1, 0), b3, voffB); PG8_STAGE(PG8_SB(1, 1), b3 + hstep, voffB); PG8_STAGE(PG8_SA(1, 0), a3, voffA);
            PG8_WAIT_V(8); PG8_WAIT_L(0); PG8_BAR; PG8_MMA(1, 0, At, B0); PG8_MMA(1, 1, At, B1); PG8_BAR; PG8_SCHED;
            } else {
            PG8_LDB(B0, 0, 0); PG8_SCHED; PG8_LDA(At, 0, 0); PG8_STAGE(PG8_SA(1, 1), a1 + hstep, voffA);
            PG8_WAIT_L(8); PG8_BAR; PG8_WAIT_L(0); PG8_MMA(0, 0, At, B0); PG8_BAR; PG8_SCHED;
            PG8_LDB(B1, 0, 1); PG8_STAGE(PG8_SB(0, 0), b2, voffB);
            PG8_BAR; PG8_WAIT_L(0); PG8_MMA(0, 1, At, B1); PG8_BAR;
            PG8_LDA(At, 0, 1); PG8_STAGE(PG8_SA(0, 0), a2, voffA);
            PG8_BAR; PG8_WAIT_L(0); PG8_MMA(1, 0, At, B0); PG8_BAR; PG8_SCHED;
            PG8_STAGE(PG8_SB(0, 1), b2 + hstep, voffB);
            PG8_WAIT_V(6); PG8_BAR; PG8_MMA(1, 1, At, B1); PG8_BAR;
            PG8_LDB(B0, 1, 0); PG8_SCHED; PG8_LDA(At, 1, 0); PG8_STAGE(PG8_SA(0, 1), a2 + hstep, voffA);
            PG8_WAIT_L(8); PG8_BAR; PG8_WAIT_L(0); PG8_MMA(0, 0, At, B0); PG8_BAR; PG8_SCHED;
            PG8_LDB(B1, 1, 1); PG8_STAGE(PG8_SB(1, 0), b3, voffB);
            PG8_BAR; PG8_WAIT_L(0); PG8_MMA(0, 1, At, B1); PG8_BAR;
            PG8_LDA(At, 1, 1); PG8_STAGE(PG8_SA(1, 0), a3, voffA);
            PG8_BAR; PG8_WAIT_L(0); PG8_MMA(1, 0, At, B0); PG8_BAR; PG8_SCHED;
            PG8_STAGE(PG8_SB(1, 1), b3 + hstep, voffB);
            PG8_WAIT_V(6); PG8_BAR; PG8_MMA(1, 1, At, B1); PG8_BAR;
            }
        }
        if constexpr (ALIGN_EPI) { if (wr == 0) PG8_BAR; }
        if constexpr (!Epi::AFTER_DRAIN) { E(acc, cur, wr, wc, fr, fq); S.done(cur); }
        { int t2_ = threadIdx.x; asm volatile("" : "+v"(t2_)); tid = t2_; lane = tid & 63; fr = lane & 15; fq = lane >> 4; PG8_LANE_SETUP(); }
        if (!has_next) break;
#pragma unroll
        for (int a = 0; a < 2; ++a)
#pragma unroll
            for (int b = 0; b < 2; ++b)
#pragma unroll
                for (int m = 0; m < 4; ++m)
#pragma unroll
                    for (int n = 0; n < 2; ++n) acc[a][b][m][n] = (f32x4){0.f, 0.f, 0.f, 0.f};
        cur = nxt; cA = nA; cB = nB; ++ui;
        if constexpr (ALIGN_EPI) { if (wr == 1) PG8_BAR; }
    }
    PG8_WAIT_V(0);
    if constexpr (!ALIGN_EPI) { if (wr == 0) PG8_BAR; }
    PG8_BAR;
    if constexpr (Epi::AFTER_DRAIN) { E.fused(acc, cur, wr, wc, fr, fq, lds, wid, lane); S.done(cur); }
#undef PG8_SA
#undef PG8_SB
#undef PG8_STAGE
#undef PG8_LDA
#undef PG8_LDB
#undef PG8_MMA
#undef PG8_WAIT_V
#undef PG8_WAIT_L
#undef PG8_BAR
#undef PG8_SCHED
}
}
constexpr int NWAVES = 8, NTHR = 512;
constexpr int BATCH = 8, SEQ = 4096, DM = 2048, M = BATCH * SEQ;
constexpr int EIN = 5408, EIN_PAD = 5632;
constexpr int LRK = 384, LRN = 3072;
constexpr int CW = 4096, CHD = 512;
constexpr int DFF = 5632, GUN = 2 * DFF;
constexpr int MH = M / 2;
constexpr size_t MiB = 1u << 20;
constexpr size_t WS_CTL = 0, CTL_ZERO_BYTES = 1024 * 1024;
constexpr size_t WS_SS = 256 * 1024;
constexpr size_t WS_SSP = 800 * MiB;
constexpr size_t WS_STATS = 812 * MiB;
constexpr size_t WS_HRAW0 = 249 * MiB + 376 * MiB;
constexpr size_t WS_W_IN_O = 1 * MiB, WS_W_OUT_O = 33 * MiB, WS_W_GU1 = 49 * MiB, WS_W_DN1 = 93 * MiB;
constexpr size_t WS_SMALL = 115 * MiB;
constexpr size_t WS_W_LR = WS_SMALL, WS_W_RG = WS_SMALL + 5 * MiB / 2, WS_GT = WS_SMALL + 3 * MiB, WS_P4 = WS_SMALL + 13 * MiB / 4, WS_GATES = WS_SMALL + 7 * MiB / 2, WS_LRB = WS_SMALL + 11 * MiB / 2;
constexpr size_t WS_H = 121 * MiB;
constexpr size_t WS_BIG = 249 * MiB;
constexpr size_t WS_PROJ = WS_BIG, WS_LRA = WS_BIG + 352 * MiB, WS_LR = WS_BIG + 376 * MiB;
constexpr size_t WS_U = WS_BIG, WS_GTAIL = WS_BIG + 352 * MiB, WS_PREH = WS_BIG + 358 * MiB, WS_UPH = WS_BIG + 364 * MiB;
constexpr size_t WS_XM = WS_BIG, WS_XC = WS_BIG + 256 * MiB, WS_KPP = WS_BIG + 512 * MiB;
constexpr size_t WS_W_IN_E = 928 * MiB, WS_W_OUT_E = 950 * MiB, WS_W_GU0 = 958 * MiB, WS_W_DN0 = 1002 * MiB, WS_END = 1024 * MiB;
static_assert(WS_LR + (size_t)M * LRN * 2 <= WS_W_IN_E && WS_UPH + 6 * MiB <= WS_W_IN_E && WS_KPP + (size_t)M * CW * 2 <= WS_END, "d_ws map");
constexpr int LDS_BYTES = 163840, MISC_OFF = LDS_BYTES - 256, HALO_OFF = 131072;

#define GAS __attribute__((address_space(1)))
#define LAS __attribute__((address_space(3)))
typedef unsigned short bf16;
typedef unsigned v4u __attribute__((ext_vector_type(4)));
typedef float f32x4 __attribute__((ext_vector_type(4)));
typedef short bf16x8 __attribute__((ext_vector_type(8)));
typedef GAS unsigned gu32;
typedef GAS unsigned long long gu64;
#define RLX_AGENT __ATOMIC_RELAXED, __HIP_MEMORY_SCOPE_AGENT
#define LDS_WAIT() asm volatile("s_waitcnt lgkmcnt(0)" ::: "memory")
#define VM_WAIT() asm volatile("s_waitcnt vmcnt(0)" ::: "memory")
__device__ __forceinline__ unsigned long long rt() { return __builtin_amdgcn_s_memrealtime(); }
__device__ __forceinline__ unsigned f2bf(float f) { return pg8::cvt_pk_bf16(f, 0.f) & 0xffffu; }
__device__ __forceinline__ unsigned pk2(float lo, float hi) { return pg8::cvt_pk_bf16(lo, hi); }
#define XB_TMO      128
#define XB_XCNT(j)  (256  + 64 * (j))
#define XB_XSUB(j)  (1280 + 64 * (j))
#define XB_XGEN(j)  (2304 + 64 * (j))
#define XB_TOP      3328
#define XB_TOPGEN   3392
#define XCD_BAR_WORDS 3456
#define XB_SPIN_CAP (1u << 18)

__device__ __forceinline__ unsigned xb_ld(unsigned* p)              { return __hip_atomic_load(p, __ATOMIC_RELAXED, __HIP_MEMORY_SCOPE_AGENT); }
__device__ __forceinline__ unsigned xb_add(unsigned* p, unsigned v) { return __hip_atomic_fetch_add(p, v, __ATOMIC_RELAXED, __HIP_MEMORY_SCOPE_AGENT); }
__device__ __forceinline__ unsigned xb_xcc_id() { return (unsigned)__builtin_amdgcn_s_getreg((3 << 11) | 20) & 0xFu; }
#define XB_SPIN(cond, bar) do { unsigned _sp = 0; while (cond) { __builtin_amdgcn_s_sleep(1); \
    if ((++_sp & 255u) == 0u) { if (xb_ld(&(bar)[XB_TMO])) break; if (_sp > XB_SPIN_CAP) { atomicAdd(&(bar)[XB_TMO], 1u); break; } } } } while (0)

struct XcdBarrier {
    unsigned* bar; unsigned x;
    volatile LAS unsigned* st;
};

__device__ __forceinline__ XcdBarrier xcd_barrier_post(unsigned* bar, volatile LAS unsigned* st) {
    XcdBarrier b; b.bar = bar; b.x = xb_xcc_id(); b.st = st;
    if (threadIdx.x == 0) (void)xb_add(&bar[XB_XCNT(b.x)], 1u);
    return b;
}
__device__ __forceinline__ void xcd_barrier_complete(unsigned* bar, unsigned x, unsigned& nloc, unsigned& nx) {
    const unsigned G = gridDim.x * gridDim.y * gridDim.z;
    unsigned sum, cnt, mine, sp = 0u;
    for (;;) {
        sum = 0u; cnt = 0u; mine = 0u;
#pragma unroll
        for (unsigned j = 0; j < 16; ++j) { const unsigned c = xb_ld(&bar[XB_XCNT(j)]); sum += c; cnt += (c > 0u) ? 1u : 0u; mine = (j == x) ? c : mine; }
        if (sum == G) break;
        __builtin_amdgcn_s_sleep(1);
        if ((++sp & 255u) == 0u) { if (xb_ld(&bar[XB_TMO])) break; if (sp > XB_SPIN_CAP) { atomicAdd(&bar[XB_TMO], 1u); break; } }
    }
    nloc = mine > 0u ? mine : 1u; nx = cnt > 0u ? cnt : 1u;
}

__device__ __forceinline__ void xcd_barrier(const XcdBarrier& b) {
    asm volatile("s_waitcnt vmcnt(0)" ::: "memory");
    __syncthreads();
    if (threadIdx.x == 0) {
        unsigned* bar = b.bar;
        __builtin_amdgcn_s_waitcnt(0);
        unsigned nloc = b.st[0], nx = b.st[1];
        if (nloc == 0u) { xcd_barrier_complete(bar, b.x, nloc, nx); b.st[0] = nloc; b.st[1] = nx; }
        const unsigned old = xb_add(&bar[XB_XSUB(b.x)], 1u);
        const unsigned gen = old / nloc;
        if (old + 1u == (gen + 1u) * nloc) {
            __builtin_amdgcn_fence(__ATOMIC_RELEASE, "agent");
            asm volatile("s_waitcnt vmcnt(0)" ::: "memory");
            const unsigned og = xb_add(&bar[XB_TOP], 1u);
            const unsigned tg = og / nx;
            if (og + 1u == (tg + 1u) * nx) xb_add(&bar[XB_TOPGEN], 1u);
            else XB_SPIN(xb_ld(&bar[XB_TOPGEN]) == tg, bar);
            __builtin_amdgcn_fence(__ATOMIC_ACQUIRE, "agent");
            xb_add(&bar[XB_XGEN(b.x)], 1u);
            asm volatile("s_waitcnt vmcnt(0)" ::: "memory");
        } else {
            XB_SPIN(xb_ld(&bar[XB_XGEN(b.x)]) == gen, bar);
            __builtin_amdgcn_fence(__ATOMIC_ACQUIRE, "agent");
            asm volatile("s_waitcnt vmcnt(0)" ::: "memory");
        }
    }
    __syncthreads();
}

typedef float f32x2 __attribute__((ext_vector_type(2)));
typedef short s16x4 __attribute__((ext_vector_type(4)));
typedef unsigned v2u __attribute__((ext_vector_type(2)));
#define LBAR() do { asm volatile("s_waitcnt lgkmcnt(0)" ::: "memory"); __builtin_amdgcn_s_barrier(); asm volatile("" ::: "memory"); } while (0)
struct Frame {
    LAS unsigned char* lds;
    int tid, lane, wave, G, gw, NGW;
};
template <int CTRL> __device__ __forceinline__ float dpp_x(float x) { return __int_as_float(__builtin_amdgcn_update_dpp(0, __float_as_int(x), CTRL, 0xf, 0xf, true)); }
__device__ __forceinline__ float wave_sum(float v) {
    v += dpp_x<0xB1>(v);
    v += dpp_x<0x4E>(v);
    v += dpp_x<0x141>(v);
    v += dpp_x<0x140>(v);
    v += __shfl_xor(v, 16); v += __shfl_xor(v, 32);
    return v;
}
__device__ __forceinline__ float bflo(unsigned w) { return __uint_as_float(w << 16); }
__device__ __forceinline__ float bfhi(unsigned w) { return __uint_as_float(w & 0xffff0000u); }
__device__ __forceinline__ float bf1(unsigned short b) { return __uint_as_float(((unsigned)b) << 16); }
__device__ __forceinline__ unsigned cvtpk(float lo, float hi) { return pg8::cvt_pk_bf16(lo, hi); }
__device__ __forceinline__ float fsig(float x) { return __builtin_amdgcn_rcpf(1.0f + __expf(-x)); }
__device__ __forceinline__ float fsilu(float x) { return x * fsig(x); }
__device__ __forceinline__ float ftanh(float x) { const float xc = fminf(fmaxf(x, -15.f), 15.f); const float t = __expf(2.f * xc); return (t - 1.f) * __builtin_amdgcn_rcpf(t + 1.f); }
__device__ __forceinline__ float fgelu_tanh(float x) { return 0.5f * x * (1.f + ftanh(0.7978845608f * (x + 0.044715f * x * x * x))); }

__device__ __forceinline__ void p0_transpose_item(const float* W, int K, int N, bf16* WT, int drow, LAS float* scr, int kb, int n0, int lane, const float* gain) {
    const int k0 = 64 * kb;
    float wv_[32];
#pragma unroll
    for (int i = 0; i < 32; ++i) { const int kk = 2 * i + (lane >> 5); wv_[i] = W[(size_t)(k0 + kk) * N + n0 + (lane & 31)]; }
#pragma unroll
    for (int i = 0; i < 32; ++i) { const int kk = 2 * i + (lane >> 5); scr[kk * 33 + (lane & 31)] = wv_[i] * (gain ? gain[k0 + kk] : 1.f); }
    LDS_WAIT(); asm volatile("" ::: "memory");
    const int c = lane & 7;
#pragma unroll
    for (int j = 0; j < 4; ++j) { const int n = (lane >> 3) + 8 * j; const LAS float* s = scr + (8 * c) * 33 + n;
        v4u o; o.x = pk2(s[0 * 33], s[1 * 33]); o.y = pk2(s[2 * 33], s[3 * 33]); o.z = pk2(s[4 * 33], s[5 * 33]); o.w = pk2(s[6 * 33], s[7 * 33]);
        *(GAS v4u*)(WT + (size_t)(drow + n) * K + k0 + 8 * c) = o; }
    LDS_WAIT(); asm volatile("" ::: "memory");
}
__device__ __forceinline__ void p0_matrix(Frame& F, const float* W, int K, int N, bf16* WT, int mode, LAS float* scr, const float* gain = nullptr) {
    const int nblk = N / 32, items = (K / 64) * nblk;
    for (int it = F.gw; it < items; it += F.NGW) {
        const int kb = it / nblk, n0 = 32 * (it % nblk);
        const int drow = mode == 0 ? n0 : (256 * (n0 >> 7) + (n0 & 127) + (mode == 2 ? 128 : 0));
        p0_transpose_item(W, K, N, WT, drow, scr, kb, n0, F.lane, gain);
    }
}
struct Ptrs {
    const float* in[41]; float* out; unsigned char* ws;
};
#define IN_X 0
#define IN_EVEN_NORM 1
#define IN_EVEN_W_IN 2
#define IN_A_CONV_W 3
#define IN_A_CONV_B 4
#define IN_A_W_R 5
#define IN_A_B_R 6
#define IN_A_W_I 7
#define IN_A_B_I 8
#define IN_A_LAMBDA 9
#define IN_B_MU 10
#define IN_B_W0 11
#define IN_B_W_UP 12
#define IN_B_A0 13
#define IN_B_A_UP 14
#define IN_B_G_UP 15
#define IN_B_K_K 16
#define IN_B_K_A 17
#define IN_B_R_K 18
#define IN_B_LN_W 19
#define IN_B_LN_B 20
#define IN_EVEN_W_OUT 21
#define IN_ODD_NORM 22
#define IN_ODD_W_IN 23
#define IN_C_CONV_W 24
#define IN_C_CONV_B 25
#define IN_C_W_Q 26
#define IN_C_W_K 27
#define IN_C_W_V 28
#define IN_C_W_IF 29
#define IN_C_B_IF 30
#define IN_C_LN_W 31
#define IN_C_SKIP 32
#define IN_ODD_W_OUT 33
#define IN_FFN_NORM 34
#define IN_FFN_W_GATE 35
#define IN_FFN_W_UP 36
#define IN_FFN_CONV_W 37
#define IN_FFN_CONV_B 38
#define IN_FFN_W_DOWN 39
#define IN_FINAL_NORM 40

__device__ __forceinline__ void ph_prologue(Frame& F, const Ptrs& P) {
    LAS float* scr = (LAS float*)(F.lds + F.wave * 16384);
    unsigned char* ws = P.ws;
    p0_matrix(F, P.in[IN_EVEN_W_IN], DM, EIN, (bf16*)(ws + WS_W_IN_E), 0, scr);
    p0_matrix(F, P.in[IN_EVEN_W_OUT], DM, DM, (bf16*)(ws + WS_W_OUT_E), 0, scr);
    const size_t gt = (size_t)F.gw * 64 + F.lane, GT = (size_t)F.NGW * 64;
    { v4u* z = (v4u*)(ws + WS_W_IN_E + (size_t)EIN * DM * 2); const size_t n = (size_t)(EIN_PAD - EIN) * DM * 2 / 16; for (size_t i = gt; i < n; i += GT) z[i] = (v4u){0u, 0u, 0u, 0u}; }
    { bf16* B = (bf16*)(ws + WS_W_LR); const float* wup = P.in[IN_B_W_UP]; const float* aup = P.in[IN_B_A_UP]; const float* gup = P.in[IN_B_G_UP];
      for (size_t i = gt; i < (size_t)LRN * LRK; i += GT) { const int n = (int)(i / LRK), k = (int)(i % LRK); float v = 0.f;
          if (n < 1024) { if (k < 64) v = wup[(size_t)k * 1024 + n]; }
          else if (n < 2048) { if (k >= 64 && k < 128) v = aup[(size_t)(k - 64) * 1024 + (n - 1024)]; }
          else { if (k >= 128 && k < 288) v = gup[(size_t)(k - 128) * 1024 + (n - 2048)]; }
          B[i] = (bf16)f2bf(v); } }
    { float* lb = (float*)(ws + WS_LRB); for (size_t i = gt; i < (size_t)LRN; i += GT) lb[i] = i < 1024 ? P.in[IN_B_W0][i] : (i < 2048 ? P.in[IN_B_A0][i - 1024] : 0.f); }
    { bf16* B = (bf16*)(ws + WS_W_RG); const float* wr = P.in[IN_A_W_R]; const float* wi = P.in[IN_A_W_I];
      for (size_t i = gt; i < (size_t)2 * 8 * 128 * 128; i += GT) { const int which = (int)(i >> 17), g = (int)((i >> 14) & 7), n = (int)((i >> 7) & 127), k = (int)(i & 127);
          const float* w = which ? wi : wr; B[i] = (bf16)f2bf(w[((size_t)g * 128 + k) * 128 + n]); } }
    { float* P4 = (float*)(ws + WS_P4); const float* wq = P.in[IN_C_W_Q]; const float* wk = P.in[IN_C_W_K];
      for (size_t i = gt; i < (size_t)1024 * 16; i += GT) { const int j = (int)(i >> 4), b = (int)((i >> 2) & 3), ii = (int)(i & 3); float s = 0.f;
#pragma unroll
          for (int a = 0; a < 4; ++a) s += wk[j * 16 + b * 4 + a] * wq[j * 16 + ii * 4 + a];
          P4[i] = s * 0.04419417382f; } }
    { bf16* Gt = (bf16*)(ws + WS_GT); const float* wq = P.in[IN_C_W_Q]; const float* wk = P.in[IN_C_W_K]; const float* wv = P.in[IN_C_W_V]; const float* wif = P.in[IN_C_W_IF];
      for (size_t i = gt; i < (size_t)16 * 8192; i += GT) { const int g = (int)(i >> 13), kidx = (int)(i & 8191), c = kidx & 4095, j = c >> 2, ii = c & 3; float s = 0.f;
          if (kidx < 4096) {
#pragma unroll
              for (int a = 0; a < 4; ++a) s += wq[j * 16 + ii * 4 + a] * wif[((size_t)0 * CW + 4 * j + a) * 16 + g] + wk[j * 16 + ii * 4 + a] * wif[((size_t)1 * CW + 4 * j + a) * 16 + g];
          } else {
#pragma unroll
              for (int a = 0; a < 4; ++a) s += wv[j * 16 + ii * 4 + a] * wif[((size_t)2 * CW + 4 * j + a) * 16 + g];
          }
          Gt[i] = (bf16)f2bf(s); } }
}
__device__ __forceinline__ void ph_late_weights(Frame& F, const Ptrs& P) {
    LAS float* scr = (LAS float*)(F.lds + F.wave * 16384);
    unsigned char* ws = P.ws;
    p0_matrix(F, P.in[IN_FFN_W_GATE], DM, DFF, (bf16*)(ws + WS_W_GU0), 1, scr, P.in[IN_FFN_NORM]);
    p0_matrix(F, P.in[IN_FFN_W_UP], DM, DFF, (bf16*)(ws + WS_W_GU0), 2, scr, P.in[IN_FFN_NORM]);
    p0_matrix(F, P.in[IN_FFN_W_DOWN], DFF, DM, (bf16*)(ws + WS_W_DN0), 0, scr);
    p0_matrix(F, P.in[IN_FFN_W_GATE] + (size_t)DM * DFF, DM, DFF, (bf16*)(ws + WS_W_GU1), 1, scr, P.in[IN_FFN_NORM] + DM);
    p0_matrix(F, P.in[IN_FFN_W_UP] + (size_t)DM * DFF, DM, DFF, (bf16*)(ws + WS_W_GU1), 2, scr, P.in[IN_FFN_NORM] + DM);
    p0_matrix(F, P.in[IN_FFN_W_DOWN] + (size_t)DFF * DM, DFF, DM, (bf16*)(ws + WS_W_DN1), 0, scr);
    p0_matrix(F, P.in[IN_ODD_W_IN], DM, 2 * CW, (bf16*)(ws + WS_W_IN_O), 0, scr, P.in[IN_ODD_NORM]);
    p0_matrix(F, P.in[IN_ODD_W_OUT], CW, DM, (bf16*)(ws + WS_W_OUT_O), 0, scr);
}
__device__ __forceinline__ void ph_rmsnorm_bf16(Frame& F, const float* src, const float* gain, bf16* dst) {
    f32x4 g[8];
#pragma unroll
    for (int j = 0; j < 8; ++j) g[j] = ((const GAS f32x4*)gain)[F.lane + 64 * j];
    int m = F.gw; f32x4 v[8];
    if (m < M) { const GAS f32x4* xr = (const GAS f32x4*)(src + (size_t)m * DM) + F.lane;
#pragma unroll
        for (int j = 0; j < 8; ++j) v[j] = xr[64 * j]; }
    for (; m < M; m += F.NGW) {
        f32x4 vn[8]; const int mn = m + F.NGW;
        if (mn < M) { const GAS f32x4* xn = (const GAS f32x4*)(src + (size_t)mn * DM) + F.lane;
#pragma unroll
            for (int j = 0; j < 8; ++j) vn[j] = xn[64 * j]; }
        float s = 0.f;
#pragma unroll
        for (int j = 0; j < 8; ++j) s += (v[j].x * v[j].x + v[j].y * v[j].y) + (v[j].z * v[j].z + v[j].w * v[j].w);
        const float rstd = rsqrtf(wave_sum(s) * (1.f / DM) + 1e-6f);
        GAS v2u* o8 = (GAS v2u*)(dst + (size_t)m * DM) + F.lane;
#pragma unroll
        for (int j = 0; j < 8; ++j) { v2u o; o.x = cvtpk(v[j].x * rstd * g[j].x, v[j].y * rstd * g[j].y); o.y = cvtpk(v[j].z * rstd * g[j].z, v[j].w * rstd * g[j].w); o8[64 * j] = o; }
        if (mn < M) {
#pragma unroll
            for (int j = 0; j < 8; ++j) v[j] = vn[j]; }
    }
}
__device__ __forceinline__ void ph_rmsnorm_f32_inplace(Frame& F, float* x, const float* gain) {
    for (int m = F.gw; m < M; m += F.NGW) {
        GAS f32x4* xr = (GAS f32x4*)(x + (size_t)m * DM) + F.lane;
        f32x4 v[8]; float s = 0.f;
#pragma unroll
        for (int j = 0; j < 8; ++j) { v[j] = xr[64 * j]; s += (v[j].x * v[j].x + v[j].y * v[j].y) + (v[j].z * v[j].z + v[j].w * v[j].w); }
        const float rstd = rsqrtf(wave_sum(s) * (1.f / DM) + 1e-6f);
#pragma unroll
        for (int j = 0; j < 8; ++j) { const f32x4 g = ((const GAS f32x4*)gain)[F.lane + 64 * j]; xr[64 * j] = v[j] * rstd * g; }
    }
}
__device__ __forceinline__ void ph_rmsnorm_final(Frame& F, const bf16* x, const float* gain, float* out) {
    f32x4 g0[4], g1[4];
#pragma unroll
    for (int j = 0; j < 4; ++j) { g0[j] = ((const GAS f32x4*)gain)[2 * F.lane + 128 * j]; g1[j] = ((const GAS f32x4*)gain)[2 * F.lane + 128 * j + 1]; }
    int m = F.gw; v4u v[4];
    if (m < M) { const GAS v4u* xr = (const GAS v4u*)(x + (size_t)m * DM) + F.lane;
#pragma unroll
        for (int j = 0; j < 4; ++j) v[j] = xr[64 * j]; }
    for (; m < M; m += F.NGW) {
        v4u vn[4]; const int mn = m + F.NGW;
        if (mn < M) { const GAS v4u* xn = (const GAS v4u*)(x + (size_t)mn * DM) + F.lane;
#pragma unroll
            for (int j = 0; j < 4; ++j) vn[j] = xn[64 * j]; }
        float s = 0.f;
#pragma unroll
        for (int j = 0; j < 4; ++j)
            s += ((bflo(v[j].x) * bflo(v[j].x) + bfhi(v[j].x) * bfhi(v[j].x)) + (bflo(v[j].y) * bflo(v[j].y) + bfhi(v[j].y) * bfhi(v[j].y))) + ((bflo(v[j].z) * bflo(v[j].z) + bfhi(v[j].z) * bfhi(v[j].z)) + (bflo(v[j].w) * bflo(v[j].w) + bfhi(v[j].w) * bfhi(v[j].w)));
        const float rstd = rsqrtf(wave_sum(s) * (1.f / DM) + 1e-6f);
        GAS f32x4* o = (GAS f32x4*)(out + (size_t)m * DM) + 2 * F.lane;
#pragma unroll
        for (int j = 0; j < 4; ++j) {
            o[128 * j] = (f32x4){bflo(v[j].x) * rstd * g0[j].x, bfhi(v[j].x) * rstd * g0[j].y, bflo(v[j].y) * rstd * g0[j].z, bfhi(v[j].y) * rstd * g0[j].w};
            o[128 * j + 1] = (f32x4){bflo(v[j].z) * rstd * g1[j].x, bfhi(v[j].z) * rstd * g1[j].y, bflo(v[j].w) * rstd * g1[j].z, bfhi(v[j].w) * rstd * g1[j].w}; }
        if (mn < M) {
#pragma unroll
            for (int j = 0; j < 4; ++j) v[j] = vn[j]; }
    }
}
__device__ __forceinline__ void ph_ss_reduce(Frame& F, const float* ssp, float* ss) {
    for (int m = F.gw * 64 + F.lane; m < M; m += F.NGW * 64) { const GAS f32x4* p = (const GAS f32x4*)(ssp + (size_t)m * 32); float s = 0.f;
#pragma unroll
        for (int i = 0; i < 8; ++i) { const f32x4 v = p[i]; s += (v.x + v.y) + (v.z + v.w); }
        ss[m] = s; }
}
__device__ __forceinline__ void ph_lra(Frame& F, const Ptrs& P) {
    const bf16* proj = (const bf16*)(P.ws + WS_PROJ); bf16* lra = (bf16*)(P.ws + WS_LRA); const float* mu = P.in[IN_B_MU];
    const size_t gt = (size_t)F.gw * 64 + F.lane, GT = (size_t)F.NGW * 64;
    for (size_t i = gt; i < (size_t)M * 48; i += GT) {
        const int m = (int)(i / 48), g8 = (int)(i % 48), c0 = 8 * g8; v4u o = (v4u){0u, 0u, 0u, 0u};
        if (c0 < 288) {
            const v4u cur = *(const GAS v4u*)(proj + (size_t)m * EIN_PAD + 5120 + c0);
            v4u prv = (v4u){0u, 0u, 0u, 0u}; if ((m & (SEQ - 1)) != 0) prv = *(const GAS v4u*)(proj + (size_t)(m - 1) * EIN_PAD + 5120 + c0);
            const f32x4 mu0 = *(const GAS f32x4*)(mu + 3072 + c0), mu1 = *(const GAS f32x4*)(mu + 3072 + c0 + 4);
            float v[8];
#pragma unroll
            for (int j = 0; j < 4; ++j) { const float c_lo = bflo(cur[j]), c_hi = bfhi(cur[j]), p_lo = bflo(prv[j]), p_hi = bfhi(prv[j]);
                const float m_lo = (2 * j < 4) ? mu0[2 * j] : mu1[2 * j - 4], m_hi = (2 * j + 1 < 4) ? mu0[2 * j + 1] : mu1[2 * j + 1 - 4];
                v[2 * j] = c_lo + (p_lo - c_lo) * m_lo; v[2 * j + 1] = c_hi + (p_hi - c_hi) * m_hi; }
#pragma unroll
            for (int j = 0; j < 8; ++j) v[j] = c0 < 64 ? ftanh(v[j]) : (c0 < 128 ? v[j] : fsig(v[j]));
            o.x = cvtpk(v[0], v[1]); o.y = cvtpk(v[2], v[3]); o.z = cvtpk(v[4], v[5]); o.w = cvtpk(v[6], v[7]);
        }
        *(GAS v4u*)(lra + (size_t)m * LRK + c0) = o;
    }
}
__device__ __forceinline__ void ph_ffn_fix(Frame& F, bf16* U, const float* cw, const float* gtail, const float* preh, const float* uph) {
    const size_t gt = (size_t)F.gw * 64 + F.lane, GT = (size_t)F.NGW * 64;
    constexpr int C4 = DFF / 4;
    for (size_t i = gt; i < (size_t)(M / 256) * 2 * C4; i += GT) {
        const int pm = (int)(i / (2 * C4)), fr = (int)((i / C4) & 1), c = 4 * (int)(i % C4);
        if ((pm & 15) == 0) continue;
        const f32x4 pre0 = *(const GAS f32x4*)(preh + ((size_t)pm * 2 + fr) * DFF + c), up = *(const GAS f32x4*)(uph + ((size_t)pm * 2 + fr) * DFF + c);
        const f32x4 ga = *(const GAS f32x4*)(gtail + ((size_t)(pm - 1) * 2 + 0) * DFF + c), gb = *(const GAS f32x4*)(gtail + ((size_t)(pm - 1) * 2 + 1) * DFF + c);
        const f32x4 w0 = *(const GAS f32x4*)(cw + c), w1 = *(const GAS f32x4*)(cw + DFF + c);
        const f32x4 pre = fr == 0 ? (pre0 + w0 * ga + w1 * gb) : (pre0 + w0 * gb);
        v2u o; o.x = cvtpk(fsilu(pre.x) * up.x, fsilu(pre.y) * up.y); o.y = cvtpk(fsilu(pre.z) * up.z, fsilu(pre.w) * up.w);
        *(GAS v2u*)(U + (size_t)(pm * 256 + fr) * DFF + c) = o;
    }
}

constexpr int RW_R = 0, RW_W = 16384, RW_K = 32768, RW_A = 49152, RW_B = 65536, RW_V = 81920, RW_Y = 98304, RW_BONUS = 114688;
__device__ __forceinline__ void rwkv_unit(Frame& F, const Ptrs& P, int unit) {
    const int b = unit >> 4, h = unit & 15, col = h * 64 + F.lane;
    const bf16* proj = (const bf16*)(P.ws + WS_PROJ); const bf16* lr = (const bf16*)(P.ws + WS_LR); bf16* ycat = (bf16*)(P.ws + WS_H);
    const float* mu = P.in[IN_B_MU];
    const float mu_r = mu[col], mu_k = mu[1024 + col], mu_v = mu[2048 + col];
    const float k_k = P.in[IN_B_K_K][col], k_a = P.in[IN_B_K_A][col], r_k = P.in[IN_B_R_K][col], ln_w = P.in[IN_B_LN_W][col], ln_b = P.in[IN_B_LN_B][col];
    LAS float* Rb = (LAS float*)(F.lds + RW_R); LAS float* Wb = (LAS float*)(F.lds + RW_W); LAS float* Kb = (LAS float*)(F.lds + RW_K);
    LAS float* Ab = (LAS float*)(F.lds + RW_A); LAS float* Bb = (LAS float*)(F.lds + RW_B); LAS float* Vb = (LAS float*)(F.lds + RW_V);
    LAS float* Yb = (LAS float*)(F.lds + RW_Y); LAS float* Bon = (LAS float*)(F.lds + RW_BONUS);
    float s[64];
#pragma unroll
    for (int k = 0; k < 64; ++k) s[k] = 0.f;
    for (int ch = 0; ch < SEQ / 64; ++ch) {
        const int t0 = ch * 64;
#pragma unroll 2
        for (int i = 0; i < 8; ++i) {
            const int tt = F.wave * 8 + i, t = t0 + tt; const size_t m = (size_t)b * SEQ + t;
            const bf16* pr = proj + m * EIN_PAD + 2048 + col;
            float r = bf1(pr[0]), k = bf1(pr[1024]), v = bf1(pr[2048]);
            float rp = 0.f, kp = 0.f, vp = 0.f;
            if (t > 0) { rp = bf1(pr[-EIN_PAD]); kp = bf1(pr[1024 - EIN_PAD]); vp = bf1(pr[2048 - EIN_PAD]); }
            r += (rp - r) * mu_r; k += (kp - k) * mu_k; v += (vp - v) * mu_v;
            const float lw = -0.60653066f * fsig(bf1(lr[m * LRN + col])), a = fsig(bf1(lr[m * LRN + 1024 + col]));
            float kk = k * k_k; const float ss = wave_sum(kk * kk); kk *= rsqrtf(fmaxf(ss, 1e-12f));
            const float kq = k * (1.f + (a - 1.f) * k_a);
            Rb[tt * 64 + F.lane] = r; Wb[tt * 64 + F.lane] = __expf(lw); Kb[tt * 64 + F.lane] = kq; Ab[tt * 64 + F.lane] = -kk; Bb[tt * 64 + F.lane] = kk * a; Vb[tt * 64 + F.lane] = v;
            const float bo = wave_sum(r * kq * r_k); if (F.lane == 0) Bon[tt] = bo;
        }
        __syncthreads();
        if (F.wave == 0) {
            for (int tt = 0; tt < 64; ++tt) {
                const LAS f32x4* A4 = (const LAS f32x4*)(Ab + tt * 64); const LAS f32x4* W4 = (const LAS f32x4*)(Wb + tt * 64); const LAS f32x4* B4 = (const LAS f32x4*)(Bb + tt * 64);
                const LAS f32x4* K4 = (const LAS f32x4*)(Kb + tt * 64); const LAS f32x4* R4 = (const LAS f32x4*)(Rb + tt * 64);
                float sa0 = 0.f, sa1 = 0.f, sa2 = 0.f, sa3 = 0.f;
#pragma unroll
                for (int q = 0; q < 16; ++q) { const f32x4 a = A4[q]; sa0 += s[4 * q] * a.x; sa1 += s[4 * q + 1] * a.y; sa2 += s[4 * q + 2] * a.z; sa3 += s[4 * q + 3] * a.w; }
                const float sa = (sa0 + sa1) + (sa2 + sa3), vv = Vb[tt * 64 + F.lane];
                float y0 = 0.f, y1 = 0.f, y2 = 0.f, y3 = 0.f;
#pragma unroll
                for (int q = 0; q < 16; ++q) { const f32x4 w = W4[q], bb = B4[q], kk = K4[q], rr = R4[q];
                    s[4 * q] = s[4 * q] * w.x + sa * bb.x + vv * kk.x; s[4 * q + 1] = s[4 * q + 1] * w.y + sa * bb.y + vv * kk.y;
                    s[4 * q + 2] = s[4 * q + 2] * w.z + sa * bb.z + vv * kk.z; s[4 * q + 3] = s[4 * q + 3] * w.w + sa * bb.w + vv * kk.w;
                    y0 += s[4 * q] * rr.x; y1 += s[4 * q + 1] * rr.y; y2 += s[4 * q + 2] * rr.z; y3 += s[4 * q + 3] * rr.w; }
                Yb[tt * 64 + F.lane] = (y0 + y1) + (y2 + y3);
            }
        }
        __syncthreads();
#pragma unroll 2
        for (int i = 0; i < 8; ++i) {
            const int tt = F.wave * 8 + i; const size_t m = (size_t)b * SEQ + t0 + tt;
            const float y = Yb[tt * 64 + F.lane]; const float mean = wave_sum(y) * (1.f / 64.f); const float d = y - mean; const float var = wave_sum(d * d) * (1.f / 64.f);
            float o = d * rsqrtf(var + 64e-5f) * ln_w + ln_b; o += Bon[tt] * Vb[tt * 64 + F.lane];
            o *= bf1(lr[m * LRN + 2048 + col]);
            ycat[m * DM + 1024 + col] = (bf16)f2bf(o);
        }
        __syncthreads();
    }
}
constexpr int RG_XCB = 0, RG_XCF = 20480, RG_A = 53248, RG_U = 86016;
#ifndef RG_PK
#define RG_PK 1
#endif
__device__ __forceinline__ void rglru_unit(Frame& F, const Ptrs& P, int unit) {
    const int b = unit >> 3, blk = unit & 7, cb0 = blk * 128;
    const bf16* proj = (const bf16*)(P.ws + WS_PROJ); bf16* ycat = (bf16*)(P.ws + WS_H);
    const float* cw = P.in[IN_A_CONV_W]; const float* cbias = P.in[IN_A_CONV_B];
    LAS bf16* XCB = (LAS bf16*)(F.lds + RG_XCB); LAS float* XCF = (LAS float*)(F.lds + RG_XCF); LAS float* AB = (LAS float*)(F.lds + RG_A); LAS float* UB = (LAS float*)(F.lds + RG_U);
    const bf16* wrg = (const bf16*)(P.ws + WS_W_RG);
    pg8::bf16x8 Br[4], Bi[4];
    float b_r, b_i, sp8;
    { const int r16 = F.lane & 15, g4 = F.lane >> 4;
#pragma unroll
    for (int ks = 0; ks < 4; ++ks) { const size_t o = ((size_t)blk * 128 + 16 * F.wave + r16) * 128 + 32 * ks + 8 * g4;
        Br[ks] = *(const pg8::bf16x8*)(wrg + o); Bi[ks] = *(const pg8::bf16x8*)(wrg + (size_t)8 * 128 * 128 + o); }
    const int cn = cb0 + 16 * F.wave + r16;
    b_r = P.in[IN_A_B_R][cn]; b_i = P.in[IN_A_B_I][cn];
    const float lam = P.in[IN_A_LAMBDA][cn]; sp8 = 8.f * log1pf(expf(-lam)); }
    float hcar = 0.f;
    v4u xr[4][2], gar[2];
    { int t0_ = F.tid; asm volatile("" : "+v"(t0_)); const int ct = (t0_ & 7) * 16, tr = t0_ >> 3; const size_t m = (size_t)b * SEQ + tr;
#pragma unroll
      for (int jj = 0; jj < 4; ++jj) { xr[jj][0] = (v4u){0u, 0u, 0u, 0u}; xr[jj][1] = xr[jj][0];
          if (tr - 3 + jj >= 0) { xr[jj][0] = *(const GAS v4u*)(proj + (m - 3 + jj) * EIN_PAD + cb0 + ct); xr[jj][1] = *(const GAS v4u*)(proj + (m - 3 + jj) * EIN_PAD + cb0 + ct + 8); } }
      gar[0] = *(const GAS v4u*)(proj + m * EIN_PAD + 1024 + cb0 + ct); gar[1] = *(const GAS v4u*)(proj + m * EIN_PAD + 1024 + cb0 + ct + 8); }
#if RG_PK
    f32x2 cw2[4][8];
    { int tq_ = F.tid; asm volatile("" : "+v"(tq_)); const int ct0 = (tq_ & 7) * 16;
#pragma unroll
      for (int jj = 0; jj < 4; ++jj)
#pragma unroll
          for (int j = 0; j < 8; ++j) cw2[jj][j] = *(const GAS f32x2*)(cw + jj * 1024 + cb0 + ct0 + 2 * j); }
#endif
    for (int ch = 0; ch < SEQ / 64; ++ch) {
        const int t0 = ch * 64;
        int tid_ = F.tid; asm volatile("" : "+v"(tid_));
        const int ct = (tid_ & 7) * 16, tr = tid_ >> 3;
        const int r16 = tid_ & 15, g4 = (tid_ >> 4) & 3;
        {
            const int t = t0 + tr; const size_t m = (size_t)b * SEQ + t;
            float acc[16];
#if RG_PK
            { f32x2 a2[8], cb2[8];
#pragma unroll
              for (int j = 0; j < 8; ++j) { cb2[j] = *(const GAS f32x2*)(cbias + cb0 + ct + 2 * j); a2[j] = (f32x2){0.f, 0.f}; }
#pragma unroll
              for (int jj = 0; jj < 4; ++jj) { const v4u x0 = xr[jj][0], x1 = xr[jj][1];
#pragma unroll
                  for (int j = 0; j < 4; ++j) { a2[j] = cw2[jj][j] * (f32x2){bflo(x0[j]), bfhi(x0[j])} + a2[j]; a2[4 + j] = cw2[jj][4 + j] * (f32x2){bflo(x1[j]), bfhi(x1[j])} + a2[4 + j]; } }
#pragma unroll
              for (int j = 0; j < 8; ++j) { a2[j] = a2[j] + cb2[j]; acc[2 * j] = a2[j].x; acc[2 * j + 1] = a2[j].y; } }
#else
#pragma unroll
            for (int j = 0; j < 16; ++j) acc[j] = cbias[cb0 + ct + j];
#pragma unroll
            for (int jj = 0; jj < 4; ++jj) { {
                const v4u x0 = xr[jj][0], x1 = xr[jj][1];
                const float* w = cw + jj * 1024 + cb0 + ct;
#pragma unroll
                for (int j = 0; j < 4; ++j) { acc[2 * j] += w[2 * j] * bflo(x0[j]); acc[2 * j + 1] += w[2 * j + 1] * bfhi(x0[j]); acc[8 + 2 * j] += w[8 + 2 * j] * bflo(x1[j]); acc[8 + 2 * j + 1] += w[8 + 2 * j + 1] * bfhi(x1[j]); } } }
#endif
#pragma unroll
            for (int j = 0; j < 16; ++j) XCF[tr * 128 + ct + j] = acc[j];
            v4u p0, p1; p0.x = cvtpk(acc[0], acc[1]); p0.y = cvtpk(acc[2], acc[3]); p0.z = cvtpk(acc[4], acc[5]); p0.w = cvtpk(acc[6], acc[7]);
            p1.x = cvtpk(acc[8], acc[9]); p1.y = cvtpk(acc[10], acc[11]); p1.z = cvtpk(acc[12], acc[13]); p1.w = cvtpk(acc[14], acc[15]);
            *(LAS v4u*)(XCB + tr * 136 + ct) = p0; *(LAS v4u*)(XCB + tr * 136 + ct + 8) = p1;
            if (ch + 1 < SEQ / 64) { const size_t mn = m + 64;
#pragma unroll
                for (int jj = 0; jj < 4; ++jj) { xr[jj][0] = *(const GAS v4u*)(proj + (mn - 3 + jj) * EIN_PAD + cb0 + ct); xr[jj][1] = *(const GAS v4u*)(proj + (mn - 3 + jj) * EIN_PAD + cb0 + ct + 8); }
            }
        }
        LBAR();
        {
#pragma unroll
            for (int mt = 0; mt < 4; ++mt) {
                pg8::f32x4 ar = {0.f, 0.f, 0.f, 0.f}, ai = {0.f, 0.f, 0.f, 0.f};
#pragma unroll
                for (int ks = 0; ks < 4; ++ks) { const pg8::bf16x8 a = *(const LAS pg8::bf16x8*)(XCB + (16 * mt + r16) * 136 + 32 * ks + 8 * g4);
                    ar = __builtin_amdgcn_mfma_f32_16x16x32_bf16(a, Br[ks], ar, 0, 0, 0); ai = __builtin_amdgcn_mfma_f32_16x16x32_bf16(a, Bi[ks], ai, 0, 0, 0); }
#pragma unroll
                for (int rg = 0; rg < 4; ++rg) { const int tt = 16 * mt + 4 * g4 + rg, cl = 16 * F.wave + r16;
                    const float rr = fsig(ar[rg] + b_r), ii = fsig(ai[rg] + b_i); const float la = -sp8 * rr; const float a = __expf(la);
                    const float mult = __builtin_amdgcn_sqrtf(fmaxf(1.f - a * a, 0.f));
                    AB[tt * 128 + cl] = a; UB[tt * 128 + cl] = mult * ii * XCF[tt * 128 + cl]; }
            }
        }
        LBAR();
        if (tid_ < 128) {
#pragma unroll 8
            for (int tt = 0; tt < 64; ++tt) { hcar = AB[tt * 128 + tid_] * hcar + UB[tt * 128 + tid_]; UB[tt * 128 + tid_] = hcar; }
        }
        LBAR();
        {
            const size_t m = (size_t)b * SEQ + t0 + tr;
            const v4u g0 = gar[0], g1 = gar[1];
            float o[16];
#pragma unroll
            for (int j = 0; j < 4; ++j) { o[2 * j] = bflo(g0[j]); o[2 * j + 1] = bfhi(g0[j]); o[8 + 2 * j] = bflo(g1[j]); o[8 + 2 * j + 1] = bfhi(g1[j]); }
#if RG_PK
#pragma unroll
            for (int j = 0; j < 8; ++j) { const f32x2 x = {o[2 * j], o[2 * j + 1]}, h2 = *(const LAS f32x2*)(UB + tr * 128 + ct + 2 * j);
                const f32x2 x2 = x * x, u = x * (x2 * (f32x2){0.0356774081f, 0.0356774081f} + (f32x2){0.7978845608f, 0.7978845608f});
                const f32x2 ea = u * (f32x2){-2.885390082f, -2.885390082f};
                const f32x2 den = (f32x2){__builtin_amdgcn_exp2f(fminf(ea.x, 60.f)), __builtin_amdgcn_exp2f(fminf(ea.y, 60.f))} + (f32x2){1.f, 1.f};
                const f32x2 r2 = x * (f32x2){__builtin_amdgcn_rcpf(den.x), __builtin_amdgcn_rcpf(den.y)} * h2;
                o[2 * j] = r2.x; o[2 * j + 1] = r2.y; }
#else
#pragma unroll
            for (int j = 0; j < 16; ++j) o[j] = UB[tr * 128 + ct + j] * fgelu_tanh(o[j]);
#endif
            v4u p0, p1; p0.x = cvtpk(o[0], o[1]); p0.y = cvtpk(o[2], o[3]); p0.z = cvtpk(o[4], o[5]); p0.w = cvtpk(o[6], o[7]);
            p1.x = cvtpk(o[8], o[9]); p1.y = cvtpk(o[10], o[11]); p1.z = cvtpk(o[12], o[13]); p1.w = cvtpk(o[14], o[15]);
            *(GAS v4u*)(ycat + m * DM + cb0 + ct) = p0; *(GAS v4u*)(ycat + m * DM + cb0 + ct + 8) = p1;
            if (ch + 1 < SEQ / 64) { gar[0] = *(const GAS v4u*)(proj + (m + 64) * EIN_PAD + 1024 + cb0 + ct); gar[1] = *(const GAS v4u*)(proj + (m + 64) * EIN_PAD + 1024 + cb0 + ct + 8); }
        }
    }
}

typedef short bf16x4 __attribute__((ext_vector_type(4)));
#define MFMA16(a, b, c) __builtin_amdgcn_mfma_f32_16x16x16bf16_1k((a), (b), (c), 0, 0, 0)
constexpr int R2_PC = 15360, R2_BT = 0, R2_KT = 2560, R2_VT = 5120, R2_RR = 7680, R2_WR = 9984, R2_TA = 12288, R2_MB = 13056, R2_MK = 13824, R2_GL = 14592;
constexpr int R2_YB = 61440, R2_YE = 6400, R2_YVF = 4096, R2_YBO = 6144;
constexpr int R2_SC = R2_YB + 8 * R2_YE, R2_SCB = 9728, R2_TAB = R2_SC + 4 * 9728;
static_assert(R2_SC + 4 * R2_SCB <= MISC_OFF, "RWKV LDS map");
__device__ __forceinline__ float bperm0(int srclane, float x) { return __int_as_float(__builtin_amdgcn_ds_bpermute(srclane << 2, __float_as_int(x))); }
__device__ __forceinline__ bf16x4 pack4(const pg8::f32x4 v) { v2u p; p.x = cvtpk(v[0], v[1]); p.y = cvtpk(v[2], v[3]); return __builtin_bit_cast(bf16x4, p); }
template <int CTRL> __device__ __forceinline__ float dppf(float x) { return __int_as_float(__builtin_amdgcn_update_dpp(0, __float_as_int(x), CTRL, 0xf, 0xf, true)); }
__device__ __forceinline__ float scan16(float x) { x += dppf<0x111>(x); x += dppf<0x112>(x); x += dppf<0x114>(x); x += dppf<0x118>(x); return x; }
__device__ __forceinline__ float xrow_sum(float x, int lid) { x += bperm0(lid ^ 16, x); x += bperm0(lid ^ 32, x); return x; }
__device__ __forceinline__ void rwkv_post(int lane, const Ptrs& P, int b, int h, int tstart, LAS unsigned char* ye, const LAS float* RW_TABP) {
    const bf16* lr = (const bf16*)(P.ws + WS_LR); bf16* ycat = (bf16*)(P.ws + WS_H);
    const LAS float* Y = (const LAS float*)ye; const LAS bf16* VF = (const LAS bf16*)(ye + R2_YVF); const LAS float* BO = (const LAS float*)(ye + R2_YBO);
    const int t = lane & 15, g = lane >> 4; const size_t m = (size_t)b * SEQ + tstart + t; const int ch0 = h * 64 + 4 * g;
    v2u gv[4];
#pragma unroll
    for (int ks = 0; ks < 4; ++ks) gv[ks] = *(const GAS v2u*)(lr + m * LRN + 2048 + ch0 + 16 * ks);
    f32x4 y[4]; float s = 0.f;
#pragma unroll
    for (int ks = 0; ks < 4; ++ks) { y[ks] = *(const LAS f32x4*)(Y + t * 64 + 16 * ks + 4 * g); s += (y[ks].x + y[ks].y) + (y[ks].z + y[ks].w); }
    const float mean = xrow_sum(s, lane) * (1.f / 64.f); float q = 0.f;
#pragma unroll
    for (int ks = 0; ks < 4; ++ks) { y[ks] = y[ks] - mean; q += (y[ks].x * y[ks].x + y[ks].y * y[ks].y) + (y[ks].z * y[ks].z + y[ks].w * y[ks].w); }
    const float rstd = rsqrtf(xrow_sum(q, lane) * (1.f / 64.f) + 64e-5f), bo = BO[t];
#pragma unroll
    for (int ks = 0; ks < 4; ++ks) { const int c = ch0 + 16 * ks;
        const f32x4 lw4 = *(const LAS f32x4*)(RW_TABP + 6 * 64 + (c - h * 64)), lb4 = *(const LAS f32x4*)(RW_TABP + 7 * 64 + (c - h * 64));
        const v2u vv = *(const LAS v2u*)(VF + t * 64 + 16 * ks + 4 * g);
        f32x4 o = y[ks] * rstd * lw4 + lb4; o.x += bo * bflo(vv.x); o.y += bo * bfhi(vv.x); o.z += bo * bflo(vv.y); o.w += bo * bfhi(vv.y);
        o.x *= bflo(gv[ks].x); o.y *= bfhi(gv[ks].x); o.z *= bflo(gv[ks].y); o.w *= bfhi(gv[ks].y);
        *(GAS v2u*)(ycat + m * DM + 1024 + c) = (v2u){cvtpk(o.x, o.y), cvtpk(o.z, o.w)}; }
}
#define RW_LOAD(SET, BT, LANE) do { const int tok_ = (BT) * 64 + 16 * w + ((LANE) & 15); const size_t m_ = (size_t)b * SEQ + tok_; const int ch0_ = h * 64 + 4 * ((LANE) >> 4); \
        const bf16* prow_ = proj + m_ * EIN_PAD + 2048 + ch0_; const bf16* lrow_ = lr + m_ * LRN + ch0_; \
        _Pragma("unroll") for (int ks = 0; ks < 4; ++ks) { IN[SET][0][ks] = *(const GAS v2u*)(prow_ + 16 * ks); IN[SET][1][ks] = *(const GAS v2u*)(prow_ + 1024 + 16 * ks); IN[SET][2][ks] = *(const GAS v2u*)(prow_ + 2048 + 16 * ks); \
            IN[SET][3][ks] = *(const GAS v2u*)(lrow_ + 16 * ks); IN[SET][4][ks] = *(const GAS v2u*)(lrow_ + 1024 + 16 * ks); } \
        { const int tp_ = (BT) * 64 + 16 * w - 1; PV[SET][0] = 0u; PV[SET][1] = 0u; PV[SET][2] = 0u; \
          if (tp_ >= 0) { const bf16* pp_ = proj + ((size_t)b * SEQ + tp_) * EIN_PAD + 2048 + h * 64 + (LANE); PV[SET][0] = pp_[0]; PV[SET][1] = pp_[1024]; PV[SET][2] = pp_[2048]; } } } while (0)
#ifndef RW_PK
#define RW_PK 0
#endif
#ifndef RW_SPF
#define RW_SPF 1
#endif
template <int CS> __device__ __forceinline__ void rwkv_batch(Frame& F, const Ptrs& P, const int b, const int h, const int w, const int bt, const int skip, pg8::f32x4 (&Z)[4], v2u (&IN)[2][5][4], unsigned (&PV)[2][3]) {
    const bf16* proj = (const bf16*)(P.ws + WS_PROJ); const bf16* lr = (const bf16*)(P.ws + WS_LR);
    const LAS float* const RW_TABP = (const LAS float*)(F.lds + R2_TAB);
        const int t0 = bt * 64, par = bt & 1;
        int lane_ = F.lane; asm volatile("" : "+v"(lane_));
        const int r16 = lane_ & 15, g = lane_ >> 4;
        if (w < 4) {
            const int c = w, tb = t0 + 16 * c, tok = tb + r16; const size_t m = (size_t)b * SEQ + tok; const int ch0 = h * 64 + 4 * g;
            LAS unsigned char* pc = F.lds + c * R2_PC; LAS unsigned char* sc = F.lds + R2_SC + c * R2_SCB; LAS unsigned char* ye = F.lds + R2_YB + (par * 4 + c) * R2_YE;
            LAS bf16* AT = (LAS bf16*)(sc + 2304); LAS bf16* BT = (LAS bf16*)(pc + R2_BT); LAS bf16* KT = (LAS bf16*)(pc + R2_KT); LAS bf16* VT = (LAS bf16*)(pc + R2_VT);
            LAS bf16* RR = (LAS bf16*)(pc + R2_RR); LAS bf16* VF = (LAS bf16*)(ye + R2_YVF); LAS float* BO = (LAS float*)(ye + R2_YBO); LAS float* GL = (LAS float*)(pc + R2_GL);
            if (CS == 0 && bt == 0) RW_LOAD(0, 0, lane_);
            if (bt + 1 < SEQ / 64) RW_LOAD(CS ^ 1, bt + 1, lane_);
            LAS bf16* PVS = (LAS bf16*)(sc + 7168);
            PVS[lane_] = (bf16)PV[CS][0]; PVS[64 + lane_] = (bf16)PV[CS][1]; PVS[128 + lane_] = (bf16)PV[CS][2];
            LDS_WAIT();
            if (!(skip & 2)) {
            float ssp = 0.f, bop = 0.f;
            pg8::f32x4 Nab = {0.f, 0.f, 0.f, 0.f}, Aak = Nab, Mrb = Nab, Mrk = Nab;
#pragma unroll
            for (int ks = 0; ks < 4; ++ks) { const int cc = ch0 + 16 * ks;
                const f32x4 muk = *(const LAS f32x4*)(RW_TABP + 1 * 64 + (cc - h * 64)), kkv = *(const LAS f32x4*)(RW_TABP + 3 * 64 + (cc - h * 64));
                const v2u lk_ = *(const LAS v2u*)(PVS + 64 + 16 * ks + 4 * g); v2u Kp_;
                Kp_.x = (unsigned)__builtin_amdgcn_update_dpp((int)lk_.x, (int)IN[CS][1][ks].x, 0x111, 0xf, 0xf, false); Kp_.y = (unsigned)__builtin_amdgcn_update_dpp((int)lk_.y, (int)IN[CS][1][ks].y, 0x111, 0xf, 0xf, false);
#pragma unroll
                for (int j = 0; j < 4; ++j) { const unsigned wk_ = (j < 2) ? IN[CS][1][ks].x : IN[CS][1][ks].y, pk_ = (j < 2) ? Kp_.x : Kp_.y;
                    const float kr = (j & 1) ? bfhi(wk_) : bflo(wk_), kp = (j & 1) ? bfhi(pk_) : bflo(pk_); const float kk = (kr + (kp - kr) * muk[j]) * kkv[j]; ssp += kk * kk; } }
            ssp = xrow_sum(ssp, lane_);
            const float inv = rsqrtf(fmaxf(ssp, 1e-12f));
#pragma unroll
            for (int ks = 0; ks < 4; ++ks) { const int cc = ch0 + 16 * ks;
                const f32x4 mur = *(const LAS f32x4*)(RW_TABP + (cc - h * 64)), muk = *(const LAS f32x4*)(RW_TABP + 1 * 64 + (cc - h * 64)), muv = *(const LAS f32x4*)(RW_TABP + 2 * 64 + (cc - h * 64));
                const f32x4 kkv = *(const LAS f32x4*)(RW_TABP + 3 * 64 + (cc - h * 64)), kav = *(const LAS f32x4*)(RW_TABP + 4 * 64 + (cc - h * 64)), rkv = *(const LAS f32x4*)(RW_TABP + 5 * 64 + (cc - h * 64));
                float kt_[4], rt_[4], vv_[4], gl_[4], at_[4], bt_[4];
                v2u Rp_, Kp_, Vp_;
                { const v2u lr_ = *(const LAS v2u*)(PVS + 16 * ks + 4 * g), lk_ = *(const LAS v2u*)(PVS + 64 + 16 * ks + 4 * g), lv_ = *(const LAS v2u*)(PVS + 128 + 16 * ks + 4 * g);
                  Rp_.x = (unsigned)__builtin_amdgcn_update_dpp((int)lr_.x, (int)IN[CS][0][ks].x, 0x111, 0xf, 0xf, false); Rp_.y = (unsigned)__builtin_amdgcn_update_dpp((int)lr_.y, (int)IN[CS][0][ks].y, 0x111, 0xf, 0xf, false);
                  Kp_.x = (unsigned)__builtin_amdgcn_update_dpp((int)lk_.x, (int)IN[CS][1][ks].x, 0x111, 0xf, 0xf, false); Kp_.y = (unsigned)__builtin_amdgcn_update_dpp((int)lk_.y, (int)IN[CS][1][ks].y, 0x111, 0xf, 0xf, false);
                  Vp_.x = (unsigned)__builtin_amdgcn_update_dpp((int)lv_.x, (int)IN[CS][2][ks].x, 0x111, 0xf, 0xf, false); Vp_.y = (unsigned)__builtin_amdgcn_update_dpp((int)lv_.y, (int)IN[CS][2][ks].y, 0x111, 0xf, 0xf, false); }
#if RW_PK
#pragma unroll
                for (int p = 0; p < 2; ++p) {
                    const unsigned wr_ = p ? IN[CS][0][ks].y : IN[CS][0][ks].x, wk_ = p ? IN[CS][1][ks].y : IN[CS][1][ks].x, wv_ = p ? IN[CS][2][ks].y : IN[CS][2][ks].x;
                    const unsigned pr_ = p ? Rp_.y : Rp_.x, pk_ = p ? Kp_.y : Kp_.x, pv_ = p ? Vp_.y : Vp_.x, zw_ = p ? IN[CS][3][ks].y : IN[CS][3][ks].x, za_ = p ? IN[CS][4][ks].y : IN[CS][4][ks].x;
                    const f32x2 rr = {bflo(wr_), bfhi(wr_)}, kr = {bflo(wk_), bfhi(wk_)}, vr = {bflo(wv_), bfhi(wv_)}, rp = {bflo(pr_), bfhi(pr_)}, kp = {bflo(pk_), bfhi(pk_)}, vp = {bflo(pv_), bfhi(pv_)};
                    const f32x2 zw = {bflo(zw_), bfhi(zw_)}, za = {bflo(za_), bfhi(za_)};
                    const f32x2 mur2 = p ? (f32x2){mur.z, mur.w} : (f32x2){mur.x, mur.y}, muk2 = p ? (f32x2){muk.z, muk.w} : (f32x2){muk.x, muk.y}, muv2 = p ? (f32x2){muv.z, muv.w} : (f32x2){muv.x, muv.y};
                    const f32x2 kkv2 = p ? (f32x2){kkv.z, kkv.w} : (f32x2){kkv.x, kkv.y}, kav2 = p ? (f32x2){kav.z, kav.w} : (f32x2){kav.x, kav.y}, rkv2 = p ? (f32x2){rkv.z, rkv.w} : (f32x2){rkv.x, rkv.y};
                    const f32x2 one2 = {1.f, 1.f}, nl2 = {-1.442695041f, -1.442695041f}, l2e = {1.442695041f, 1.442695041f};
                    const f32x2 r = rr + (rp - rr) * mur2, k = kr + (kp - kr) * muk2, v = vr + (vp - vr) * muv2;
                    const f32x2 ezw = zw * nl2, eza = za * nl2;
                    const f32x2 dw = (f32x2){__builtin_amdgcn_exp2f(ezw.x), __builtin_amdgcn_exp2f(ezw.y)} + one2, da = (f32x2){__builtin_amdgcn_exp2f(eza.x), __builtin_amdgcn_exp2f(eza.y)} + one2;
                    const f32x2 lw = (f32x2){__builtin_amdgcn_rcpf(dw.x), __builtin_amdgcn_rcpf(dw.y)} * (f32x2){-0.60653066f, -0.60653066f}, al = {__builtin_amdgcn_rcpf(da.x), __builtin_amdgcn_rcpf(da.y)};
                    const f32x2 cl = {scan16(lw.x), scan16(lw.y)};
                    const f32x2 e1 = cl * l2e, e3 = (cl - lw) * l2e;
                    const f32x2 gcur = {__builtin_amdgcn_exp2f(e1.x), __builtin_amdgcn_exp2f(e1.y)}, gi = {__builtin_amdgcn_exp2f(-e1.x), __builtin_amdgcn_exp2f(-e1.y)}, gprev = {__builtin_amdgcn_exp2f(e3.x), __builtin_amdgcn_exp2f(e3.y)};
                    const f32x2 kk = k * kkv2 * (f32x2){inv, inv};
                    const f32x2 kq = k * ((al - one2) * kav2 + one2); const f32x2 bo2 = r * kq * rkv2; bop += bo2.x + bo2.y;
                    const f32x2 at2 = kk * gprev, bt2 = kk * al * gi, kt2 = kq * gi, rt2 = r * gcur;
                    at_[2 * p] = -at2.x; at_[2 * p + 1] = -at2.y; bt_[2 * p] = bt2.x; bt_[2 * p + 1] = bt2.y; kt_[2 * p] = kt2.x; kt_[2 * p + 1] = kt2.y;
                    rt_[2 * p] = rt2.x; rt_[2 * p + 1] = rt2.y; vv_[2 * p] = v.x; vv_[2 * p + 1] = v.y; gl_[2 * p] = gcur.x; gl_[2 * p + 1] = gcur.y;
                }
#else
#pragma unroll
                for (int j = 0; j < 4; ++j) {
                    const unsigned wr_ = (j < 2) ? IN[CS][0][ks].x : IN[CS][0][ks].y, wk_ = (j < 2) ? IN[CS][1][ks].x : IN[CS][1][ks].y, wv_ = (j < 2) ? IN[CS][2][ks].x : IN[CS][2][ks].y;
                    const unsigned pr_ = (j < 2) ? Rp_.x : Rp_.y, pk_ = (j < 2) ? Kp_.x : Kp_.y, pv_ = (j < 2) ? Vp_.x : Vp_.y;
                    const unsigned zw_ = (j < 2) ? IN[CS][3][ks].x : IN[CS][3][ks].y, za_ = (j < 2) ? IN[CS][4][ks].x : IN[CS][4][ks].y;
                    const float rr = (j & 1) ? bfhi(wr_) : bflo(wr_), kr = (j & 1) ? bfhi(wk_) : bflo(wk_), vr = (j & 1) ? bfhi(wv_) : bflo(wv_);
                    const float rp = (j & 1) ? bfhi(pr_) : bflo(pr_), kp = (j & 1) ? bfhi(pk_) : bflo(pk_), vp = (j & 1) ? bfhi(pv_) : bflo(pv_);
                    const float zw = (j & 1) ? bfhi(zw_) : bflo(zw_), za = (j & 1) ? bfhi(za_) : bflo(za_);
                    const float r = rr + (rp - rr) * mur[j], k = kr + (kp - kr) * muk[j], v = vr + (vp - vr) * muv[j];
                    const float lw = -0.60653066f * fsig(zw), al = fsig(za);
                    const float cl = scan16(lw), gcur = __expf(cl), gi = __expf(-cl), gprev = __expf(cl - lw);
                    const float kk = k * kkv[j] * inv;
                    const float kq = k * (1.f + (al - 1.f) * kav[j]); bop += r * kq * rkv[j];
                    at_[j] = -kk * gprev; bt_[j] = kk * al * gi; kt_[j] = kq * gi; rt_[j] = r * gcur; vv_[j] = v; gl_[j] = gcur;
                }
#endif
                const bf16x4 bK = pack4((pg8::f32x4){kt_[0], kt_[1], kt_[2], kt_[3]}), aR = pack4((pg8::f32x4){rt_[0], rt_[1], rt_[2], rt_[3]});
                const bf16x4 aA = pack4((pg8::f32x4){at_[0], at_[1], at_[2], at_[3]}), bB = pack4((pg8::f32x4){bt_[0], bt_[1], bt_[2], bt_[3]});
                const v2u vpk = (v2u){cvtpk(vv_[0], vv_[1]), cvtpk(vv_[2], vv_[3])};
                if (r16 == 15) *(LAS f32x4*)(GL + 16 * ks + 4 * g) = (f32x4){gl_[0], gl_[1], gl_[2], gl_[3]};
                *(LAS bf16x4*)(RR + r16 * 72 + 16 * ks + 4 * g) = aR; *(LAS v2u*)(VF + r16 * 64 + 16 * ks + 4 * g) = vpk;
                if (!(skip & 16))
#pragma unroll
                for (int j = 0; j < 4; ++j) { const int kch = 16 * ks + 4 * g + j;
                    AT[kch * 20 + r16] = (bf16)aA[j]; BT[kch * 20 + r16] = (bf16)bB[j]; KT[kch * 20 + r16] = (bf16)bK[j];
                    VT[kch * 20 + r16] = (bf16)((j & 1) ? (((j < 2) ? vpk.x : vpk.y) >> 16) : (((j < 2) ? vpk.x : vpk.y) & 0xffffu)); }
                Nab = MFMA16(aA, bB, Nab); Aak = MFMA16(aA, bK, Aak); Mrb = MFMA16(aR, bB, Mrb); Mrk = MFMA16(aR, bK, Mrk);
                __builtin_amdgcn_sched_barrier(0);
            }
            bop = xrow_sum(bop, lane_);
            if (g == 0) BO[r16] = bop;
            LAS float* NF = (LAS float*)sc; LAS bf16* TB = (LAS bf16*)(sc + 4864);
            LAS bf16* MB = (LAS bf16*)(pc + R2_MB); LAS bf16* MK = (LAS bf16*)(pc + R2_MK); LAS bf16* TAo = (LAS bf16*)(pc + R2_TA); LAS bf16* WR = (LAS bf16*)(pc + R2_WR);
#pragma unroll
            for (int rg = 0; rg < 4; ++rg) { const int t = 4 * g + rg;
                if (!(r16 < t)) { Nab[rg] = 0.f; Aak[rg] = 0.f; } if (!(r16 <= t)) { Mrb[rg] = 0.f; Mrk[rg] = 0.f; }
                NF[t * 16 + r16] = Nab[rg]; MB[t * 24 + r16] = (bf16)f2bf(Mrb[rg]); MK[t * 24 + r16] = (bf16)f2bf(Mrk[rg]); }
            const bf16x4 bAak = pack4(Aak);
            LDS_WAIT();
            float Tc[16];
#pragma unroll
            for (int t = 0; t < 16; ++t) {
                const LAS f32x4* rowp = (const LAS f32x4*)(NF + t * 16);
                float acc = (t == lane_) ? 1.f : 0.f, acc1 = 0.f, acc2 = 0.f, acc3 = 0.f;
                if (!(skip & 1))
#pragma unroll
                for (int q = 0; q < 4; ++q) { if (4 * q < t) { const f32x4 rv = rowp[q];
                    if (4 * q + 0 < t) acc += rv.x * Tc[4 * q + 0]; if (4 * q + 1 < t) acc1 += rv.y * Tc[4 * q + 1]; if (4 * q + 2 < t) acc2 += rv.z * Tc[4 * q + 2]; if (4 * q + 3 < t) acc3 += rv.w * Tc[4 * q + 3]; } }
                Tc[t] = (acc + acc1) + (acc2 + acc3);
            }
            if (lane_ < 16) {
#pragma unroll
                for (int t = 0; t < 16; ++t) TB[t * 24 + lane_] = (bf16)f2bf(Tc[t]);
            }
            LDS_WAIT();
            const bf16x4 aT = *(const LAS bf16x4*)(TB + r16 * 24 + 4 * g);
#pragma unroll
            for (int nt = 0; nt < 4; ++nt) { const bf16x4 bA = *(const LAS bf16x4*)(AT + (16 * nt + r16) * 20 + 4 * g);
                const pg8::f32x4 Wn = MFMA16(aT, bA, ((pg8::f32x4){0.f, 0.f, 0.f, 0.f}));
#pragma unroll
                for (int rg = 0; rg < 4; ++rg) WR[(4 * g + rg) * 72 + 16 * nt + r16] = (bf16)f2bf(Wn[rg]); }
            { const pg8::f32x4 TAm = MFMA16(aT, bAak, ((pg8::f32x4){0.f, 0.f, 0.f, 0.f}));
#pragma unroll
              for (int rg = 0; rg < 4; ++rg) TAo[(4 * g + rg) * 24 + r16] = (bf16)f2bf(TAm[rg]); }
            }
        } else if (bt > 0 && !(skip & 8)) {
            rwkv_post(lane_, P, b, h, t0 - 64 + 16 * (w - 4), F.lds + R2_YB + ((1 - par) * 4 + (w - 4)) * R2_YE, RW_TABP);
        }
        LBAR();
        if (w < 4 && !(skip & 4)) {
            const int nb = w;
#if RW_SPF
            bf16x4 nW[4], nR[4], nV, nT;
#define RW_SPF_LOAD(C) do { const LAS unsigned char* pq_ = F.lds + (C) * R2_PC; \
                _Pragma("unroll") for (int kb = 0; kb < 4; ++kb) { nW[kb] = *(const LAS bf16x4*)((const LAS bf16*)(pq_ + R2_WR) + r16 * 72 + 16 * kb + 4 * g); nR[kb] = *(const LAS bf16x4*)((const LAS bf16*)(pq_ + R2_RR) + r16 * 72 + 16 * kb + 4 * g); } \
                nV = *(const LAS bf16x4*)((const LAS bf16*)(pq_ + R2_VT) + (16 * nb + r16) * 20 + 4 * g); nT = *(const LAS bf16x4*)((const LAS bf16*)(pq_ + R2_TA) + r16 * 24 + 4 * g); } while (0)
            RW_SPF_LOAD(0);
#endif
#pragma unroll 1
            for (int c = 0; c < 4; ++c) {
                LAS unsigned char* pc = F.lds + c * R2_PC; LAS float* Y = (LAS float*)(F.lds + R2_YB + (par * 4 + c) * R2_YE);
                const LAS bf16* WR = (const LAS bf16*)(pc + R2_WR); const LAS bf16* RR = (const LAS bf16*)(pc + R2_RR);
                bf16x4 zb[4];
#pragma unroll
                for (int kb = 0; kb < 4; ++kb) zb[kb] = pack4(Z[kb]);
#if RW_SPF
                bf16x4 cW[4], cR[4]; const bf16x4 vB = nV, cT = nT;
#pragma unroll
                for (int kb = 0; kb < 4; ++kb) { cW[kb] = nW[kb]; cR[kb] = nR[kb]; }
                if (c < 3) RW_SPF_LOAD(c + 1);
                pg8::f32x4 U = {0.f, 0.f, 0.f, 0.f}, Yt = U;
#pragma unroll
                for (int kb = 0; kb < 4; ++kb) { U = MFMA16(cW[kb], zb[kb], U); Yt = MFMA16(cR[kb], zb[kb], Yt); }
                U = MFMA16(cT, vB, U);
#else
                const bf16x4 vB = *(const LAS bf16x4*)((const LAS bf16*)(pc + R2_VT) + (16 * nb + r16) * 20 + 4 * g);
                pg8::f32x4 U = {0.f, 0.f, 0.f, 0.f}, Yt = U;
#pragma unroll
                for (int kb = 0; kb < 4; ++kb) { const bf16x4 aW = *(const LAS bf16x4*)(WR + r16 * 72 + 16 * kb + 4 * g), aR = *(const LAS bf16x4*)(RR + r16 * 72 + 16 * kb + 4 * g);
                    U = MFMA16(aW, zb[kb], U); Yt = MFMA16(aR, zb[kb], Yt); }
                U = MFMA16(*(const LAS bf16x4*)((const LAS bf16*)(pc + R2_TA) + r16 * 24 + 4 * g), vB, U);
#endif
                const bf16x4 ub = pack4(U);
                Yt = MFMA16(*(const LAS bf16x4*)((const LAS bf16*)(pc + R2_MB) + r16 * 24 + 4 * g), ub, Yt);
                Yt = MFMA16(*(const LAS bf16x4*)((const LAS bf16*)(pc + R2_MK) + r16 * 24 + 4 * g), vB, Yt);
#pragma unroll
                for (int rg = 0; rg < 4; ++rg) Y[(4 * g + rg) * 64 + 16 * nb + r16] = Yt[rg];
#pragma unroll
                for (int kb = 0; kb < 4; ++kb) {
                    Z[kb] = MFMA16(*(const LAS bf16x4*)((const LAS bf16*)(pc + R2_BT) + (16 * kb + r16) * 20 + 4 * g), ub, Z[kb]);
                    Z[kb] = MFMA16(*(const LAS bf16x4*)((const LAS bf16*)(pc + R2_KT) + (16 * kb + r16) * 20 + 4 * g), vB, Z[kb]);
                    Z[kb] = Z[kb] * *(const LAS f32x4*)((const LAS float*)(pc + R2_GL) + 16 * kb + 4 * g);
                }
            }
        }
        LBAR();
    }
__device__ __forceinline__ void rwkv_unit2(Frame& F, const Ptrs& P, int unit, int skip = 0) {
    const int b = unit >> 4, h = unit & 15, w = F.wave;
    const bf16* proj = (const bf16*)(P.ws + WS_PROJ); const bf16* lr = (const bf16*)(P.ws + WS_LR);
    const float* mu = P.in[IN_B_MU];
    { const int k_ = F.tid >> 6, c_ = h * 64 + (F.tid & 63);
      const float* src_ = k_ < 3 ? mu + 1024 * k_ : (k_ == 3 ? P.in[IN_B_K_K] : (k_ == 4 ? P.in[IN_B_K_A] : (k_ == 5 ? P.in[IN_B_R_K] : (k_ == 6 ? P.in[IN_B_LN_W] : P.in[IN_B_LN_B]))));
      ((LAS float*)(F.lds + R2_TAB))[F.tid] = src_[c_]; }
    LBAR();
    pg8::f32x4 Z[4];
#pragma unroll
    for (int i = 0; i < 4; ++i) Z[i] = (pg8::f32x4){0.f, 0.f, 0.f, 0.f};
    v2u IN[2][5][4]; unsigned PV[2][3];
    for (int bt = 0; bt < SEQ / 64; bt += 2) {
        rwkv_batch<0>(F, P, b, h, w, bt, skip, Z, IN, PV);
        rwkv_batch<1>(F, P, b, h, w, bt + 1, skip, Z, IN, PV);
    }
#undef RW_LOAD
    int lane2_ = F.lane, tl_ = SEQ - 64; asm volatile("" : "+v"(lane2_), "+s"(tl_));
    if (w >= 4) rwkv_post(lane2_, P, b, h, tl_ + 16 * (w - 4), F.lds + R2_YB + (1 * 4 + (w - 4)) * R2_YE, (const LAS float*)(F.lds + R2_TAB));
}

#ifndef PRE_PK
#define PRE_PK 1
#endif
constexpr int PT_CW = 0, PT_CB = 8192, PT_P4 = 10240, PT_GT = 18432, PT_SZ = 51200;
__device__ __forceinline__ void pre_step(const v4u (&x)[4], const LAS unsigned char* T, const int cl, const int t, const int r, bf16* xcp_out, bf16* kp_out, pg8::f32x4& acc) {
    float a[8];
#if PRE_PK
    {
        f32x2 a2[4];
        { const f32x4 b0 = *(const LAS f32x4*)(T + PT_CB + cl * 4), b1 = *(const LAS f32x4*)(T + PT_CB + cl * 4 + 16);
          a2[0] = (f32x2){b0.x, b0.y}; a2[1] = (f32x2){b0.z, b0.w}; a2[2] = (f32x2){b1.x, b1.y}; a2[3] = (f32x2){b1.z, b1.w}; }
#pragma unroll
        for (int jj = 0; jj < 4; ++jj) { const float mk = (t - 3 + jj >= 0) ? 1.f : 0.f; const f32x2 mk2 = {mk, mk};
            const f32x4 w0 = *(const LAS f32x4*)(T + PT_CW + jj * 2048 + cl * 4), w1 = *(const LAS f32x4*)(T + PT_CW + jj * 2048 + cl * 4 + 16);
#pragma unroll
            for (int p = 0; p < 4; ++p) { const f32x2 wv = (p == 0) ? (f32x2){w0.x, w0.y} : (p == 1) ? (f32x2){w0.z, w0.w} : (p == 2) ? (f32x2){w1.x, w1.y} : (f32x2){w1.z, w1.w};
                a2[p] = (wv * mk2) * (f32x2){bflo(x[jj][p]), bfhi(x[jj][p])} + a2[p]; } }
#pragma unroll
        for (int p = 0; p < 4; ++p) { const f32x2 ea = a2[p] * (f32x2){-1.442695041f, -1.442695041f};
            const f32x2 den = (f32x2){__builtin_amdgcn_exp2f(ea.x), __builtin_amdgcn_exp2f(ea.y)} + (f32x2){1.f, 1.f};
            const f32x2 sv = a2[p] * (f32x2){__builtin_amdgcn_rcpf(den.x), __builtin_amdgcn_rcpf(den.y)};
            a[2 * p] = sv.x; a[2 * p + 1] = sv.y; }
    }
#else
    { const f32x4 b0 = *(const LAS f32x4*)(T + PT_CB + cl * 4), b1 = *(const LAS f32x4*)(T + PT_CB + cl * 4 + 16);
      a[0] = b0.x; a[1] = b0.y; a[2] = b0.z; a[3] = b0.w; a[4] = b1.x; a[5] = b1.y; a[6] = b1.z; a[7] = b1.w; }
#pragma unroll
    for (int jj = 0; jj < 4; ++jj) { const float mk = (t - 3 + jj >= 0) ? 1.f : 0.f; const f32x4 w0 = *(const LAS f32x4*)(T + PT_CW + jj * 2048 + cl * 4) * mk, w1 = *(const LAS f32x4*)(T + PT_CW + jj * 2048 + cl * 4 + 16) * mk;
        a[0] += w0.x * bflo(x[jj][0]); a[1] += w0.y * bfhi(x[jj][0]); a[2] += w0.z * bflo(x[jj][1]); a[3] += w0.w * bfhi(x[jj][1]);
        a[4] += w1.x * bflo(x[jj][2]); a[5] += w1.y * bfhi(x[jj][2]); a[6] += w1.z * bflo(x[jj][3]); a[7] += w1.w * bfhi(x[jj][3]); }
#pragma unroll
    for (int j = 0; j < 8; ++j) a[j] = fsilu(a[j]);
#endif
    v4u xcp; xcp.x = cvtpk(a[0], a[1]); xcp.y = cvtpk(a[2], a[3]); xcp.z = cvtpk(a[4], a[5]); xcp.w = cvtpk(a[6], a[7]);
    float ar[8];
#pragma unroll
    for (int j = 0; j < 4; ++j) { ar[2 * j] = bflo(xcp[j]); ar[2 * j + 1] = bfhi(xcp[j]); }
    float kq[8];
#pragma unroll
    for (int bq = 0; bq < 2; ++bq) { const LAS unsigned char* p4 = T + PT_P4 + (cl / 4 + bq) * 64;
        const f32x4 q0 = *(const LAS f32x4*)(p4), q1 = *(const LAS f32x4*)(p4 + 16), q2 = *(const LAS f32x4*)(p4 + 32), q3 = *(const LAS f32x4*)(p4 + 48);
        const f32x4 o = q0 * ar[4 * bq] + q1 * ar[4 * bq + 1] + q2 * ar[4 * bq + 2] + q3 * ar[4 * bq + 3];
        kq[4 * bq] = o.x; kq[4 * bq + 1] = o.y; kq[4 * bq + 2] = o.z; kq[4 * bq + 3] = o.w; }
    v4u kp; kp.x = cvtpk(kq[0], kq[1]); kp.y = cvtpk(kq[2], kq[3]); kp.z = cvtpk(kq[4], kq[5]); kp.w = cvtpk(kq[6], kq[7]);
    *(GAS v4u*)xcp_out = xcp; *(GAS v4u*)kp_out = kp;
    const v4u g1 = *(const LAS v4u*)(T + PT_GT + (r * 1024 + cl) * 2), g2 = *(const LAS v4u*)(T + PT_GT + (r * 1024 + 512 + cl) * 2);
    acc = __builtin_amdgcn_mfma_f32_16x16x32_bf16(__builtin_bit_cast(pg8::bf16x8, xcp), __builtin_bit_cast(pg8::bf16x8, g1), acc, 0, 0, 0);
    acc = __builtin_amdgcn_mfma_f32_16x16x32_bf16(__builtin_bit_cast(pg8::bf16x8, x[3]), __builtin_bit_cast(pg8::bf16x8, g2), acc, 0, 0, 0);
}
__device__ __forceinline__ void ph_mlstm_pre(Frame& F, const Ptrs& P) {
    const bf16* xm = (const bf16*)(P.ws + WS_XM); bf16* xc = (bf16*)(P.ws + WS_XC); bf16* kpp = (bf16*)(P.ws + WS_KPP);
    const bf16* Gt = (const bf16*)(P.ws + WS_GT); const float* P4 = (const float*)(P.ws + WS_P4); float* gates = (float*)(P.ws + WS_GATES);
    const float* cw = P.in[IN_C_CONV_W]; const float* cbias = P.in[IN_C_CONV_B];
    const int r = F.lane & 15, g = F.lane >> 4;
    for (int rb = blockIdx.x; rb < M / 128; rb += F.G) {
        const int tile = rb * 8 + F.wave, m = tile * 16 + r, t = m & (SEQ - 1);
        pg8::f32x4 acc = {0.f, 0.f, 0.f, 0.f};
        const bf16* xrow = xm + (size_t)m * CW; bf16* xcrow = xc + (size_t)m * CW; bf16* kprow = kpp + (size_t)m * CW;
        v4u XA[4][4], XB[4][4];
#define PRE_LOAD(X, G) do { _Pragma("unroll") for (int u_ = 0; u_ < 4; ++u_) { const int c0_ = 128 * (G) + 32 * u_ + 8 * g; \
            _Pragma("unroll") for (int jj = 0; jj < 4; ++jj) X[u_][jj] = *(const GAS v4u*)(xrow + (ptrdiff_t)((t - 3 + jj >= 0) ? jj - 3 : 0) * CW + c0_); } } while (0)
        PRE_LOAD(XA, 0);
        for (int G = 0; G < 32; G += 2) {
            const int seg = G >> 2;
            LAS unsigned char* T = F.lds + (seg & 1) * PT_SZ;
            if ((G & 3) == 0) { const int c512 = seg * 512;
              for (int i = F.tid; i < 512; i += NTHR) { const int jj = i >> 7, q = i & 127; *(LAS f32x4*)(T + PT_CW + jj * 2048 + q * 16) = *(const GAS f32x4*)(cw + jj * CW + c512 + 4 * q); }
              if (F.tid < 128) *(LAS f32x4*)(T + PT_CB + F.tid * 16) = *(const GAS f32x4*)(cbias + c512 + 4 * F.tid);
              *(LAS f32x4*)(T + PT_P4 + F.tid * 16) = *(const GAS f32x4*)(P4 + (size_t)(c512 / 4) * 16 + 4 * F.tid);
              for (int i = F.tid; i < 2048; i += NTHR) { const int gi = i >> 7, part = (i >> 6) & 1, q = i & 63; *(LAS v4u*)(T + PT_GT + (gi * 1024 + part * 512 + q * 8) * 2) = *(const GAS v4u*)(Gt + (size_t)gi * 8192 + part * 4096 + c512 + 8 * q); }
              LBAR(); }
            PRE_LOAD(XB, G + 1);
#pragma unroll
            for (int u = 0; u < 4; ++u) { const int cl = 128 * (G & 3) + 32 * u + 8 * g, c0 = 512 * seg + cl; pre_step(XA[u], T, cl, t, r, xcrow + c0, kprow + c0, acc); }
            if (G + 2 < 32) PRE_LOAD(XA, G + 2);
#pragma unroll
            for (int u = 0; u < 4; ++u) { const int cl = 128 * ((G + 1) & 3) + 32 * u + 8 * g, c0 = 512 * seg + cl; pre_step(XB[u], T, cl, t, r, xcrow + c0, kprow + c0, acc); }
        }
#undef PRE_LOAD
        const float bi = P.in[IN_C_B_IF][r];
#pragma unroll
        for (int rg = 0; rg < 4; ++rg) gates[(size_t)(tile * 16 + 4 * g + rg) * 16 + r] = acc[rg] + bi;
        LBAR();
    }
}
__device__ __forceinline__ void ph_mlstm_post(Frame& F, const Ptrs& P) {
    const bf16* hc = (const bf16*)(P.ws + WS_XM); bf16* xc = (bf16*)(P.ws + WS_XC);
    const float* lnw = P.in[IN_C_LN_W]; const float* skip = P.in[IN_C_SKIP];
    for (int m = F.gw; m < M; m += F.NGW) {
#pragma unroll 2
        for (int hh = 0; hh < 8; ++hh) {
            const int c0 = hh * CHD + 8 * F.lane;
            const v4u hv = *(const GAS v4u*)(hc + (size_t)m * CW + c0), xv = *(const GAS v4u*)(xc + (size_t)m * CW + c0);
            float x[8]; float s = 0.f;
#pragma unroll
            for (int j = 0; j < 4; ++j) { x[2 * j] = bflo(hv[j]); x[2 * j + 1] = bfhi(hv[j]); s += x[2 * j] + x[2 * j + 1]; }
            const float mean = wave_sum(s) * (1.f / CHD); float q = 0.f;
#pragma unroll
            for (int j = 0; j < 8; ++j) { x[j] -= mean; q += x[j] * x[j]; }
            const float rstd = rsqrtf(wave_sum(q) * (1.f / CHD) + 1e-6f);
            const f32x4 w0 = *(const GAS f32x4*)(lnw + c0), w1 = *(const GAS f32x4*)(lnw + c0 + 4), s0 = *(const GAS f32x4*)(skip + c0), s1 = *(const GAS f32x4*)(skip + c0 + 4);
            float o[8];
            o[0] = x[0] * rstd * w0.x + s0.x * bflo(xv[0]); o[1] = x[1] * rstd * w0.y + s0.y * bfhi(xv[0]); o[2] = x[2] * rstd * w0.z + s0.z * bflo(xv[1]); o[3] = x[3] * rstd * w0.w + s0.w * bfhi(xv[1]);
            o[4] = x[4] * rstd * w1.x + s1.x * bflo(xv[2]); o[5] = x[5] * rstd * w1.y + s1.y * bfhi(xv[2]); o[6] = x[6] * rstd * w1.z + s1.z * bflo(xv[3]); o[7] = x[7] * rstd * w1.w + s1.w * bfhi(xv[3]);
            v4u w; w.x = cvtpk(o[0], o[1]); w.y = cvtpk(o[2], o[3]); w.z = cvtpk(o[4], o[5]); w.w = cvtpk(o[6], o[7]);
            *(GAS v4u*)(xc + (size_t)m * CW + c0) = w;
        }
    }
}
__device__ __forceinline__ void ph_mlstm_stats(Frame& F, const Ptrs& P) {
    const bf16* hc = (const bf16*)(P.ws + WS_XM); float* stats = (float*)(P.ws + WS_STATS);
    for (int m = F.gw; m < M; m += F.NGW) {
        v4u hv[8];
#pragma unroll
        for (int hh = 0; hh < 8; ++hh) hv[hh] = *(const GAS v4u*)(hc + (size_t)m * CW + hh * CHD + 8 * F.lane);
#pragma unroll
        for (int hh = 0; hh < 8; ++hh) { float x[8]; float s = 0.f;
#pragma unroll
            for (int j = 0; j < 4; ++j) { x[2 * j] = bflo(hv[hh][j]); x[2 * j + 1] = bfhi(hv[hh][j]); s += x[2 * j] + x[2 * j + 1]; }
            const float mean = wave_sum(s) * (1.f / CHD); float q = 0.f;
#pragma unroll
            for (int j = 0; j < 8; ++j) { const float d = x[j] - mean; q += d * d; }
            const float rstd = rsqrtf(wave_sum(q) * (1.f / CHD) + 1e-6f);
            if (F.lane == 0) { f32x2 o = {mean, rstd}; *(GAS f32x2*)(stats + ((size_t)m * 8 + hh) * 2) = o; } }
    }
}
constexpr int ML_QP = 0, ML_KP = 66560, ML_VTE = 133120, ML_MISC = 151552, ML_SD = 155200, ML_QSTR = 520, ML_VSTR = 72;
constexpr int MS_E = 0, MS_ROWF = 64, MS_SC = 128, MS_FLOOR = 192, MS_RS = 256, MS_QN = 320, MS_SCAL = 384, MS_N = 400;
__device__ __forceinline__ float bperm(int srclane, float x) { return __int_as_float(__builtin_amdgcn_ds_bpermute(srclane << 2, __float_as_int(x))); }
#ifndef NEW_N
#define NEW_N 4
#endif
#ifndef ML_QPF
#define ML_QPF 0
#endif
#ifndef ML_GLDS
#define ML_GLDS 1
#endif
#ifndef ML_GPRE
#define ML_GPRE 1
#endif
#ifndef ML_SDOWN
#define ML_SDOWN 1
#endif
#ifndef ML_PIPE3
#define ML_PIPE3 1
#endif
#ifndef ML_PIPE6
#define ML_PIPE6 1
#endif
#ifndef ML_XPF
#define ML_XPF 1
#endif
#ifndef ML_WVREG
#define ML_WVREG 1
#endif
#ifndef ML_PIPE2
#define ML_PIPE2 0
#endif
#ifndef ML_QNASM
#define ML_QNASM 1
#endif
#ifndef ML_NSPLIT
#define ML_NSPLIT (ML_SDOWN && ML_GLDS)
#endif
#define SDX(t, s_) (ML_SDOWN ? ((t) * 64 + ((((s_) >> 3) ^ ((t) & 7)) << 3) + ((s_) & 7)) : ((t) * ML_VSTR + (s_)))
#ifndef DRY_SKIP
#define DRY_SKIP 0
#endif
#define DSK(bit) (dry && ((DRY_SKIP >> (bit)) & 1))
__device__ __forceinline__ void mlstm_unit(Frame& F, const Ptrs& P, int unit, bool dry = false) {
    const int j = unit & 3, hh = (unit >> 2) & 7, b = unit >> 5;
    const bf16* xcg = (const bf16*)(P.ws + WS_XC); const bf16* kpg = (const bf16*)(P.ws + WS_KPP); bf16* xm = (bf16*)(P.ws + WS_XM);
    const float* gates = (const float*)(P.ws + WS_GATES); const float* wv = P.in[IN_C_W_V];
    LAS bf16* QP = (LAS bf16*)(F.lds + ML_QP); LAS bf16* KP = (LAS bf16*)(F.lds + ML_KP); LAS bf16* VTE = (LAS bf16*)(F.lds + ML_VTE); LAS bf16* SD = ML_SDOWN ? (LAS bf16*)(F.lds + ML_SD) : QP;
    LAS float* MS = (LAS float*)(F.lds + ML_MISC);
    const int w = F.wave;
    const int hc0 = hh * CHD, vc0 = hc0 + 128 * j;
    v2u Cb[32];
#pragma unroll
    for (int i = 0; i < 32; ++i) Cb[i] = (v2u){0u, 0u};
    MS[MS_N + F.tid] = 0.f; if (F.tid == 0) { MS[MS_SCAL + 2] = 0.f; MS[MS_SCAL + 3] = 0.f; }
#if ML_GPRE
    float* gsc = P.out + (size_t)unit * 8192;
    { const int l0 = F.tid & 63;
      for (int c8 = 0; c8 < 8; ++c8) { const int chq = w * 8 + c8; const size_t mm = (size_t)b * SEQ + chq * 64 + l0;
        const float ipre = gates[mm * 16 + hh], fpre = gates[mm * 16 + 8 + hh];
        const float lf = fminf(fpre, 0.f) - log1pf(__expf(-fabsf(fpre)));
        float bcum = lf;
#pragma unroll
        for (int o = 1; o < 64; o <<= 1) { const float tv = bperm(l0 - o, bcum); if (l0 >= o) bcum += tv; }
        float pm = ipre - bcum;
#pragma unroll
        for (int o = 1; o < 64; o <<= 1) { const float tv = bperm(l0 - o, pm); if (l0 >= o) pm = fmaxf(pm, tv); }
        { f32x2 o2 = {bcum, pm}; *(GAS f32x2*)(gsc + (chq * 64 + l0) * 2) = o2; } }
      asm volatile("s_waitcnt vmcnt(0)" ::: "memory"); }
#endif
    LBAR();
#if ML_QPF
    v4u qpf[ML_QPF];
    { int t0_ = F.tid; asm volatile("" : "+v"(t0_));
#pragma unroll
      for (int it = 0; it < ML_QPF; ++it) { const int id = it * NTHR + t0_, row = id >> 6, cchunk = id & 63; qpf[it] = *(const GAS v4u*)(xcg + ((size_t)b * SEQ + row) * CW + hc0 + 8 * cchunk); } }
#endif
#if ML_WVREG
    f32x4 wq0, wq1, wq2, wq3;
    { const float* wb = wv + (size_t)(vc0 / 4 + (F.tid & 31)) * 16; wq0 = *(const GAS f32x4*)(wb); wq1 = *(const GAS f32x4*)(wb + 4); wq2 = *(const GAS f32x4*)(wb + 8); wq3 = *(const GAS f32x4*)(wb + 12); }
#endif
#if ML_XPF
    v2u xvn[4]; float ipn = 0.f, fpn = 0.f, gpn = 0.f;
    { int t0_ = F.tid; asm volatile("" : "+v"(t0_)); const int vb_ = t0_ & 31, sg_ = t0_ >> 5, l0_ = t0_ & 63; const size_t mq = (size_t)b * SEQ;
#pragma unroll
      for (int i = 0; i < 4; ++i) xvn[i] = *(const GAS v2u*)(xm + (mq + 4 * sg_ + i) * CW + vc0 + 4 * vb_);
      if (w == 0) { ipn = gates[(mq + l0_) * 16 + hh]; const f32x2 bp = *(const GAS f32x2*)(gsc + l0_ * 2); fpn = bp.x; gpn = bp.y; } }
#endif
    for (int ch = 0; ch < SEQ / 64; ++ch) {
        const size_t m0 = (size_t)b * SEQ + ch * 64;
        int tid = F.tid; asm volatile("" : "+v"(tid));
        const int lid = tid & 63, r = lid & 15, g = lid >> 4;
#if ML_GLDS
        float ipre = 0.f, fpre = 0.f, gpm = 0.f;
#if ML_NSPLIT
        if (tid < 256) { const f32x2 nv = *(const LAS f32x2*)(MS + MS_N + 2 * tid); const int k_ = 2 * tid, pos = (k_ & ~31) + 8 * ((k_ >> 2) & 3) + 4 * ((k_ >> 4) & 1) + (k_ & 3);
            const unsigned hi2 = cvtpk(nv.x, nv.y), lo2 = cvtpk(nv.x - bflo(hi2), nv.y - bfhi(hi2));
            *(LAS unsigned*)(SD + pos) = hi2; *(LAS unsigned*)(SD + 512 + pos) = lo2; }
#endif
#if ML_XPF
        ipre = ipn; fpre = fpn; gpm = gpn;
#elif ML_GPRE
        if (w == 0) { ipre = gates[(m0 + lid) * 16 + hh]; const f32x2 bp = *(const GAS f32x2*)(gsc + (ch * 64 + lid) * 2); fpre = bp.x; gpm = bp.y; }
#else
        if (w == 0) { ipre = gates[(m0 + lid) * 16 + hh]; fpre = gates[(m0 + lid) * 16 + 8 + hh]; }
#endif
        const int vblk = tid & 31, sg = tid >> 5;
        f32x4 po[4];
        {
#if ML_WVREG
          const f32x4 q0 = wq0, q1 = wq1, q2 = wq2, q3 = wq3;
#else
          const float* wb = wv + (size_t)(vc0 / 4 + vblk) * 16;
          const f32x4 q0 = *(const GAS f32x4*)(wb), q1 = *(const GAS f32x4*)(wb + 4), q2 = *(const GAS f32x4*)(wb + 8), q3 = *(const GAS f32x4*)(wb + 12);
#endif
          v2u xv[4];
#if ML_XPF
#pragma unroll
          for (int i = 0; i < 4; ++i) xv[i] = xvn[i];
#else
#pragma unroll
          for (int i = 0; i < 4; ++i) xv[i] = *(const GAS v2u*)(xm + (m0 + 4 * sg + i) * CW + vc0 + 4 * vblk);
#endif
          if (!ML_SDOWN || ch == 0) {
#pragma unroll
          for (int i = 0; i < 8; ++i) { const int row = w + 8 * i;
              __builtin_amdgcn_global_load_lds((const unsigned*)(xcg + (m0 + row) * CW + hc0 + 8 * lid), (LAS unsigned*)(QP + row * ML_QSTR), 16, 0, 0); } }
          if (w == 0 && !DSK(6)) {
            const int s = lid; const float mprev = MS[MS_SCAL + 2 + (ch & 1)];
#if ML_GPRE
            const float bcum = fpre, pm = gpm;
#else
            const float lf = fminf(fpre, 0.f) - log1pf(__expf(-fabsf(fpre)));
            float bcum = lf;
#pragma unroll
            for (int o = 1; o < 64; o <<= 1) { const float tv = bperm(s - o, bcum); if (s >= o) bcum += tv; }
            float pm = ipre - bcum;
#pragma unroll
            for (int o = 1; o < 64; o <<= 1) { const float tv = bperm(s - o, pm); if (s >= o) pm = fmaxf(pm, tv); }
#endif
            const float blast = __int_as_float(__builtin_amdgcn_readlane(__float_as_int(bcum), 63)), pmlast = __int_as_float(__builtin_amdgcn_readlane(__float_as_int(pm), 63));
            const float mt = fmaxf(bcum + mprev, bcum + pm);
            const float mnew = fmaxf(blast + mprev, blast + pmlast);
            MS[MS_E + s] = __expf(blast - bcum + ipre - mnew);
            MS[MS_ROWF + s] = __expf(bcum - blast + mnew - mt);
            MS[MS_SC + s] = __expf(bcum + mprev - mt);
            MS[MS_FLOOR + s] = __expf(-mt);
            MS[MS_QN + s] = 0.f;
            if (s == 0) { MS[MS_SCAL + 0] = __expf(blast + mprev - mnew); MS[MS_SCAL + 2 + ((ch + 1) & 1)] = mnew; }
          }
#pragma unroll
          for (int i = 0; i < 4; ++i) po[i] = q0 * bflo(xv[i].x) + q1 * bfhi(xv[i].x) + q2 * bflo(xv[i].y) + q3 * bfhi(xv[i].y); }
        asm volatile("s_waitcnt vmcnt(0)" ::: "memory");
#pragma unroll
        for (int i = 0; i < 8; ++i) { const int row = w + 8 * i;
            __builtin_amdgcn_global_load_lds((const unsigned*)(kpg + (m0 + row) * CW + hc0 + 8 * lid), (LAS unsigned*)(KP + row * ML_QSTR), 16, 0, 0); }
        LBAR();
        if (!DSK(1)) { const f32x4 e4 = *(const LAS f32x4*)(MS + MS_E + 4 * sg);
#pragma unroll
          for (int j = 0; j < 4; ++j) *(LAS v2u*)(VTE + (4 * vblk + j) * ML_VSTR + 4 * sg) = (v2u){cvtpk(po[0][j] * e4[0], po[1][j] * e4[1]), cvtpk(po[2][j] * e4[2], po[3][j] * e4[3])}; }
        __builtin_amdgcn_sched_barrier(0);
        pg8::f32x4 N2[4];
#pragma unroll
        for (int i = 0; i < 4; ++i) N2[i] = (pg8::f32x4){0.f, 0.f, 0.f, 0.f};
#if ML_PIPE3
        if (!DSK(3)) {
#define ML_R64(dst, off) asm volatile("ds_read_b64 %0, %1 offset:%2" : "=v"(dst) : "v"(qb_), "n"(off))
#define ML_RSET(buf, ks) do { ML_R64(fa[buf][0], 0 * 32 * ML_QSTR + 64 * (ks)); ML_R64(fb[buf][0], 0 * 32 * ML_QSTR + 64 * (ks) + 32); ML_R64(fa[buf][1], 1 * 32 * ML_QSTR + 64 * (ks)); ML_R64(fb[buf][1], 1 * 32 * ML_QSTR + 64 * (ks) + 32); \
                               ML_R64(fa[buf][2], 2 * 32 * ML_QSTR + 64 * (ks)); ML_R64(fb[buf][2], 2 * 32 * ML_QSTR + 64 * (ks) + 32); ML_R64(fa[buf][3], 3 * 32 * ML_QSTR + 64 * (ks)); ML_R64(fb[buf][3], 3 * 32 * ML_QSTR + 64 * (ks) + 32); } while (0)
            const unsigned qb_ = (unsigned)(__SIZE_TYPE__)((const LAS char*)QP) + (unsigned)((r * ML_QSTR + 4 * g) * 2);
            v2u fa[2][4], fb[2][4];
            ML_RSET(0, 0);
#pragma unroll
            for (int ks = 0; ks < 16; ++ks) {
                v4u bp; bp.x = Cb[2 * ks].x; bp.y = Cb[2 * ks].y; bp.z = Cb[2 * ks + 1].x; bp.w = Cb[2 * ks + 1].y;
                const pg8::bf16x8 bfrag = __builtin_bit_cast(pg8::bf16x8, bp);
                if (ks < 15) { if (ks & 1) ML_RSET(0, ks + 1); else ML_RSET(1, ks + 1); }
                if (ks < 15) asm volatile("s_waitcnt lgkmcnt(8)" : "+v"(fa[ks & 1][0]), "+v"(fb[ks & 1][0]), "+v"(fa[ks & 1][1]), "+v"(fb[ks & 1][1]), "+v"(fa[ks & 1][2]), "+v"(fb[ks & 1][2]), "+v"(fa[ks & 1][3]), "+v"(fb[ks & 1][3]));
                else asm volatile("s_waitcnt lgkmcnt(0)" : "+v"(fa[ks & 1][0]), "+v"(fb[ks & 1][0]), "+v"(fa[ks & 1][1]), "+v"(fb[ks & 1][1]), "+v"(fa[ks & 1][2]), "+v"(fb[ks & 1][2]), "+v"(fa[ks & 1][3]), "+v"(fb[ks & 1][3]));
#pragma unroll
                for (int tq = 0; tq < 4; ++tq) { const v4u ap = (v4u){fa[ks & 1][tq].x, fa[ks & 1][tq].y, fb[ks & 1][tq].x, fb[ks & 1][tq].y};
                    N2[tq] = __builtin_amdgcn_mfma_f32_16x16x32_bf16(__builtin_bit_cast(pg8::bf16x8, ap), bfrag, N2[tq], 0, 0, 0); }
            }
#undef ML_RSET
#undef ML_R64
        }
        __builtin_amdgcn_sched_barrier(0);
#else
        if (!DSK(3))
#pragma unroll
        for (int ks = 0; ks < 16; ++ks) {
            v4u bp; bp.x = Cb[2 * ks].x; bp.y = Cb[2 * ks].y; bp.z = Cb[2 * ks + 1].x; bp.w = Cb[2 * ks + 1].y;
            const pg8::bf16x8 bfrag = __builtin_bit_cast(pg8::bf16x8, bp);
#pragma unroll
            for (int tq = 0; tq < 4; ++tq) { const LAS bf16* qrow = QP + (16 * tq + r) * ML_QSTR + 32 * ks + 4 * g;
                const v2u a0 = *(const LAS v2u*)(qrow), a1 = *(const LAS v2u*)(qrow + 16); v4u ap; ap.x = a0.x; ap.y = a0.y; ap.z = a1.x; ap.w = a1.y;
                N2[tq] = __builtin_amdgcn_mfma_f32_16x16x32_bf16(__builtin_bit_cast(pg8::bf16x8, ap), bfrag, N2[tq], 0, 0, 0); }
            if ((ks & 3) == 3) __builtin_amdgcn_sched_barrier(0);
        }
#endif
        if (!DSK(7)) { const int tqq = w & 3, kh = w >> 2; pg8::f32x4 qa = {0.f, 0.f, 0.f, 0.f};
#if ML_QNASM && ML_NSPLIT
          {
              const unsigned qb_ = (unsigned)(__SIZE_TYPE__)((const LAS char*)QP) + (unsigned)(((16 * tqq + r) * ML_QSTR + 256 * kh + 4 * g) * 2);
              const unsigned nb_ = (unsigned)(__SIZE_TYPE__)((const LAS char*)SD) + (unsigned)(512 * kh + 16 * g);
#define ML_QN_SET(buf, k8) do { asm volatile("ds_read_b64 %0, %1 offset:%2" : "=v"(qa0[buf]) : "v"(qb_), "n"(64 * (k8))); asm volatile("ds_read_b64 %0, %1 offset:%2" : "=v"(qa1[buf]) : "v"(qb_), "n"(64 * (k8) + 32)); \
                               asm volatile("ds_read_b128 %0, %1 offset:%2" : "=v"(qnp[buf]) : "v"(nb_), "n"(64 * (k8))); asm volatile("ds_read_b128 %0, %1 offset:%2" : "=v"(qnl[buf]) : "v"(nb_), "n"(64 * (k8) + 1024)); } while (0)
              v2u qa0[2], qa1[2]; v4u qnp[2], qnl[2];
              ML_QN_SET(0, 0);
#pragma unroll
              for (int k8 = 0; k8 < 8; ++k8) {
                  if (k8 < 7) { if (k8 & 1) ML_QN_SET(0, k8 + 1); else ML_QN_SET(1, k8 + 1); }
                  if (k8 < 7) asm volatile("s_waitcnt lgkmcnt(4)" : "+v"(qa0[k8 & 1]), "+v"(qa1[k8 & 1]), "+v"(qnp[k8 & 1]), "+v"(qnl[k8 & 1]));
                  else asm volatile("s_waitcnt lgkmcnt(0)" : "+v"(qa0[k8 & 1]), "+v"(qa1[k8 & 1]), "+v"(qnp[k8 & 1]), "+v"(qnl[k8 & 1]));
                  const v4u ap = (v4u){qa0[k8 & 1].x, qa0[k8 & 1].y, qa1[k8 & 1].x, qa1[k8 & 1].y};
                  qa = __builtin_amdgcn_mfma_f32_16x16x32_bf16(__builtin_bit_cast(pg8::bf16x8, ap), __builtin_bit_cast(pg8::bf16x8, qnp[k8 & 1]), qa, 0, 0, 0);
                  qa = __builtin_amdgcn_mfma_f32_16x16x32_bf16(__builtin_bit_cast(pg8::bf16x8, ap), __builtin_bit_cast(pg8::bf16x8, qnl[k8 & 1]), qa, 0, 0, 0); }
#undef ML_QN_SET
          }
#else
          int qn1 = ((16 * tqq + r) * ML_QSTR + 256 * kh + 4 * g) * 2, qn2 = qn1 + 32; asm volatile("" : "+v"(qn2));
#pragma unroll
          for (int k8 = 0; k8 < 8; ++k8) { const int ks = 8 * kh + k8;
              const v2u a0 = *(const LAS v2u*)((const LAS char*)QP + qn1 + 64 * k8), a1 = *(const LAS v2u*)((const LAS char*)QP + qn2 + 64 * k8); v4u ap; ap.x = a0.x; ap.y = a0.y; ap.z = a1.x; ap.w = a1.y;
#if ML_NSPLIT
              const v4u np = *(const LAS v4u*)(SD + 32 * ks + 8 * g), nl = *(const LAS v4u*)(SD + 512 + 32 * ks + 8 * g);
#else
              const f32x4 n0 = *(const LAS f32x4*)(MS + MS_N + 32 * ks + 4 * g), n1 = *(const LAS f32x4*)(MS + MS_N + 32 * ks + 16 + 4 * g);
              v4u np; np.x = cvtpk(n0.x, n0.y); np.y = cvtpk(n0.z, n0.w); np.z = cvtpk(n1.x, n1.y); np.w = cvtpk(n1.z, n1.w);
              v4u nl;
              nl.x = cvtpk(n0.x - bflo(np.x), n0.y - bfhi(np.x)); nl.y = cvtpk(n0.z - bflo(np.y), n0.w - bfhi(np.y)); nl.z = cvtpk(n1.x - bflo(np.z), n1.y - bfhi(np.z)); nl.w = cvtpk(n1.z - bflo(np.w), n1.w - bfhi(np.w));
#endif
              qa = __builtin_amdgcn_mfma_f32_16x16x32_bf16(__builtin_bit_cast(pg8::bf16x8, ap), __builtin_bit_cast(pg8::bf16x8, np), qa, 0, 0, 0);
              qa = __builtin_amdgcn_mfma_f32_16x16x32_bf16(__builtin_bit_cast(pg8::bf16x8, ap), __builtin_bit_cast(pg8::bf16x8, nl), qa, 0, 0, 0); }
#endif
          if (r == 0) {
#pragma unroll
              for (int rg = 0; rg < 4; ++rg) __hip_atomic_fetch_add(&MS[MS_QN + 16 * tqq + 4 * g + rg], qa[rg], __ATOMIC_RELAXED, __HIP_MEMORY_SCOPE_WORKGROUP); } }
        asm volatile("s_waitcnt vmcnt(0)" ::: "memory");
        LBAR();
        const int tm = w >> 1, tn0 = 2 * (w & 1);
        pg8::f32x4 S0 = {0.f, 0.f, 0.f, 0.f}, S1 = {0.f, 0.f, 0.f, 0.f};
        if (tn0 <= tm && !DSK(2)) {
#if ML_PIPE2
            const LAS bf16* pa = QP + (16 * tm + r) * ML_QSTR + 8 * g; const LAS bf16* pb = KP + (16 * tn0 + r) * ML_QSTR + 8 * g;
            pg8::bf16x8 an = *(const LAS pg8::bf16x8*)(pa), b0n = *(const LAS pg8::bf16x8*)(pb), b1n = *(const LAS pg8::bf16x8*)(pb + 16 * ML_QSTR);
#pragma unroll
            for (int ks = 0; ks < 16; ++ks) { const pg8::bf16x8 a = an, b0 = b0n, b1 = b1n;
                if (ks < 15) { an = *(const LAS pg8::bf16x8*)(pa + 32 * (ks + 1)); b0n = *(const LAS pg8::bf16x8*)(pb + 32 * (ks + 1)); b1n = *(const LAS pg8::bf16x8*)(pb + 16 * ML_QSTR + 32 * (ks + 1)); }
                S0 = __builtin_amdgcn_mfma_f32_16x16x32_bf16(a, b0, S0, 0, 0, 0); S1 = __builtin_amdgcn_mfma_f32_16x16x32_bf16(a, b1, S1, 0, 0, 0); }
            __builtin_amdgcn_sched_group_barrier(0x100, 6, 0);
#pragma unroll
            for (int i = 0; i < 14; ++i) { __builtin_amdgcn_sched_group_barrier(0x008, 2, 0); __builtin_amdgcn_sched_group_barrier(0x100, 3, 0); }
            __builtin_amdgcn_sched_group_barrier(0x008, 4, 0);
#else
#pragma unroll 4
            for (int ks = 0; ks < 16; ++ks) { const pg8::bf16x8 a = *(const LAS pg8::bf16x8*)(QP + (16 * tm + r) * ML_QSTR + 32 * ks + 8 * g);
                const pg8::bf16x8 b0 = *(const LAS pg8::bf16x8*)(KP + (16 * tn0 + r) * ML_QSTR + 32 * ks + 8 * g), b1 = *(const LAS pg8::bf16x8*)(KP + (16 * tn0 + 16 + r) * ML_QSTR + 32 * ks + 8 * g);
                S0 = __builtin_amdgcn_mfma_f32_16x16x32_bf16(a, b0, S0, 0, 0, 0); S1 = __builtin_amdgcn_mfma_f32_16x16x32_bf16(a, b1, S1, 0, 0, 0); }
#endif
#pragma unroll
            for (int rg = 0; rg < 4; ++rg) { const int t = 16 * tm + 4 * g + rg;
                if (16 * tn0 + r > t) S0[rg] = 0.f; if (16 * tn0 + 16 + r > t) S1[rg] = 0.f; }
        }
        __builtin_amdgcn_sched_barrier(0);
#else
        if (!DSK(0)) {
#if ML_QPF
#pragma unroll
            for (int it = 0; it < ML_QPF; ++it) { const int id = it * NTHR + tid, row = id >> 6, cchunk = id & 63; *(LAS v4u*)(QP + row * ML_QSTR + 8 * cchunk) = qpf[it]; }
#pragma unroll
            for (int it = ML_QPF; it < 8; ++it) { const int id = it * NTHR + tid, row = id >> 6, cchunk = id & 63;
                *(LAS v4u*)(QP + row * ML_QSTR + 8 * cchunk) = *(const GAS v4u*)(xcg + (m0 + row) * CW + hc0 + 8 * cchunk); }
#pragma unroll 4
            for (int it = 0; it < 8; ++it) { const int id = it * NTHR + tid, row = id >> 6, cchunk = id & 63;
                *(LAS v4u*)(KP + row * ML_QSTR + 8 * cchunk) = *(const GAS v4u*)(kpg + (m0 + row) * CW + hc0 + 8 * cchunk); }
#else
#pragma unroll 2
        for (int it = 0; it < 8; ++it) { const int id = it * NTHR + tid, row = id >> 6, cchunk = id & 63;
            const v4u q = *(const GAS v4u*)(xcg + (m0 + row) * CW + hc0 + 8 * cchunk), k = *(const GAS v4u*)(kpg + (m0 + row) * CW + hc0 + 8 * cchunk);
            *(LAS v4u*)(QP + row * ML_QSTR + 8 * cchunk) = q; *(LAS v4u*)(KP + row * ML_QSTR + 8 * cchunk) = k; }
#endif
        }
        if (w == 0 && !DSK(6)) {
            const int s = lid; const float mprev = MS[MS_SCAL + 2 + (ch & 1)];
            const float ipre = gates[(m0 + s) * 16 + hh], fpre = gates[(m0 + s) * 16 + 8 + hh];
            const float lf = fminf(fpre, 0.f) - log1pf(__expf(-fabsf(fpre)));
            float bcum = lf;
#pragma unroll
            for (int o = 1; o < 64; o <<= 1) { const float tv = bperm(s - o, bcum); if (s >= o) bcum += tv; }
            float pm = ipre - bcum;
#pragma unroll
            for (int o = 1; o < 64; o <<= 1) { const float tv = bperm(s - o, pm); if (s >= o) pm = fmaxf(pm, tv); }
            const float blast = __int_as_float(__builtin_amdgcn_readlane(__float_as_int(bcum), 63)), pmlast = __int_as_float(__builtin_amdgcn_readlane(__float_as_int(pm), 63));
            const float mt = fmaxf(bcum + mprev, bcum + pm);
            const float mnew = fmaxf(blast + mprev, blast + pmlast);
            MS[MS_E + s] = __expf(blast - bcum + ipre - mnew);
            MS[MS_ROWF + s] = __expf(bcum - blast + mnew - mt);
            MS[MS_SC + s] = __expf(bcum + mprev - mt);
            MS[MS_FLOOR + s] = __expf(-mt);
            MS[MS_QN + s] = 0.f;
            if (s == 0) { MS[MS_SCAL + 0] = __expf(blast + mprev - mnew); MS[MS_SCAL + 2 + ((ch + 1) & 1)] = mnew; }
        }
        LBAR();
        if (!DSK(1)) { const int vblk = tid & 31, sg = tid >> 5;
          const float* wb = wv + (size_t)(vc0 / 4 + vblk) * 16;
          const f32x4 q0 = *(const GAS f32x4*)(wb), q1 = *(const GAS f32x4*)(wb + 4), q2 = *(const GAS f32x4*)(wb + 8), q3 = *(const GAS f32x4*)(wb + 12);
          const f32x4 e4 = *(const LAS f32x4*)(MS + MS_E + 4 * sg);
          f32x4 o[4];
#pragma unroll
          for (int i = 0; i < 4; ++i) { const v2u xv = *(const GAS v2u*)(xm + (m0 + 4 * sg + i) * CW + vc0 + 4 * vblk);
              o[i] = (q0 * bflo(xv.x) + q1 * bfhi(xv.x) + q2 * bflo(xv.y) + q3 * bfhi(xv.y)) * e4[i]; }
#pragma unroll
          for (int j = 0; j < 4; ++j) *(LAS v2u*)(VTE + (4 * vblk + j) * ML_VSTR + 4 * sg) = (v2u){cvtpk(o[0][j], o[1][j]), cvtpk(o[2][j], o[3][j])}; }
        __builtin_amdgcn_sched_barrier(0);
        const int tm = w >> 1, tn0 = 2 * (w & 1);
        pg8::f32x4 S0 = {0.f, 0.f, 0.f, 0.f}, S1 = {0.f, 0.f, 0.f, 0.f};
        if (tn0 <= tm && !DSK(2)) {
#pragma unroll 4
            for (int ks = 0; ks < 16; ++ks) { const pg8::bf16x8 a = *(const LAS pg8::bf16x8*)(QP + (16 * tm + r) * ML_QSTR + 32 * ks + 8 * g);
                const pg8::bf16x8 b0 = *(const LAS pg8::bf16x8*)(KP + (16 * tn0 + r) * ML_QSTR + 32 * ks + 8 * g), b1 = *(const LAS pg8::bf16x8*)(KP + (16 * tn0 + 16 + r) * ML_QSTR + 32 * ks + 8 * g);
                S0 = __builtin_amdgcn_mfma_f32_16x16x32_bf16(a, b0, S0, 0, 0, 0); S1 = __builtin_amdgcn_mfma_f32_16x16x32_bf16(a, b1, S1, 0, 0, 0); }
#pragma unroll
            for (int rg = 0; rg < 4; ++rg) { const int t = 16 * tm + 4 * g + rg;
                if (16 * tn0 + r > t) S0[rg] = 0.f; if (16 * tn0 + 16 + r > t) S1[rg] = 0.f; }
        }
        __builtin_amdgcn_sched_barrier(0);
        pg8::f32x4 N2[4];
#pragma unroll
        for (int i = 0; i < 4; ++i) N2[i] = (pg8::f32x4){0.f, 0.f, 0.f, 0.f};
        if (!DSK(3))
#pragma unroll
        for (int ks = 0; ks < 16; ++ks) {
            v4u bp; bp.x = Cb[2 * ks].x; bp.y = Cb[2 * ks].y; bp.z = Cb[2 * ks + 1].x; bp.w = Cb[2 * ks + 1].y;
            const pg8::bf16x8 bfrag = __builtin_bit_cast(pg8::bf16x8, bp);
#pragma unroll
            for (int tq = 0; tq < 4; ++tq) { const LAS bf16* qrow = QP + (16 * tq + r) * ML_QSTR + 32 * ks + 4 * g;
                const v2u a0 = *(const LAS v2u*)(qrow), a1 = *(const LAS v2u*)(qrow + 16); v4u ap; ap.x = a0.x; ap.y = a0.y; ap.z = a1.x; ap.w = a1.y;
                N2[tq] = __builtin_amdgcn_mfma_f32_16x16x32_bf16(__builtin_bit_cast(pg8::bf16x8, ap), bfrag, N2[tq], 0, 0, 0); }
            if ((ks & 3) == 3) __builtin_amdgcn_sched_barrier(0);
        }
        if (!DSK(7)) { const int tqq = w & 3, kh = w >> 2; pg8::f32x4 qa = {0.f, 0.f, 0.f, 0.f};
#pragma unroll
          for (int k8 = 0; k8 < 8; ++k8) { const int ks = 8 * kh + k8;
              const LAS bf16* qrow = QP + (16 * tqq + r) * ML_QSTR + 32 * ks + 4 * g;
              const v2u a0 = *(const LAS v2u*)(qrow), a1 = *(const LAS v2u*)(qrow + 16); v4u ap; ap.x = a0.x; ap.y = a0.y; ap.z = a1.x; ap.w = a1.y;
              const f32x4 n0 = *(const LAS f32x4*)(MS + MS_N + 32 * ks + 4 * g), n1 = *(const LAS f32x4*)(MS + MS_N + 32 * ks + 16 + 4 * g);
              v4u np; np.x = cvtpk(n0.x, n0.y); np.y = cvtpk(n0.z, n0.w); np.z = cvtpk(n1.x, n1.y); np.w = cvtpk(n1.z, n1.w);
              v4u nl;
              nl.x = cvtpk(n0.x - bflo(np.x), n0.y - bfhi(np.x)); nl.y = cvtpk(n0.z - bflo(np.y), n0.w - bfhi(np.y)); nl.z = cvtpk(n1.x - bflo(np.z), n1.y - bfhi(np.z)); nl.w = cvtpk(n1.z - bflo(np.w), n1.w - bfhi(np.w));
              qa = __builtin_amdgcn_mfma_f32_16x16x32_bf16(__builtin_bit_cast(pg8::bf16x8, ap), __builtin_bit_cast(pg8::bf16x8, np), qa, 0, 0, 0);
              qa = __builtin_amdgcn_mfma_f32_16x16x32_bf16(__builtin_bit_cast(pg8::bf16x8, ap), __builtin_bit_cast(pg8::bf16x8, nl), qa, 0, 0, 0); }
          if (r == 0) {
#pragma unroll
              for (int rg = 0; rg < 4; ++rg) __hip_atomic_fetch_add(&MS[MS_QN + 16 * tqq + 4 * g + rg], qa[rg], __ATOMIC_RELAXED, __HIP_MEMORY_SCOPE_WORKGROUP); } }
#endif
#if !(ML_SDOWN && ML_GLDS)
        LBAR();
#endif
        if (tn0 <= tm) {
#pragma unroll
            for (int rg = 0; rg < 4; ++rg) { const int t = 16 * tm + 4 * g + rg; SD[SDX(t, 16 * tn0 + r)] = (bf16)f2bf(S0[rg]); SD[SDX(t, 16 * tn0 + 16 + r)] = (bf16)f2bf(S1[rg]); }
        } else {
#pragma unroll
            for (int rg = 0; rg < 4; ++rg) { const int t = 16 * tm + 4 * g + rg; SD[SDX(t, 16 * tn0 + r)] = 0; SD[SDX(t, 16 * tn0 + 16 + r)] = 0; }
        }
        LBAR();
#if ML_SDOWN && ML_GLDS
        if (ch + 1 < SEQ / 64) {
#if ML_XPF
            { int t2_ = F.tid; asm volatile("" : "+v"(t2_)); const int vb_ = t2_ & 31, sg_ = t2_ >> 5, l2_ = t2_ & 63;
#pragma unroll
              for (int i = 0; i < 4; ++i) xvn[i] = *(const GAS v2u*)(xm + (m0 + 64 + 4 * sg_ + i) * CW + vc0 + 4 * vb_);
              if (w == 0) { ipn = gates[(m0 + 64 + l2_) * 16 + hh]; const f32x2 bp = *(const GAS f32x2*)(gsc + ((ch + 1) * 64 + l2_) * 2); fpn = bp.x; gpn = bp.y; } }
#endif
#pragma unroll
            for (int i = 0; i < 8; ++i) { const int row = w + 8 * i;
                __builtin_amdgcn_global_load_lds((const unsigned*)(xcg + (m0 + 64 + row) * CW + hc0 + 8 * lid), (LAS unsigned*)(QP + row * ML_QSTR), 16, 0, 0); } }
#endif
#if ML_QPF
        if (ch + 1 < SEQ / 64) { int t2_ = F.tid; asm volatile("" : "+v"(t2_));
#pragma unroll
            for (int it = 0; it < ML_QPF; ++it) { const int id = it * NTHR + t2_, row = id >> 6, cchunk = id & 63; qpf[it] = *(const GAS v4u*)(xcg + (m0 + 64 + row) * CW + hc0 + 8 * cchunk); } }
#endif
        const float decay = MS[MS_SCAL + 0];
        pg8::bf16x8 eb0, eb1, el0, el1; pg8::f32x4 nacc[4];
#pragma unroll
        for (int i = 0; i < 4; ++i) nacc[i] = (pg8::f32x4){0.f, 0.f, 0.f, 0.f};
          { const f32x4 ea = *(const LAS f32x4*)(MS + MS_E + 8 * g), ebv = *(const LAS f32x4*)(MS + MS_E + 8 * g + 4), ec = *(const LAS f32x4*)(MS + MS_E + 32 + 8 * g), ed = *(const LAS f32x4*)(MS + MS_E + 32 + 8 * g + 4);
            v4u p0, p1; p0.x = cvtpk(ea.x, ea.y); p0.y = cvtpk(ea.z, ea.w); p0.z = cvtpk(ebv.x, ebv.y); p0.w = cvtpk(ebv.z, ebv.w); p1.x = cvtpk(ec.x, ec.y); p1.y = cvtpk(ec.z, ec.w); p1.z = cvtpk(ed.x, ed.y); p1.w = cvtpk(ed.z, ed.w);
            eb0 = __builtin_bit_cast(pg8::bf16x8, p0); eb1 = __builtin_bit_cast(pg8::bf16x8, p1);
#if NEW_N == 4
            v4u q0, q1;
            q0.x = cvtpk(ea.x - bflo(p0.x), ea.y - bfhi(p0.x)); q0.y = cvtpk(ea.z - bflo(p0.y), ea.w - bfhi(p0.y)); q0.z = cvtpk(ebv.x - bflo(p0.z), ebv.y - bfhi(p0.z)); q0.w = cvtpk(ebv.z - bflo(p0.w), ebv.w - bfhi(p0.w));
            q1.x = cvtpk(ec.x - bflo(p1.x), ec.y - bfhi(p1.x)); q1.y = cvtpk(ec.z - bflo(p1.y), ec.w - bfhi(p1.y)); q1.z = cvtpk(ed.x - bflo(p1.z), ed.y - bfhi(p1.z)); q1.w = cvtpk(ed.z - bflo(p1.w), ed.w - bfhi(p1.w));
            el0 = __builtin_bit_cast(pg8::bf16x8, q0); el1 = __builtin_bit_cast(pg8::bf16x8, q1);
#endif
          }
        pg8::f32x4 RSa[4];
#pragma unroll
        for (int i = 0; i < 4; ++i) RSa[i] = (pg8::f32x4){0.f, 0.f, 0.f, 0.f};
#pragma unroll
        for (int i = 0; i < 4; ++i) N2[i] = N2[i] * decay;
#pragma unroll
        for (int ks = 0; ks < 2; ++ks) { const pg8::bf16x8 vb = *(const LAS pg8::bf16x8*)(VTE + (16 * w + r) * ML_VSTR + 32 * ks + 8 * g);
#pragma unroll
            for (int tq = 0; tq < 4; ++tq) { const pg8::bf16x8 a = *(const LAS pg8::bf16x8*)(SD + SDX(16 * tq + r, 32 * ks + 8 * g));
                N2[tq] = __builtin_amdgcn_mfma_f32_16x16x32_bf16(a, vb, N2[tq], 0, 0, 0);
                RSa[tq] = __builtin_amdgcn_mfma_f32_16x16x32_bf16(a, ks ? eb1 : eb0, RSa[tq], 0, 0, 0); RSa[tq] = __builtin_amdgcn_mfma_f32_16x16x32_bf16(a, ks ? el1 : el0, RSa[tq], 0, 0, 0); } }
#pragma unroll
        for (int tq = 0; tq < 4; ++tq)
#pragma unroll
            for (int rg = 0; rg < 4; ++rg) { const int t = 16 * tq + 4 * g + rg; const float rowf = MS[MS_ROWF + t], sc = MS[MS_SC + t];
                const float num = rowf * N2[tq][rg], den = rowf * RSa[tq][rg] + sc * MS[MS_QN + t];
                const float hval = num * __builtin_amdgcn_rcpf(fmaxf(fabsf(den), MS[MS_FLOOR + t]));
                if (!dry) xm[(m0 + t) * CW + vc0 + 16 * w + r] = (bf16)f2bf(hval); }
        __builtin_amdgcn_sched_barrier(0);
        { const pg8::bf16x8 vb0 = *(const LAS pg8::bf16x8*)(VTE + (16 * w + r) * ML_VSTR + 8 * g), vb1 = *(const LAS pg8::bf16x8*)(VTE + (16 * w + r) * ML_VSTR + 32 + 8 * g);
          const int q4 = r >> 2, p4 = r & 3;
#if ML_PIPE6 && NEW_N == 4
#define ML_TRA(dst0, dst1, KB) do { const LAS bf16* base_ = KP + (8 * g + q4) * ML_QSTR + 16 * (KB) + 4 * p4; \
              const s16x4 t00 = __builtin_amdgcn_ds_read_tr16_b64_v4i16((LAS s16x4*)(base_)), t01 = __builtin_amdgcn_ds_read_tr16_b64_v4i16((LAS s16x4*)(base_ + 4 * ML_QSTR)); \
              const s16x4 t10 = __builtin_amdgcn_ds_read_tr16_b64_v4i16((LAS s16x4*)(base_ + 32 * ML_QSTR)), t11 = __builtin_amdgcn_ds_read_tr16_b64_v4i16((LAS s16x4*)(base_ + 36 * ML_QSTR)); \
              dst0[0] = t00[0]; dst0[1] = t00[1]; dst0[2] = t00[2]; dst0[3] = t00[3]; dst0[4] = t01[0]; dst0[5] = t01[1]; dst0[6] = t01[2]; dst0[7] = t01[3]; \
              dst1[0] = t10[0]; dst1[1] = t10[1]; dst1[2] = t10[2]; dst1[3] = t10[3]; dst1[4] = t11[0]; dst1[5] = t11[1]; dst1[6] = t11[2]; dst1[7] = t11[3]; } while (0)
          if (!DSK(4)) {
              { pg8::f32x4 na[4];
#pragma unroll
                for (int i = 0; i < 4; ++i) { pg8::bf16x8 a0, a1; ML_TRA(a0, a1, 4 * w + i);
                    na[i] = __builtin_amdgcn_mfma_f32_16x16x32_bf16(a0, eb0, ((pg8::f32x4){0.f, 0.f, 0.f, 0.f}), 0, 0, 0); na[i] = __builtin_amdgcn_mfma_f32_16x16x32_bf16(a1, eb1, na[i], 0, 0, 0);
                    na[i] = __builtin_amdgcn_mfma_f32_16x16x32_bf16(a0, el0, na[i], 0, 0, 0); na[i] = __builtin_amdgcn_mfma_f32_16x16x32_bf16(a1, el1, na[i], 0, 0, 0); }
                if (r == 0) {
#pragma unroll
                    for (int i = 0; i < 4; ++i) { LAS f32x4* np_ = (LAS f32x4*)(MS + MS_N + 16 * (4 * w + i) + 4 * g); *np_ = *np_ * decay + na[i]; } } }
              __builtin_amdgcn_sched_barrier(0);
              pg8::bf16x8 an[2][2];
              ML_TRA(an[0][0], an[0][1], 0); ML_TRA(an[1][0], an[1][1], 1);
#pragma unroll
              for (int kp = 0; kp < 16; ++kp) {
                  pg8::bf16x8 ac[2][2];
#pragma unroll
                  for (int u = 0; u < 2; ++u) { ac[u][0] = an[u][0]; ac[u][1] = an[u][1]; }
                  if (kp < 15) { ML_TRA(an[0][0], an[0][1], 2 * kp + 2); ML_TRA(an[1][0], an[1][1], 2 * kp + 3); }
                  pg8::f32x4 c0 = (pg8::f32x4){bflo(Cb[2 * kp].x), bfhi(Cb[2 * kp].x), bflo(Cb[2 * kp].y), bfhi(Cb[2 * kp].y)} * decay;
                  pg8::f32x4 c1 = (pg8::f32x4){bflo(Cb[2 * kp + 1].x), bfhi(Cb[2 * kp + 1].x), bflo(Cb[2 * kp + 1].y), bfhi(Cb[2 * kp + 1].y)} * decay;
                  c0 = __builtin_amdgcn_mfma_f32_16x16x32_bf16(ac[0][0], vb0, c0, 0, 0, 0); c1 = __builtin_amdgcn_mfma_f32_16x16x32_bf16(ac[1][0], vb0, c1, 0, 0, 0);
                  c0 = __builtin_amdgcn_mfma_f32_16x16x32_bf16(ac[0][1], vb1, c0, 0, 0, 0); c1 = __builtin_amdgcn_mfma_f32_16x16x32_bf16(ac[1][1], vb1, c1, 0, 0, 0);
                  Cb[2 * kp].x = cvtpk(c0[0], c0[1]); Cb[2 * kp].y = cvtpk(c0[2], c0[3]); Cb[2 * kp + 1].x = cvtpk(c1[0], c1[1]); Cb[2 * kp + 1].y = cvtpk(c1[2], c1[3]);
              }
              __builtin_amdgcn_sched_group_barrier(0x100, 8, 0);
#pragma unroll
              for (int i = 0; i < 15; ++i) { __builtin_amdgcn_sched_group_barrier(0x100, 8, 0); __builtin_amdgcn_sched_group_barrier(0x008, 4, 0); }
              __builtin_amdgcn_sched_group_barrier(0x008, 4, 0);
          }
#undef ML_TRA
#else
          if (!DSK(4))
#pragma unroll
          for (int kb = 0; kb < 32; ++kb) {
              const LAS bf16* base = KP + (8 * g + q4) * ML_QSTR + 16 * kb + 4 * p4;
              const s16x4 t00 = __builtin_amdgcn_ds_read_tr16_b64_v4i16((LAS s16x4*)(base)), t01 = __builtin_amdgcn_ds_read_tr16_b64_v4i16((LAS s16x4*)(base + 4 * ML_QSTR));
              const s16x4 t10 = __builtin_amdgcn_ds_read_tr16_b64_v4i16((LAS s16x4*)(base + 32 * ML_QSTR)), t11 = __builtin_amdgcn_ds_read_tr16_b64_v4i16((LAS s16x4*)(base + 36 * ML_QSTR));
              pg8::bf16x8 a0, a1;
              a0[0] = t00[0]; a0[1] = t00[1]; a0[2] = t00[2]; a0[3] = t00[3]; a0[4] = t01[0]; a0[5] = t01[1]; a0[6] = t01[2]; a0[7] = t01[3];
              a1[0] = t10[0]; a1[1] = t10[1]; a1[2] = t10[2]; a1[3] = t10[3]; a1[4] = t11[0]; a1[5] = t11[1]; a1[6] = t11[2]; a1[7] = t11[3];
              pg8::f32x4 c = (pg8::f32x4){bflo(Cb[kb].x), bfhi(Cb[kb].x), bflo(Cb[kb].y), bfhi(Cb[kb].y)} * decay;
              c = __builtin_amdgcn_mfma_f32_16x16x32_bf16(a0, vb0, c, 0, 0, 0);
              c = __builtin_amdgcn_mfma_f32_16x16x32_bf16(a1, vb1, c, 0, 0, 0);
              Cb[kb].x = cvtpk(c[0], c[1]); Cb[kb].y = cvtpk(c[2], c[3]);
              if (NEW_N && (kb >> 2) == w) { pg8::f32x4 na = __builtin_amdgcn_mfma_f32_16x16x32_bf16(a0, eb0, ((pg8::f32x4){0.f, 0.f, 0.f, 0.f}), 0, 0, 0); na = __builtin_amdgcn_mfma_f32_16x16x32_bf16(a1, eb1, na, 0, 0, 0);
#if NEW_N == 4
                  na = __builtin_amdgcn_mfma_f32_16x16x32_bf16(a0, el0, na, 0, 0, 0); na = __builtin_amdgcn_mfma_f32_16x16x32_bf16(a1, el1, na, 0, 0, 0);
#endif
#if NEW_N == 2
                  if (r == 0) { LAS f32x4* np_ = (LAS f32x4*)(MS + MS_QN + 600 + 16 * kb + 4 * g); *np_ = na; } }
#elif NEW_N == 3
                  nacc[kb & 3] = na; }
#else
                  if (r == 0) { LAS f32x4* np_ = (LAS f32x4*)(MS + MS_N + 16 * kb + 4 * g); *np_ = *np_ * decay + na; } }
#endif
              if ((kb & 7) == 7) __builtin_amdgcn_sched_barrier(0);
          }
#endif
#if NEW_N == 3
          if (r == 0) {
#pragma unroll
              for (int i = 0; i < 4; ++i) { LAS f32x4* np_ = (LAS f32x4*)(MS + MS_N + 16 * (4 * w + i) + 4 * g); *np_ = *np_ * decay + nacc[i]; } }
#endif
          if (NEW_N != 1 && NEW_N != 3 && NEW_N != 4) { float nk = MS[MS_N + tid] * decay;
#pragma unroll 8
          for (int s2 = 0; s2 < 64; ++s2) nk += MS[MS_E + s2] * bf1(KP[s2 * ML_QSTR + tid]);
          MS[MS_N + tid] = nk; }
        }
        LBAR();
    }
}

#ifndef SITE_MASK
#define SITE_MASK 0xFFFFFFFFu
#endif
#define SITE_ON(n) (((SITE_MASK) >> (n)) & 1u)
#ifndef GEMM_ALIGN
#define GEMM_ALIGN true
#endif
#ifndef GEMM_SP2
#define GEMM_SP2 true
#endif
#ifndef RW_SKIP
#define RW_SKIP 0
#endif
#ifndef RW_REP
#define RW_REP 1
#endif
#ifndef RG_REP
#define RG_REP 1
#endif
#ifndef REP_MASK
#define REP_MASK 0u
#endif
#define SITE_REP(n) (1 + (int)(((REP_MASK) >> (n)) & 1u))
constexpr int N_PHASES = 22;
struct Args { Ptrs p; int ph_lo, ph_hi, li, pad; };
__device__ __forceinline__ Frame mk_frame(LAS unsigned char* lds) {
    Frame F; F.lds = lds; int t = threadIdx.x; asm volatile("" : "+v"(t));
    F.tid = t; F.lane = t & 63; F.wave = __builtin_amdgcn_readfirstlane(t >> 6);
    F.G = gridDim.x; F.gw = blockIdx.x * NWAVES + F.wave; F.NGW = F.G * NWAVES; return F;
}
template <class Epi, bool ALIGN = GEMM_ALIGN> __device__ __forceinline__ void run_gemm(Frame& F, const bf16* A, const bf16* Bt, int Mr, int N, int K, const Epi& E) {
    pg8::Gemm g{A, Bt, Mr, N, K}; pg8::StaticOrder S; S.init(Mr, N, F.G, (int)blockIdx.x);
    pg8::gemm_phase<Epi, pg8::StaticOrder, ALIGN, GEMM_SP2>(F.lds, g, S, E);
}
__global__ void __launch_bounds__(NTHR, 2) fwd_kernel(Args args) {
    extern __shared__ __attribute__((aligned(16))) unsigned char lds_raw[];
    const Ptrs& P = args.p; unsigned char* ws = P.ws;
    volatile LAS unsigned* MISC = (volatile LAS unsigned*)((LAS unsigned char*)lds_raw + MISC_OFF);
    if (threadIdx.x < 64) MISC[threadIdx.x] = 0u;
    __syncthreads();
    XcdBarrier bar = xcd_barrier_post((unsigned*)(ws + WS_CTL) + 1024 + args.li * 4096, MISC + 8);
    const int lo = args.ph_lo, hi = args.ph_hi;
    int ph = 0;
#define PHASE_BEGIN if (ph >= lo && ph < hi) { Frame F = mk_frame((LAS unsigned char*)lds_raw);
#define PHASE_END   if (ph + 1 < hi) xcd_barrier(bar); } ++ph;

    PHASE_BEGIN
#if SITE_ON(0)
 for (int rep_ = 0; rep_ < SITE_REP(0); ++rep_) { if (rep_) xcd_barrier(bar);
 ph_prologue(F, P); ph_rmsnorm_bf16(F, P.in[IN_X], P.in[IN_EVEN_NORM], (bf16*)(ws + WS_H));  }
#endif
    PHASE_END
    PHASE_BEGIN
#if SITE_ON(1)
 for (int rep_ = 0; rep_ < SITE_REP(1); ++rep_) { if (rep_) xcd_barrier(bar);
#if defined(DIAG_GEMM) && DIAG_GEMM < 10
 { unsigned long long* dbg = (unsigned long long*)(ws + 768 * 1024) + blockIdx.x * 8; if (threadIdx.x == 0) { dbg[0] = 0; dbg[1] = 0; dbg[3] = 0; dbg[2] = (unsigned long long)clock64(); }
   pg8::EpiTimed<pg8::EpiBf16<0>> E{{(bf16*)(ws + WS_PROJ), EIN_PAD, nullptr, 0, 0, 1.f}, dbg}; run_gemm(F, (const bf16*)(ws + WS_H), (const bf16*)(ws + WS_W_IN_E), M, EIN_PAD, DM, E); }
#else
 { pg8::EpiBf16<0> E{(bf16*)(ws + WS_PROJ), EIN_PAD, nullptr, 0, 0, 1.f}; run_gemm(F, (const bf16*)(ws + WS_H), (const bf16*)(ws + WS_W_IN_E), M, EIN_PAD, DM, E); }
#endif
 }
#endif
    PHASE_END
    PHASE_BEGIN
#if SITE_ON(2)
 for (int rep_ = 0; rep_ < SITE_REP(2); ++rep_) { if (rep_) xcd_barrier(bar);
 ph_lra(F, P);  }
#endif
    PHASE_END
    PHASE_BEGIN
#if SITE_ON(3)
 for (int rep_ = 0; rep_ < SITE_REP(3); ++rep_) { if (rep_) xcd_barrier(bar);
 { pg8::EpiBf16<0> E{(bf16*)(ws + WS_LR), LRN, (const float*)(ws + WS_LRB), 0, 0, 1.f}; run_gemm(F, (const bf16*)(ws + WS_LRA), (const bf16*)(ws + WS_W_LR), M, LRN, LRK, E); }  }
#endif
    PHASE_END
    PHASE_BEGIN
#if SITE_ON(4)
 for (int rep_ = 0; rep_ < SITE_REP(4); ++rep_) { if (rep_) xcd_barrier(bar);
 if (F.G >= 256 && blockIdx.x >= 192) { Frame Fl = F; Fl.gw = (blockIdx.x - 192) * NWAVES + F.wave; Fl.NGW = (F.G - 192) * NWAVES; ph_late_weights(Fl, P); } else if (F.G < 256 && blockIdx.x == 0) { }
 if (F.G < 256) { ph_late_weights(F, P); __syncthreads(); }
 for (int u = blockIdx.x; u < 192; u += F.G) { if (u < 128) { for (int q_ = 0; q_ < RW_REP; ++q_) { rwkv_unit2(F, P, u, (q_ + 1 < RW_REP) ? RW_SKIP : 0); __syncthreads(); } } else { for (int q_ = 0; q_ < RG_REP; ++q_) { rglru_unit(F, P, u - 128); __syncthreads(); } } }  }
#endif
    PHASE_END
    PHASE_BEGIN
#if SITE_ON(5)
 for (int rep_ = 0; rep_ < SITE_REP(5); ++rep_) { if (rep_) xcd_barrier(bar);
 { pg8::EpiRes E{P.in[IN_X], nullptr, nullptr, DM, (bf16*)(ws + WS_HRAW0), (float*)(ws + WS_SSP)}; run_gemm(F, (const bf16*)(ws + WS_H), (const bf16*)(ws + WS_W_OUT_E), M, DM, DM, E); }  }
#endif
    PHASE_END
        PHASE_BEGIN
 ph_ss_reduce(F, (const float*)(ws + WS_SSP), (float*)(ws + WS_SS) + 0);
    PHASE_END

    for (int layer = 0; layer < 2; ++layer) {
        if (layer == 1) {
            PHASE_BEGIN
#if SITE_ON(7)
 for (int rep_ = 0; rep_ < SITE_REP(7); ++rep_) { if (rep_) xcd_barrier(bar);
 { pg8::EpiBf16<0> E{(bf16*)(ws + WS_XM), CW, nullptr, 0, 0, 1.f, (const float*)(ws + WS_SS) + M}; run_gemm(F, (const bf16*)(ws + WS_H), (const bf16*)(ws + WS_W_IN_O), M, CW, DM, E); }  }
#endif
    PHASE_END
            PHASE_BEGIN
#if SITE_ON(8)
 for (int rep_ = 0; rep_ < SITE_REP(8); ++rep_) { if (rep_) xcd_barrier(bar);
 ph_mlstm_pre(F, P);  }
#endif
    PHASE_END
            PHASE_BEGIN
#if SITE_ON(9)
 for (int rep_ = 0; rep_ < SITE_REP(9); ++rep_) { if (rep_) xcd_barrier(bar);
 for (int u = blockIdx.x; u < 256; u += F.G) { const int x = u & 7, y = u >> 3, hd = 8 * (y >> 2) + x; mlstm_unit(F, P, (hd << 2) | (y & 3), rep_ + 1 < SITE_REP(9)); }  }
#endif
    PHASE_END
            PHASE_BEGIN
#if SITE_ON(10)
 for (int rep_ = 0; rep_ < SITE_REP(10); ++rep_) { if (rep_) xcd_barrier(bar);
 ph_mlstm_stats(F, P);  }
#endif
    PHASE_END
            PHASE_BEGIN
#if SITE_ON(11)
 for (int rep_ = 0; rep_ < SITE_REP(11); ++rep_) { if (rep_) xcd_barrier(bar);
 { pg8::EpiZLn E{(const bf16*)(ws + WS_XM), (bf16*)(ws + WS_XC), CW, (const float*)(ws + WS_SS) + M, (const float*)(ws + WS_STATS), P.in[IN_C_LN_W], P.in[IN_C_SKIP]}; run_gemm(F, (const bf16*)(ws + WS_H), (const bf16*)(ws + WS_W_IN_O) + (size_t)CW * DM, M, CW, DM, E); }  }
#endif
    PHASE_END
            PHASE_BEGIN
#if SITE_ON(12)
 for (int rep_ = 0; rep_ < SITE_REP(12); ++rep_) { if (rep_) xcd_barrier(bar);
 { pg8::EpiRes E{nullptr, (const bf16*)(ws + WS_H), nullptr, DM, (bf16*)(ws + WS_H), (float*)(ws + WS_SSP)}; run_gemm(F, (const bf16*)(ws + WS_XC), (const bf16*)(ws + WS_W_OUT_O), M, DM, CW, E); }  }
#endif
    PHASE_END
        PHASE_BEGIN
 ph_ss_reduce(F, (const float*)(ws + WS_SSP), (float*)(ws + WS_SS) + 2 * M);
    PHASE_END

        }
        const bf16* wgu = (const bf16*)(ws + (layer ? WS_W_GU1 : WS_W_GU0)); const bf16* wdn = (const bf16*)(ws + (layer ? WS_W_DN1 : WS_W_DN0));
        const float* fcw = P.in[IN_FFN_CONV_W] + (size_t)layer * 3 * DFF; const float* fcb = P.in[IN_FFN_CONV_B] + (size_t)layer * DFF;
        PHASE_BEGIN
#if SITE_ON(14)
 for (int rep_ = 0; rep_ < SITE_REP(14); ++rep_) { if (rep_) xcd_barrier(bar);
#if defined(DIAG_GEMM) && DIAG_GEMM >= 10
 { unsigned long long* dbg = (unsigned long long*)(ws + 768 * 1024) + blockIdx.x * 8; if (threadIdx.x == 0 && layer == 0) { dbg[0] = 0; dbg[1] = 0; dbg[3] = 0; } if (threadIdx.x == 0) dbg[2] = (unsigned long long)clock64();
   pg8::EpiTimed<pg8::EpiGU> E{{(bf16*)(ws + WS_U), fcw, fcb, (float*)(ws + WS_GTAIL), (float*)(ws + WS_PREH), (float*)(ws + WS_UPH), (LAS float*)(F.lds + HALO_OFF), (const float*)(ws + WS_SS) + (layer ? 2 * M : 0)}, dbg}; run_gemm<pg8::EpiGU, true>(F, (const bf16*)(ws + (layer ? WS_H : WS_HRAW0)), wgu, M, GUN, DM, E); } }
#else
 { pg8::EpiGU E{(bf16*)(ws + WS_U), fcw, fcb, (float*)(ws + WS_GTAIL), (float*)(ws + WS_PREH), (float*)(ws + WS_UPH), (LAS float*)(F.lds + HALO_OFF), (const float*)(ws + WS_SS) + (layer ? 2 * M : 0)}; run_gemm<pg8::EpiGU, true>(F, (const bf16*)(ws + (layer ? WS_H : WS_HRAW0)), wgu, M, GUN, DM, E); } }
#endif

#endif
    PHASE_END
        PHASE_BEGIN
#if SITE_ON(15)
 for (int rep_ = 0; rep_ < SITE_REP(15); ++rep_) { if (rep_) xcd_barrier(bar);
 ph_ffn_fix(F, (bf16*)(ws + WS_U), fcw, (const float*)(ws + WS_GTAIL), (const float*)(ws + WS_PREH), (const float*)(ws + WS_UPH)); }
#endif
    PHASE_END
        PHASE_BEGIN
#if SITE_ON(16)
 for (int rep_ = 0; rep_ < SITE_REP(16); ++rep_) { if (rep_) xcd_barrier(bar);
 { pg8::EpiRes E{nullptr, (const bf16*)(ws + (layer ? WS_H : WS_HRAW0)), nullptr, DM, (bf16*)(ws + WS_H), layer ? (float*)nullptr : (float*)(ws + WS_SSP)}; run_gemm(F, (const bf16*)(ws + WS_U), wdn, M, DM, DFF, E); } }
#endif
    PHASE_END
        if (layer == 0) {
        PHASE_BEGIN
 ph_ss_reduce(F, (const float*)(ws + WS_SSP), (float*)(ws + WS_SS) + M);
    PHASE_END
        }

    }
    PHASE_BEGIN
#if SITE_ON(17)
 for (int rep_ = 0; rep_ < SITE_REP(17); ++rep_) { if (rep_) xcd_barrier(bar);
#ifdef DIAG_GEMM
 { const unsigned long long* dbg = (const unsigned long long*)(ws + 768 * 1024); double k = 0, e2 = 0, n = 0; for (int i = 0; i < 256; ++i) { k += (double)dbg[i * 8]; e2 += (double)dbg[i * 8 + 1]; n += (double)dbg[i * 8 + 3]; }
   const float v = (DIAG_GEMM % 10) == 1 ? sqrtf(100.f * floorf((float)(e2 / k) * 25.f + 0.5f) / 25.f) : ((DIAG_GEMM % 10) == 2 ? sqrtf(floorf((float)(k / n) / 4000.f + 0.5f) * 4.f) : sqrtf(floorf((float)(e2 / n) / 2000.f + 0.5f) * 2.f));
   for (size_t i = (size_t)blockIdx.x * NTHR + threadIdx.x; i < (size_t)M * DM; i += (size_t)gridDim.x * NTHR) P.out[i] = v; }
#else
 ph_rmsnorm_final(F, (const bf16*)(ws + WS_H), P.in[IN_FINAL_NORM], P.out);
#endif
 }
#endif
    PHASE_END
#undef PHASE_BEGIN
#undef PHASE_END
}


#ifdef DIAG_PHASES
__global__ void cks_kernel(const unsigned* p0, size_t n0, const unsigned* p1, size_t n1, const unsigned* p2, size_t n2, unsigned long long* slot) {
    unsigned long long s = 0; const size_t gt = (size_t)blockIdx.x * blockDim.x + threadIdx.x, GT = (size_t)gridDim.x * blockDim.x;
    for (size_t i = gt; i < n0; i += GT) s += (unsigned long long)p0[i] * (unsigned long long)((i & 1023) + 1);
    for (size_t i = gt; i < n1; i += GT) s += (unsigned long long)p1[i] * (unsigned long long)((i & 1023) + 1);
    for (size_t i = gt; i < n2; i += GT) s += (unsigned long long)p2[i] * (unsigned long long)((i & 1023) + 1);
    for (int o = 32; o >= 1; o >>= 1) s += __shfl_xor(s, o);
    if ((threadIdx.x & 63) == 0) atomicAdd(slot, s);
}
__global__ void diag_out_kernel(const unsigned long long* slots, float* out, size_t n) {
    int p = 0; for (int i = N_PHASES - 1; i >= 0; --i) if (slots[i] != slots[64 + i]) p = i + 1;
    const float v = 1.0f + (float)p;
    for (size_t i = (size_t)blockIdx.x * blockDim.x + threadIdx.x; i < n; i += (size_t)gridDim.x * blockDim.x) out[i] = v;
}
#endif
extern "C" void kernel_launch(void* const* d_in, const int* in_sizes, int n_in, void* d_out, int out_size, void* d_ws, size_t ws_size, hipStream_t stream) {
    static int grid = 0;
    if (grid == 0) {
        if (n_in != 41 || out_size != M * DM || ws_size < WS_END) { fprintf(stderr, "kernel_launch: unexpected problem (n_in %d, out %d, ws %zu)\n", n_in, out_size, ws_size); grid = -1; return; }
        int dev = 0, cus = 0, per_cu = 0;
        if (hipGetDevice(&dev) != hipSuccess || hipDeviceGetAttribute(&cus, hipDeviceAttributeMultiprocessorCount, dev) != hipSuccess) { grid = -1; return; }
        if (hipFuncSetAttribute((const void*)fwd_kernel, hipFuncAttributeMaxDynamicSharedMemorySize, LDS_BYTES) != hipSuccess) { fprintf(stderr, "kernel_launch: hipFuncSetAttribute failed\n"); grid = -1; return; }
        if (hipOccupancyMaxActiveBlocksPerMultiprocessor(&per_cu, (const void*)fwd_kernel, NTHR, LDS_BYTES) != hipSuccess || per_cu < 1) { fprintf(stderr, "kernel_launch: occupancy query says %d\n", per_cu); (void)hipGetLastError(); }
        grid = cus;
    }
    if (grid < 0) return;
    (void)hipMemsetAsync((char*)d_ws + WS_CTL, 0, CTL_ZERO_BYTES, stream);
    Args a{};
    for (int i = 0; i < 41; ++i) a.p.in[i] = (const float*)d_in[i];
    a.p.out = (float*)d_out; a.p.ws = (unsigned char*)d_ws;
    constexpr int NL = MK_N_LAUNCHES;
#ifdef DIAG_PHASES
    static_assert(NL == N_PHASES, "diag build runs one launch per phase");
    unsigned long long* slots = (unsigned long long*)((char*)d_ws + 65536);
    unsigned char* w8 = (unsigned char*)d_ws;
    for (int run = 0; run < 2; ++run)
    for (int li = 0; li < NL; ++li) {
        a.ph_lo = li; a.ph_hi = li + 1; a.li = 0;
        hipLaunchKernelGGL(fwd_kernel, dim3(grid), dim3(NTHR), LDS_BYTES, stream, a);
        const unsigned *p0 = nullptr, *p1 = nullptr, *p2 = nullptr; size_t n0 = 0, n1 = 0, n2 = 0;
        auto R = [&](size_t off, size_t bytes, const unsigned*& p, size_t& n) { p = (const unsigned*)(w8 + off); n = bytes / 4; };
        const size_t HB = (size_t)M * DM * 2, OB = (size_t)M * DM * 4;
        switch (li) {
            case 0: R(WS_H, HB, p0, n0); R(WS_W_IN_O, 120 * MiB, p1, n1); R(WS_W_IN_E, 96 * MiB, p2, n2); break;
            case 1: R(WS_PROJ, (size_t)M * EIN_PAD * 2, p0, n0); break;
            case 2: R(WS_LRA, (size_t)M * LRK * 2, p0, n0); break;
            case 3: R(WS_LR, (size_t)M * LRN * 2, p0, n0); break;
            case 4: R(WS_H, HB, p0, n0); break;
            case 6: case 13: case 20: R(WS_H, HB, p0, n0); break;
            case 7: case 10: case 21: case 24: R(WS_GU, (size_t)MH * GUN * 2, p0, n0); break;
            case 8: case 11: case 22: case 25: R(WS_U, (size_t)MH * DFF * 2, p0, n0); break;
            case 14: case 16: R(WS_XM, (size_t)M * CW * 2, p0, n0); break;
            case 15: R(WS_XC, (size_t)M * CW * 2, p0, n0); R(WS_KPP, (size_t)M * CW * 2, p1, n1); R(WS_GATES, (size_t)M * 16 * 4, p2, n2); break;
            case 17: case 18: R(WS_XC, (size_t)M * CW * 2, p0, n0); break;
            default: p0 = (const unsigned*)d_out; n0 = OB / 4; break;
        }
        hipLaunchKernelGGL(cks_kernel, dim3(1024), dim3(256), 0, stream, p0, n0, p1, n1, p2, n2, slots + run * 64 + li);
    }
    hipLaunchKernelGGL(diag_out_kernel, dim3(1024), dim3(256), 0, stream, (const unsigned long long*)slots, (float*)d_out, (size_t)M * DM);
#else
    for (int li = 0; li < NL; ++li) {
        a.ph_lo = (int)((long)N_PHASES * li / NL); a.ph_hi = (int)((long)N_PHASES * (li + 1) / NL); a.li = (NL == N_PHASES) ? 0 : (li & 3);
        hipLaunchKernelGGL(fwd_kernel, dim3(grid), dim3(NTHR), LDS_BYTES, stream, a);
    }
#endif
}
```
